# Optimizing an MI355X kernel written in HIP

```python
import jax, jax.numpy as jnp
from jax import lax
import numpy as np

D_MODEL = 1024
BATCH = 8
SEQ = 2048
DEPTH = 4

CHUNK = 64
N_MIXERS = 2
N_RET_LAYERS = (DEPTH + 1) // 2
N_SB_LAYERS = DEPTH // 2
RET_HEADS = D_MODEL // 256
RET_QK_DIM = D_MODEL // RET_HEADS
RET_V_DIM = 2 * RET_QK_DIM
RET_IN_DIM = 2 * RET_HEADS * RET_QK_DIM + 2 * RET_HEADS * RET_V_DIM
ROPE_BASE = 10000.0
GN_EPS = 1e-6
SB_HEADS = 16
SB_HEAD_DIM = D_MODEL // SB_HEADS
Q_BLOCK = 128
N_EXPERTS = 32
TOP_K = 4
D_EXPERT = D_MODEL
SWIGLU_LIMIT = 7.0
SWIGLU_ALPHA = 1.702
MOE_BLOCK = 128
D_PLE = 256
DN_ALPHA = float((2 * DEPTH) ** 0.25)
DN_BETA = float((8 * DEPTH) ** -0.25)
LN_EPS = 1e-5

kernel_name = 'hybrid_retention_stickbreaking_moe_encoder'


def layer_norm(x, g, b):
    xf = x.astype(jnp.float32)
    mu = jnp.mean(xf, axis=-1, keepdims=True)
    var = jnp.mean(jnp.square(xf - mu), axis=-1, keepdims=True)
    return ((xf - mu) * lax.rsqrt(var + LN_EPS)).astype(x.dtype) * g + b


def rotary(x, pos):
    half = x.shape[-1] // 2
    inv_freq = 1.0 / (ROPE_BASE ** (jnp.arange(half, dtype=jnp.float32) / half))
    ang = pos.astype(jnp.float32)[:, None] * inv_freq[None, :]
    cos = jnp.cos(ang)[None, :, None, :].astype(x.dtype)
    sin = jnp.sin(ang)[None, :, None, :].astype(x.dtype)
    x1, x2 = x[..., :half], x[..., half:]
    return jnp.concatenate([x1 * cos - x2 * sin, x1 * sin + x2 * cos], axis=-1)


def retention_mixer(x, w_in, w_out):
    B, S, _ = x.shape
    H, dk, dv = RET_HEADS, RET_QK_DIM, RET_V_DIM
    proj = x @ w_in
    q, k, v, g = jnp.split(proj, [H * dk, 2 * H * dk, 2 * H * dk + H * dv], axis=-1)
    pos = jnp.arange(S)
    q = rotary(q.reshape(B, S, H, dk), pos)
    k = rotary(k.reshape(B, S, H, dk), pos) * (dk ** -0.5)
    v = v.reshape(B, S, H, dv)
    n_chunks = S // CHUNK
    log_gamma = jnp.log(1.0 - 2.0 ** (-5.0 - jnp.arange(H, dtype=jnp.float32)))
    idx = jnp.arange(CHUNK, dtype=jnp.float32)
    inner_decay = jnp.exp(log_gamma[:, None, None] * jnp.abs(idx[:, None] - idx[None, :]))
    query_decay = jnp.exp(log_gamma[:, None] * (idx + 1.0))
    key_decay = jnp.exp(log_gamma[:, None] * (CHUNK - 1.0 - idx))
    chunk_decay = jnp.exp(log_gamma * CHUNK)

    def to_chunks(t):
        return t.reshape(B, n_chunks, CHUNK, H, t.shape[-1]).transpose(1, 0, 3, 2, 4)

    def step(state, inp):
        qi, ki, vi = inp
        scores = jnp.einsum('bhid,bhjd->bhij', qi, ki) * inner_decay[None]
        inner = jnp.einsum('bhij,bhje->bhie', scores, vi)
        cross = jnp.einsum('bhid,bhde->bhie', qi, state) * query_decay[None, :, :, None]
        new_state = state * chunk_decay[None, :, None, None] + jnp.einsum(
            'bhjd,bhje->bhde', ki * key_decay[None, :, :, None], vi)
        return new_state, (inner + cross).astype(jnp.float32)

    state0 = jnp.zeros((B, H, dk, dv), jnp.float32)
    _, out = lax.scan(step, state0, (to_chunks(q), to_chunks(k), to_chunks(v)))
    out = out.transpose(1, 0, 3, 2, 4).reshape(B, S, H, dv)
    mu = jnp.mean(out, axis=-1, keepdims=True)
    var = jnp.mean(jnp.square(out - mu), axis=-1, keepdims=True)
    normed = ((out - mu) * lax.rsqrt(var + GN_EPS)).reshape(B, S, H * dv).astype(g.dtype)
    return (jax.nn.silu(g) * normed) @ w_out


def stick_breaking_mixer(x, w_in, w_out):
    B, S, _ = x.shape
    H, d = SB_HEADS, SB_HEAD_DIM
    q, k, v = jnp.split(x @ w_in, 3, axis=-1)
    q = q.reshape(B, S, H, d)
    k = k.reshape(B, S, H, d)
    v = v.reshape(B, S, H, d)
    outs = []
    for blk in range(S // Q_BLOCK):
        q0 = blk * Q_BLOCK
        kv_end = q0 + Q_BLOCK
        qb, kb, vb = q[:, q0:kv_end], k[:, :kv_end], v[:, :kv_end]
        z = jnp.einsum('bqhd,bkhd->bhqk', qb, kb).astype(jnp.float32) * (d ** -0.5)
        t_idx = q0 + jnp.arange(Q_BLOCK)[:, None]
        s_idx = jnp.arange(kv_end)[None, :]
        past = s_idx < t_idx
        log_not = jnp.where(past, -jax.nn.softplus(z), 0.0)
        later = lax.cumsum(log_not, axis=3, reverse=True) - log_not
        a = jnp.where(past, jnp.exp(jax.nn.log_sigmoid(z) + later), 0.0)
        outs.append(jnp.einsum('bhqk,bkhd->bqhd', a.astype(vb.dtype), vb))
    o = jnp.concatenate(outs, axis=1).reshape(B, S, H * d)
    return o @ w_out


def moe_channel_mixer(x, router_w, router_b, w_gate_up, b_gate_up, w_down, b_down):
    B, S, D = x.shape
    h = x.reshape(B * S, D)
    T = h.shape[0]
    logits = (h @ router_w + router_b).astype(jnp.float32)
    top_logits, top_idx = lax.top_k(logits, TOP_K)
    gates = jax.nn.softmax(top_logits, axis=-1)
    flat_e = top_idx.reshape(-1)
    flat_tok = jnp.repeat(jnp.arange(T, dtype=jnp.int32), TOP_K)
    flat_gate = gates.reshape(-1)
    order = jnp.argsort(flat_e)
    sorted_e = flat_e[order]
    counts = jnp.bincount(flat_e, length=N_EXPERTS)
    padded = (counts + MOE_BLOCK - 1) // MOE_BLOCK * MOE_BLOCK
    pad_ends = jnp.cumsum(padded)
    pad_starts = pad_ends - padded
    starts = jnp.cumsum(counts) - counts
    dest = pad_starts[sorted_e] + jnp.arange(T * TOP_K) - starts[sorted_e]
    n_blocks = -(-(T * TOP_K + N_EXPERTS * (MOE_BLOCK - 1)) // MOE_BLOCK)
    n_rows = n_blocks * MOE_BLOCK
    row_tok = jnp.full((n_rows,), T, jnp.int32).at[dest].set(flat_tok[order])
    row_gate = jnp.zeros((n_rows,), jnp.float32).at[dest].set(flat_gate[order])
    block_start = jnp.arange(n_blocks) * MOE_BLOCK
    block_expert = jnp.minimum(jnp.searchsorted(pad_ends, block_start, side='right'), N_EXPERTS - 1)
    h_pad = jnp.concatenate([h, jnp.zeros((1, D), h.dtype)], axis=0)
    xs = h_pad[row_tok].reshape(n_blocks, MOE_BLOCK, D)

    def expert_block(args):
        xb, e = args
        gu = xb @ w_gate_up[e] + b_gate_up[e]
        gate = jnp.minimum(gu[:, 0::2], SWIGLU_LIMIT)
        up = jnp.clip(gu[:, 1::2], -SWIGLU_LIMIT, SWIGLU_LIMIT)
        act = (up + 1.0) * (gate * jax.nn.sigmoid(gate * SWIGLU_ALPHA))
        return act @ w_down[e] + b_down[e]

    ys = lax.map(expert_block, (xs, block_expert))
    ys = ys.reshape(n_rows, D) * row_gate[:, None].astype(ys.dtype)
    out = jnp.zeros((T + 1, D), ys.dtype).at[row_tok].add(ys)[:T]
    return out.reshape(B, S, D)


def setup_inputs(seed: int = 0) -> dict:
    key = jax.random.key(seed)
    ks = jax.random.split(key, 20)
    f32 = jnp.float32
    D, F, E = D_MODEL, D_EXPERT, N_EXPERTS
    nrm = lambda k, shape: jax.random.normal(k, shape, f32)
    x = nrm(ks[0], (BATCH, SEQ, D))
    p = nrm(ks[1], (DEPTH, BATCH, SEQ, D_PLE))
    h_qk, h_v = RET_HEADS * RET_QK_DIM, RET_HEADS * RET_V_DIM
    ret_col_scale = jnp.concatenate([jnp.ones((2 * h_qk,), f32), jnp.full((h_v,), DN_BETA, f32), jnp.ones((h_v,), f32)])
    ret_w_in = nrm(ks[2], (N_RET_LAYERS, D, RET_IN_DIM)) * (D ** -0.5) * ret_col_scale
    ret_w_out = nrm(ks[3], (N_RET_LAYERS, h_v, D)) * (h_v ** -0.5) * DN_BETA
    sb_col_scale = jnp.concatenate([jnp.ones((2 * D,), f32), jnp.full((D,), DN_BETA, f32)])
    sb_w_in = nrm(ks[4], (N_SB_LAYERS, D, 3 * D)) * (D ** -0.5) * sb_col_scale
    sb_w_out = nrm(ks[5], (N_SB_LAYERS, D, D)) * (D ** -0.5) * DN_BETA
    ln1_g = 1.0 + 0.02 * nrm(ks[6], (DEPTH, D))
    ln1_b = 0.02 * nrm(ks[7], (DEPTH, D))
    router_w = nrm(ks[8], (DEPTH, D, E)) * (D ** -0.5)
    router_b = 0.01 * nrm(ks[9], (DEPTH, E))
    w_gate_up = nrm(ks[10], (DEPTH, E, D, 2 * F)) * (D ** -0.5)
    b_gate_up = 0.02 * nrm(ks[11], (DEPTH, E, 2 * F))
    w_down = nrm(ks[12], (DEPTH, E, F, D)) * (F ** -0.5) * DN_BETA
    b_down = 0.02 * nrm(ks[13], (DEPTH, E, D))
    ln2_g = 1.0 + 0.02 * nrm(ks[14], (DEPTH, D))
    ln2_b = 0.02 * nrm(ks[15], (DEPTH, D))
    ple_w = nrm(ks[16], (DEPTH, D_PLE, D)) * (D_PLE ** -0.5) * DN_BETA
    ple_gate_w = nrm(ks[17], (DEPTH, D, D)) * (D ** -0.5)
    ple_gate_b = 0.02 * nrm(ks[18], (DEPTH, D))
    return {'x': x, 'p': p, 'ret_w_in': ret_w_in, 'ret_w_out': ret_w_out,
            'sb_w_in': sb_w_in, 'sb_w_out': sb_w_out, 'ln1_g': ln1_g, 'ln1_b': ln1_b,
            'router_w': router_w, 'router_b': router_b, 'w_gate_up': w_gate_up,
            'b_gate_up': b_gate_up, 'w_down': w_down, 'b_down': b_down,
            'ln2_g': ln2_g, 'ln2_b': ln2_b, 'ple_w': ple_w, 'ple_gate_w': ple_gate_w,
            'ple_gate_b': ple_gate_b}


def reference(x, p, ret_w_in, ret_w_out, sb_w_in, sb_w_out, ln1_g, ln1_b, router_w, router_b,
              w_gate_up, b_gate_up, w_down, b_down, ln2_g, ln2_b, ple_w, ple_gate_w, ple_gate_b):
    for i in range(DEPTH):
        j = i // N_MIXERS
        if i % N_MIXERS == 0:
            mix = retention_mixer(x, ret_w_in[j], ret_w_out[j])
        else:
            mix = stick_breaking_mixer(x, sb_w_in[j], sb_w_out[j])
        x = layer_norm(DN_ALPHA * x + mix, ln1_g[i], ln1_b[i])
        ffn = moe_channel_mixer(x, router_w[i], router_b[i], w_gate_up[i], b_gate_up[i],
                                w_down[i], b_down[i])
        x = layer_norm(DN_ALPHA * x + ffn, ln2_g[i], ln2_b[i])
        ple_gate = jax.nn.sigmoid(x @ ple_gate_w[i] + ple_gate_b[i])
        x = x + ple_gate * (p[i] @ ple_w[i])
    return x
```

```cpp
#include <hip/hip_runtime.h>
#include <stdint.h>
#include <cstdio>

typedef unsigned short bf16_t;
typedef short bf16x8 __attribute__((ext_vector_type(8)));
typedef float f32x4 __attribute__((ext_vector_type(4)));
typedef unsigned u32x4 __attribute__((ext_vector_type(4)));
typedef unsigned u32x2 __attribute__((ext_vector_type(2)));

constexpr int DM = 1024, NB = 8, SEQ = 2048, DEPTH = 4, T = NB * SEQ;
constexpr int RH = 4, RDK = 256, RDV = 512, RIN = 6144, RHV = RH * RDV;
constexpr int SH = 16, SD = 64;
constexpr int NE = 32, TOPK = 4, DF = 1024, DPLE = 256;
constexpr int NSLOT = T * TOPK;
constexpr int RPAD = NSLOT + NE * 256;
constexpr float DN_ALPHA = 1.6817928305074290f;
constexpr float LN_EPS = 1e-5f, GN_EPS = 1e-6f;

constexpr size_t MiB = (size_t)1 << 20;
constexpr size_t al(size_t x) { return (x + 255) & ~(size_t)255; }
constexpr size_t OFF_CTL = 0;
constexpr size_t OFF_WRI = OFF_CTL + MiB;
constexpr size_t OFF_WRO = OFF_WRI + al((size_t)2 * RIN * DM * 2);
constexpr size_t OFF_WSI = OFF_WRO + al((size_t)2 * DM * RHV * 2);
constexpr size_t OFF_WSO = OFF_WSI + al((size_t)2 * 3 * DM * DM * 2);
constexpr size_t OFF_WPG = OFF_WSO + al((size_t)2 * DM * DM * 2);
constexpr size_t OFF_WPW = OFF_WPG + al((size_t)4 * DM * DM * 2);
constexpr size_t OFF_WGU = OFF_WPW + al((size_t)4 * DM * DPLE * 2);
constexpr size_t OFF_WDN = OFF_WGU + al((size_t)128 * 2 * DF * DM * 2);
constexpr size_t OFF_PB  = OFF_WDN + al((size_t)128 * DM * DF * 2);
constexpr size_t OFF_XF  = OFF_PB  + al((size_t)4 * T * DPLE * 2);
constexpr size_t OFF_XB  = OFF_XF  + al((size_t)T * DM * 4);
constexpr size_t OFF_X1F = OFF_XB  + al((size_t)T * DM * 2);
constexpr size_t OFF_X1B = OFF_X1F + al((size_t)T * DM * 4);
constexpr size_t OFF_X2F = OFF_X1B + al((size_t)T * DM * 2);
constexpr size_t OFF_X2B = OFF_X2F + al((size_t)T * DM * 4);
constexpr size_t OFF_MIX = OFF_X2B + al((size_t)T * DM * 2);
constexpr size_t OFF_Q   = OFF_MIX + al((size_t)T * DM * 4);
constexpr size_t OFF_K   = OFF_Q   + al((size_t)T * DM * 2);
constexpr size_t OFF_V   = OFF_K   + al((size_t)T * DM * 2);
constexpr size_t OFF_G   = OFF_V   + al((size_t)T * RHV * 2);
constexpr size_t OFF_RO  = OFF_G   + al((size_t)T * RHV * 2);
constexpr size_t OFF_GN  = OFF_RO  + al((size_t)T * RHV * 4);
constexpr size_t OFF_ACT = OFF_GN  + al((size_t)T * RHV * 2);
constexpr size_t OFF_YB  = OFF_ACT + al((size_t)RPAD * DF * 2);
constexpr size_t OFF_PP  = OFF_YB  + al((size_t)NSLOT * DM * 2);
constexpr size_t OFF_GG  = OFF_PP  + al((size_t)T * DM * 4);
constexpr size_t OFF_EL  = OFF_GG  + al((size_t)T * DM * 4);
constexpr size_t OFF_GT  = OFF_EL  + al((size_t)NE * T * 4);
constexpr size_t OFF_ROPE= OFF_GT  + al((size_t)NSLOT * 4);
constexpr size_t OFF_PROJ= OFF_ROPE+ al((size_t)SEQ * 128 * 2 * 4);
constexpr size_t WS_END  = OFF_PROJ+ al((size_t)T * RIN * 4);
constexpr int CW_CNT = 64;

__device__ __forceinline__ unsigned f2bf(float f) { unsigned u = __float_as_uint(f); return (u + 0x7fffu + ((u >> 16) & 1u)) >> 16; }
__device__ __forceinline__ unsigned pk2(float lo, float hi) { return f2bf(lo) | (f2bf(hi) << 16); }
__device__ __forceinline__ float bf2f(unsigned b) { return __uint_as_float(b << 16); }
__device__ __forceinline__ float wave_sum(float v) {
#pragma unroll
    for (int o = 1; o < 64; o <<= 1) v += __shfl_xor(v, o);
    return v;
}
__device__ __forceinline__ float sigmoidf_(float x) { return 1.0f / (1.0f + __expf(-x)); }

__global__ __launch_bounds__(256) void k_transpose(const float* __restrict__ W, bf16_t* __restrict__ WT, int nb, int K, int N) {
    __shared__ float scr_all[4][64 * 33];
    const int lane = threadIdx.x & 63, wave = threadIdx.x >> 6;
    float* scr = scr_all[wave];
    const int nblk = N / 32, per = (K / 64) * nblk;
    const long total = (long)nb * per;
    for (long it = (long)blockIdx.x * 4 + wave; it < total; it += (long)gridDim.x * 4) {
        const int mb = (int)(it / per), item = (int)(it % per);
        const float* Wm = W + (size_t)mb * K * N; bf16_t* WTm = WT + (size_t)mb * K * N;
        const int kb = item / nblk, nbk = item % nblk, k0 = 64 * kb, n0 = 32 * nbk;
#pragma unroll 8
        for (int i = 0; i < 32; ++i) { const int kk = 2 * i + (lane >> 5); scr[kk * 33 + (lane & 31)] = Wm[(size_t)(k0 + kk) * N + n0 + (lane & 31)]; }
        __builtin_amdgcn_s_waitcnt(0); __builtin_amdgcn_wave_barrier();
        const int c = lane & 7;
#pragma unroll
        for (int j = 0; j < 4; ++j) { const int n = (lane >> 3) + 8 * j; const float* s = scr + (8 * c) * 33 + n;
            u32x4 o; o.x = pk2(s[0 * 33], s[1 * 33]); o.y = pk2(s[2 * 33], s[3 * 33]); o.z = pk2(s[4 * 33], s[5 * 33]); o.w = pk2(s[6 * 33], s[7 * 33]);
            *(u32x4*)(WTm + (size_t)(n0 + n) * K + k0 + 8 * c) = o; }
        __builtin_amdgcn_s_waitcnt(0); __builtin_amdgcn_wave_barrier();
    }
}
__global__ __launch_bounds__(256) void k_cvt(const float* __restrict__ src, bf16_t* __restrict__ dstb, float* __restrict__ dstf, size_t n4) {
    for (size_t i = (size_t)blockIdx.x * 256 + threadIdx.x; i < n4; i += (size_t)gridDim.x * 256) {
        const f32x4 v = ((const f32x4*)src)[i];
        u32x2 o; o.x = pk2(v.x, v.y); o.y = pk2(v.z, v.w);
        ((u32x2*)dstb)[i] = o;
        if (dstf) ((f32x4*)dstf)[i] = v;
    }
}
__global__ __launch_bounds__(256) void k_rope_table(float* __restrict__ rope) {
    const int i = blockIdx.x * 256 + threadIdx.x;
    if (i >= SEQ * 128) return;
    const int pos = i >> 7, d = i & 127;
    const float invf = 1.0f / powf(10000.0f, (float)d / 128.0f);
    const float ang = (float)pos * invf;
    rope[2 * i] = (float)cos((double)ang); rope[2 * i + 1] = (float)sin((double)ang);
}

struct GArgs {
    const bf16_t* A; const bf16_t* Bt; float* C;
    const unsigned* cnt; const int* elist; const float* bias; bf16_t* O;
    int M, N, K, ldc;
};
template <int MODE>
__global__ __launch_bounds__(256) void k_gemm(GArgs g) {
    __shared__ int padoff[NE + 1];
    const int tid = threadIdx.x, lane = tid & 63, wave = tid >> 6, wr = wave >> 1, wc = wave & 1;
    const int r0 = blockIdx.y * 64, c0 = blockIdx.x * 64;
    int e = 0, lrow0 = 0, ecnt = 0;
    if (MODE != 0) {
        if (tid == 0) { int a = 0; for (int i = 0; i < NE; ++i) { padoff[i] = a; a += ((int)g.cnt[i] + 255) & ~255; } padoff[NE] = a; }
        __syncthreads();
        if (r0 >= padoff[NE]) return;
        while (r0 >= padoff[e + 1]) ++e;
        lrow0 = r0 - padoff[e]; ecnt = (int)g.cnt[e];
    }
    const int K = g.K;
    const bf16_t* Bt = g.Bt + (MODE != 0 ? (size_t)e * g.N * K : (size_t)0);
    const bf16_t* ap[2];
#pragma unroll
    for (int mi = 0; mi < 2; ++mi) {
        const int rr = wr * 32 + mi * 16 + (lane & 15);
        if (MODE == 1) { const int lr = lrow0 + rr; const int slot = lr < ecnt ? g.elist[(size_t)e * T + lr] : 0; ap[mi] = g.A + (size_t)(slot >> 2) * K; }
        else ap[mi] = g.A + (size_t)(r0 + rr) * K;
    }
    const bf16_t* bp[2];
#pragma unroll
    for (int ni = 0; ni < 2; ++ni) bp[ni] = Bt + (size_t)(c0 + wc * 32 + ni * 16 + (lane & 15)) * K;
    const int ko = 8 * (lane >> 4);
    f32x4 acc[2][2];
#pragma unroll
    for (int mi = 0; mi < 2; ++mi)
#pragma unroll
        for (int ni = 0; ni < 2; ++ni) acc[mi][ni] = (f32x4){0.f, 0.f, 0.f, 0.f};
    for (int k0 = 0; k0 < K; k0 += 32) {
        bf16x8 a[2], b[2];
#pragma unroll
        for (int mi = 0; mi < 2; ++mi) a[mi] = *(const bf16x8*)(ap[mi] + k0 + ko);
#pragma unroll
        for (int ni = 0; ni < 2; ++ni) b[ni] = *(const bf16x8*)(bp[ni] + k0 + ko);
#pragma unroll
        for (int mi = 0; mi < 2; ++mi)
#pragma unroll
            for (int ni = 0; ni < 2; ++ni) acc[mi][ni] = __builtin_amdgcn_mfma_f32_16x16x32_bf16(a[mi], b[ni], acc[mi][ni], 0, 0, 0);
    }
#pragma unroll
    for (int mi = 0; mi < 2; ++mi)
#pragma unroll
        for (int ni = 0; ni < 2; ++ni)
#pragma unroll
            for (int j = 0; j < 4; ++j) {
                const int rr = wr * 32 + mi * 16 + (lane >> 4) * 4 + j, col = c0 + wc * 32 + ni * 16 + (lane & 15);
                float v = acc[mi][ni][j];
                if (MODE == 0) { g.C[(size_t)(r0 + rr) * g.ldc + col] = v; }
                if (MODE == 1) {
                    v += g.bias[(size_t)e * 2 * DF + col];
                    const float other = __shfl_xor(v, 1);
                    if (!(lane & 1) && (lrow0 + rr) < ecnt) {
                        const float gate = fminf(v, 7.0f), up = fminf(fmaxf(other, -7.0f), 7.0f);
                        const float act = (up + 1.0f) * (gate * sigmoidf_(gate * 1.702f));
                        g.O[(size_t)(r0 + rr) * DF + (col >> 1)] = (bf16_t)f2bf(act);
                    }
                }
                if (MODE == 2) {
                    if ((lrow0 + rr) < ecnt) {
                        const int slot = g.elist[(size_t)e * T + lrow0 + rr];
                        g.O[(size_t)slot * DM + col] = (bf16_t)f2bf(v + g.bias[(size_t)e * DM + col]);
                    }
                }
            }
}

__global__ __launch_bounds__(256) void k_ret_post(const float* __restrict__ proj, const float* __restrict__ rope, bf16_t* __restrict__ q, bf16_t* __restrict__ k, bf16_t* __restrict__ v, bf16_t* __restrict__ g) {
    const int t = blockIdx.x, tid = threadIdx.x, pos = t & (SEQ - 1);
    const float* pr = proj + (size_t)t * RIN;
    for (int i = tid; i < 512; i += 256) {
        const int h = i >> 7, d = i & 127;
        const float c = rope[(pos * 128 + d) * 2], s = rope[(pos * 128 + d) * 2 + 1];
        { const float x1 = pr[h * 256 + d], x2 = pr[h * 256 + d + 128];
          q[(size_t)t * DM + h * 256 + d] = (bf16_t)f2bf(x1 * c - x2 * s); q[(size_t)t * DM + h * 256 + d + 128] = (bf16_t)f2bf(x1 * s + x2 * c); }
        { const float x1 = pr[1024 + h * 256 + d], x2 = pr[1024 + h * 256 + d + 128];
          k[(size_t)t * DM + h * 256 + d] = (bf16_t)f2bf((x1 * c - x2 * s) * 0.0625f); k[(size_t)t * DM + h * 256 + d + 128] = (bf16_t)f2bf((x1 * s + x2 * c) * 0.0625f); }
    }
    for (int i = tid; i < RHV; i += 256) { v[(size_t)t * RHV + i] = (bf16_t)f2bf(pr[2048 + i]); g[(size_t)t * RHV + i] = (bf16_t)f2bf(pr[4096 + i]); }
}
__global__ __launch_bounds__(256) void k_ret_naive(const bf16_t* __restrict__ q, const bf16_t* __restrict__ k, const bf16_t* __restrict__ v, float* __restrict__ ro) {
    __shared__ unsigned Ks[64][129];
    __shared__ float St[64][68];
    const int bid = blockIdx.x, ci = bid & 31, h = (bid >> 5) & 3, b = bid >> 7, tid = threadIdx.x;
    const float lgam = log1pf(-exp2f(-5.0f - (float)h));
    float acc0[64], acc1[64];
#pragma unroll
    for (int i = 0; i < 64; ++i) { acc0[i] = 0.f; acc1[i] = 0.f; }
    const int tq = tid >> 2, sub = tid & 3;
    const unsigned* qrow = (const unsigned*)(q + (size_t)(b * SEQ + ci * 64 + tq) * DM + h * 256);
    for (int cj = 0; cj <= ci; ++cj) {
        __syncthreads();
        for (int i = tid; i < 64 * 128; i += 256) { const int r = i >> 7, c = i & 127; Ks[r][c] = ((const unsigned*)(k + (size_t)(b * SEQ + cj * 64 + r) * DM + h * 256))[c]; }
        __syncthreads();
        for (int n = 0; n < 16; ++n) {
            const int sk = sub + 4 * n; float s = 0.f;
            for (int d2 = 0; d2 < 128; ++d2) { const unsigned qa = qrow[d2], ka = Ks[sk][d2]; s += bf2f(qa & 0xffffu) * bf2f(ka & 0xffffu) + bf2f(qa >> 16) * bf2f(ka >> 16); }
            const float dist = fabsf((float)(ci * 64 + tq) - (float)(cj * 64 + sk));
            St[sk][tq] = s * __expf(lgam * dist);
        }
        __syncthreads();
        for (int sk = 0; sk < 64; ++sk) {
            const bf16_t* vr = v + (size_t)(b * SEQ + cj * 64 + sk) * RHV + h * RDV;
            const float v0 = bf2f(vr[tid]), v1 = bf2f(vr[tid + 256]);
#pragma unroll
            for (int t4 = 0; t4 < 16; ++t4) { const f32x4 s4 = *(const f32x4*)&St[sk][t4 * 4];
                acc0[t4 * 4 + 0] += s4.x * v0; acc0[t4 * 4 + 1] += s4.y * v0; acc0[t4 * 4 + 2] += s4.z * v0; acc0[t4 * 4 + 3] += s4.w * v0;
                acc1[t4 * 4 + 0] += s4.x * v1; acc1[t4 * 4 + 1] += s4.y * v1; acc1[t4 * 4 + 2] += s4.z * v1; acc1[t4 * 4 + 3] += s4.w * v1; }
        }
    }
#pragma unroll
    for (int i = 0; i < 64; ++i) { float* o = ro + (size_t)(b * SEQ + ci * 64 + i) * RHV + h * RDV; o[tid] = acc0[i]; o[tid + 256] = acc1[i]; }
}
__global__ __launch_bounds__(256) void k_ret_gate(const float* __restrict__ ro, const bf16_t* __restrict__ g, bf16_t* __restrict__ gn) {
    const int w = blockIdx.x * 4 + (threadIdx.x >> 6), lane = threadIdx.x & 63;
    const float* r = ro + (size_t)w * RDV; const bf16_t* gg = g + (size_t)w * RDV; bf16_t* o = gn + (size_t)w * RDV;
    float x[8]; float s = 0.f;
#pragma unroll
    for (int j = 0; j < 8; ++j) { x[j] = r[lane + 64 * j]; s += x[j]; }
    const float mean = wave_sum(s) * (1.0f / RDV); float s2 = 0.f;
#pragma unroll
    for (int j = 0; j < 8; ++j) { x[j] -= mean; s2 += x[j] * x[j]; }
    const float rstd = 1.0f / sqrtf(wave_sum(s2) * (1.0f / RDV) + GN_EPS);
#pragma unroll
    for (int j = 0; j < 8; ++j) { const float gv = bf2f(gg[lane + 64 * j]); o[lane + 64 * j] = (bf16_t)f2bf(gv * sigmoidf_(gv) * (x[j] * rstd)); }
}

__global__ __launch_bounds__(256) void k_sb_post(const float* __restrict__ proj, bf16_t* __restrict__ q, bf16_t* __restrict__ k, bf16_t* __restrict__ v) {
    const int t = blockIdx.x, tid = threadIdx.x; const float* pr = proj + (size_t)t * 3 * DM;
    for (int i = tid; i < DM; i += 256) { q[(size_t)t * DM + i] = (bf16_t)f2bf(pr[i] * 0.125f); k[(size_t)t * DM + i] = (bf16_t)f2bf(pr[DM + i]); v[(size_t)t * DM + i] = (bf16_t)f2bf(pr[2 * DM + i]); }
}
__global__ __launch_bounds__(256) void k_sb_naive(const bf16_t* __restrict__ q, const bf16_t* __restrict__ k, const bf16_t* __restrict__ v, bf16_t* __restrict__ o) {
    const int bid = blockIdx.x, qb = bid & 7, h = (bid >> 3) & 15, b = bid >> 7;
    const int wave = __builtin_amdgcn_readfirstlane(threadIdx.x >> 6), lane = threadIdx.x & 63;
    const int t0 = qb * 256 + wave * 64, t = t0 + lane;
    float qf[64], of[64];
    { const unsigned* qr = (const unsigned*)(q + (size_t)(b * SEQ + t) * DM + h * SD);
#pragma unroll
      for (int d2 = 0; d2 < 32; ++d2) { const unsigned w = qr[d2]; qf[2 * d2] = bf2f(w & 0xffffu); qf[2 * d2 + 1] = bf2f(w >> 16); } }
#pragma unroll
    for (int d = 0; d < 64; ++d) of[d] = 0.f;
    float run = 1.0f;
    for (int s = t0 + 62; s >= 0; --s) {
        if (s < t0 && __all(run == 0.0f)) break;
        const u32x4* kr = (const u32x4*)(k + (size_t)(b * SEQ + s) * DM + h * SD);
        const u32x4* vr = (const u32x4*)(v + (size_t)(b * SEQ + s) * DM + h * SD);
        float z = 0.f;
#pragma unroll
        for (int c = 0; c < 8; ++c) { const u32x4 kk = kr[c];
            z += qf[8 * c + 0] * bf2f(kk.x & 0xffffu) + qf[8 * c + 1] * bf2f(kk.x >> 16) + qf[8 * c + 2] * bf2f(kk.y & 0xffffu) + qf[8 * c + 3] * bf2f(kk.y >> 16)
               + qf[8 * c + 4] * bf2f(kk.z & 0xffffu) + qf[8 * c + 5] * bf2f(kk.z >> 16) + qf[8 * c + 6] * bf2f(kk.w & 0xffffu) + qf[8 * c + 7] * bf2f(kk.w >> 16); }
        const float ez = __expf(-fabsf(z)), inv = 1.0f / (1.0f + ez);
        const float beta = z >= 0.f ? inv : ez * inv, omb = z >= 0.f ? ez * inv : inv;
        const bool act = s < t;
        const float a = act ? beta * run : 0.f;
        run = act ? run * omb : run;
#pragma unroll
        for (int c = 0; c < 8; ++c) { const u32x4 vv = vr[c];
            of[8 * c + 0] += a * bf2f(vv.x & 0xffffu); of[8 * c + 1] += a * bf2f(vv.x >> 16); of[8 * c + 2] += a * bf2f(vv.y & 0xffffu); of[8 * c + 3] += a * bf2f(vv.y >> 16);
            of[8 * c + 4] += a * bf2f(vv.z & 0xffffu); of[8 * c + 5] += a * bf2f(vv.z >> 16); of[8 * c + 6] += a * bf2f(vv.w & 0xffffu); of[8 * c + 7] += a * bf2f(vv.w >> 16); }
    }
    unsigned* orow = (unsigned*)(o + (size_t)(b * SEQ + t) * DM + h * SD);
#pragma unroll
    for (int d2 = 0; d2 < 32; ++d2) orow[d2] = pk2(of[2 * d2], of[2 * d2 + 1]);
}

__global__ __launch_bounds__(256) void k_ln1_router(const float* __restrict__ xf, const float* __restrict__ mix, const float* __restrict__ lg, const float* __restrict__ lb,
                                                    const float* __restrict__ rw, const float* __restrict__ rb, float* __restrict__ x1f, bf16_t* __restrict__ x1b,
                                                    unsigned* __restrict__ cnt, int* __restrict__ elist, float* __restrict__ gates) {
    __shared__ float xs_all[4][DM];
    const int wave = threadIdx.x >> 6, lane = threadIdx.x & 63, t = blockIdx.x * 4 + wave;
    float* xs = xs_all[wave];
    f32x4 y[4]; float s = 0.f;
#pragma unroll
    for (int j = 0; j < 4; ++j) { const int c = 4 * lane + 256 * j; const f32x4 a = *(const f32x4*)(xf + (size_t)t * DM + c), m = *(const f32x4*)(mix + (size_t)t * DM + c);
        y[j] = a * DN_ALPHA + m; s += (y[j].x + y[j].y) + (y[j].z + y[j].w); }
    const float mean = wave_sum(s) * (1.0f / DM); float s2 = 0.f;
#pragma unroll
    for (int j = 0; j < 4; ++j) { y[j] = y[j] - mean; s2 += (y[j].x * y[j].x + y[j].y * y[j].y) + (y[j].z * y[j].z + y[j].w * y[j].w); }
    const float rstd = 1.0f / sqrtf(wave_sum(s2) * (1.0f / DM) + LN_EPS);
#pragma unroll
    for (int j = 0; j < 4; ++j) { const int c = 4 * lane + 256 * j; const f32x4 gv = *(const f32x4*)(lg + c), bv = *(const f32x4*)(lb + c);
        const f32x4 o = y[j] * rstd * gv + bv;
        *(f32x4*)(x1f + (size_t)t * DM + c) = o; u32x2 pb; pb.x = pk2(o.x, o.y); pb.y = pk2(o.z, o.w); *(u32x2*)(x1b + (size_t)t * DM + c) = pb;
        *(f32x4*)(xs + c) = o; }
    __builtin_amdgcn_s_waitcnt(0); __builtin_amdgcn_wave_barrier();
    const int e = lane & 31, half = lane >> 5; float p = 0.f;
    for (int d = 0; d < 512; ++d) { const int c = half * 512 + d; p += xs[c] * rw[c * NE + e]; }
    p += __shfl_xor(p, 32);
    float vcur = p + rb[e];
    float topv[4]; int topi[4];
#pragma unroll
    for (int kk = 0; kk < 4; ++kk) {
        float bv = vcur; int bi = e;
#pragma unroll
        for (int off = 1; off < 32; off <<= 1) { const float ov = __shfl_xor(bv, off); const int oi = __shfl_xor(bi, off); if (ov > bv || (ov == bv && oi < bi)) { bv = ov; bi = oi; } }
        topv[kk] = bv; topi[kk] = bi; if (e == bi) vcur = -INFINITY;
    }
    const float e1 = __expf(topv[1] - topv[0]), e2 = __expf(topv[2] - topv[0]), e3 = __expf(topv[3] - topv[0]);
    const float inv = 1.0f / (1.0f + e1 + e2 + e3);
    if (lane < 4) {
        const int ee = lane == 0 ? topi[0] : lane == 1 ? topi[1] : lane == 2 ? topi[2] : topi[3];
        const float gg = (lane == 0 ? 1.0f : lane == 1 ? e1 : lane == 2 ? e2 : e3) * inv;
        const unsigned pos = atomicAdd(cnt + ee, 1u);
        elist[(size_t)ee * T + pos] = t * 4 + lane; gates[t * 4 + lane] = gg;
    }
}
__global__ __launch_bounds__(256) void k_ln2(const float* __restrict__ x1f, const bf16_t* __restrict__ yb, const float* __restrict__ gates, const float* __restrict__ lg, const float* __restrict__ lb,
                                             float* __restrict__ x2f, bf16_t* __restrict__ x2b) {
    const int wave = threadIdx.x >> 6, lane = threadIdx.x & 63, t = blockIdx.x * 4 + wave;
    const float g0 = gates[t * 4], g1 = gates[t * 4 + 1], g2 = gates[t * 4 + 2], g3 = gates[t * 4 + 3];
    f32x4 y[4]; float s = 0.f;
#pragma unroll
    for (int j = 0; j < 4; ++j) { const int c = 4 * lane + 256 * j; const f32x4 a = *(const f32x4*)(x1f + (size_t)t * DM + c);
        f32x4 f = (f32x4){0.f, 0.f, 0.f, 0.f};
#pragma unroll
        for (int kk = 0; kk < 4; ++kk) { const u32x2 w = *(const u32x2*)(yb + (size_t)(t * 4 + kk) * DM + c); const float gk = kk == 0 ? g0 : kk == 1 ? g1 : kk == 2 ? g2 : g3;
            f.x += gk * bf2f(w.x & 0xffffu); f.y += gk * bf2f(w.x >> 16); f.z += gk * bf2f(w.y & 0xffffu); f.w += gk * bf2f(w.y >> 16); }
        y[j] = a * DN_ALPHA + f; s += (y[j].x + y[j].y) + (y[j].z + y[j].w); }
    const float mean = wave_sum(s) * (1.0f / DM); float s2 = 0.f;
#pragma unroll
    for (int j = 0; j < 4; ++j) { y[j] = y[j] - mean; s2 += (y[j].x * y[j].x + y[j].y * y[j].y) + (y[j].z * y[j].z + y[j].w * y[j].w); }
    const float rstd = 1.0f / sqrtf(wave_sum(s2) * (1.0f / DM) + LN_EPS);
#pragma unroll
    for (int j = 0; j < 4; ++j) { const int c = 4 * lane + 256 * j; const f32x4 gv = *(const f32x4*)(lg + c), bv = *(const f32x4*)(lb + c);
        const f32x4 o = y[j] * rstd * gv + bv;
        *(f32x4*)(x2f + (size_t)t * DM + c) = o; u32x2 pb; pb.x = pk2(o.x, o.y); pb.y = pk2(o.z, o.w); *(u32x2*)(x2b + (size_t)t * DM + c) = pb; }
}
__global__ __launch_bounds__(256) void k_ple_final(const float* __restrict__ x2f, const float* __restrict__ G, const float* __restrict__ bg, const float* __restrict__ PP,
                                                   float* __restrict__ xf, bf16_t* __restrict__ xb, float* __restrict__ out) {
    const size_t i = (size_t)blockIdx.x * 256 + threadIdx.x;
    const int c = (int)(i & 255) * 4;
    const f32x4 x = ((const f32x4*)x2f)[i], gq = ((const f32x4*)G)[i], b = *(const f32x4*)(bg + c), pp = ((const f32x4*)PP)[i];
    f32x4 o; o.x = x.x + sigmoidf_(gq.x + b.x) * pp.x; o.y = x.y + sigmoidf_(gq.y + b.y) * pp.y; o.z = x.z + sigmoidf_(gq.z + b.z) * pp.z; o.w = x.w + sigmoidf_(gq.w + b.w) * pp.w;
    ((f32x4*)xf)[i] = o; u32x2 pb; pb.x = pk2(o.x, o.y); pb.y = pk2(o.z, o.w); ((u32x2*)xb)[i] = pb;
    if (out) ((f32x4*)out)[i] = o;
}

extern "C" void kernel_launch(void* const* d_in, const int* in_sizes, int n_in, void* d_out, int out_size, void* d_ws, size_t ws_size, hipStream_t stream) {
    if (n_in != 19 || ws_size < WS_END || out_size != T * DM) { fprintf(stderr, "kernel_launch: unexpected arguments (n_in %d, ws %zu need %zu, out %d)\n", n_in, ws_size, (size_t)WS_END, out_size); return; }
    const float* x = (const float*)d_in[0]; const float* p = (const float*)d_in[1];
    const float* ret_w_in = (const float*)d_in[2]; const float* ret_w_out = (const float*)d_in[3];
    const float* sb_w_in = (const float*)d_in[4]; const float* sb_w_out = (const float*)d_in[5];
    const float* ln1_g = (const float*)d_in[6]; const float* ln1_b = (const float*)d_in[7];
    const float* router_w = (const float*)d_in[8]; const float* router_b = (const float*)d_in[9];
    const float* w_gate_up = (const float*)d_in[10]; const float* b_gate_up = (const float*)d_in[11];
    const float* w_down = (const float*)d_in[12]; const float* b_down = (const float*)d_in[13];
    const float* ln2_g = (const float*)d_in[14]; const float* ln2_b = (const float*)d_in[15];
    const float* ple_w = (const float*)d_in[16]; const float* ple_gate_w = (const float*)d_in[17]; const float* ple_gate_b = (const float*)d_in[18];
    unsigned char* ws = (unsigned char*)d_ws;
    unsigned* ctl = (unsigned*)(ws + OFF_CTL);
    bf16_t* WRI = (bf16_t*)(ws + OFF_WRI); bf16_t* WRO = (bf16_t*)(ws + OFF_WRO); bf16_t* WSI = (bf16_t*)(ws + OFF_WSI); bf16_t* WSO = (bf16_t*)(ws + OFF_WSO);
    bf16_t* WPG = (bf16_t*)(ws + OFF_WPG); bf16_t* WPW = (bf16_t*)(ws + OFF_WPW); bf16_t* WGU = (bf16_t*)(ws + OFF_WGU); bf16_t* WDN = (bf16_t*)(ws + OFF_WDN);
    bf16_t* PB = (bf16_t*)(ws + OFF_PB); float* XF = (float*)(ws + OFF_XF); bf16_t* XB = (bf16_t*)(ws + OFF_XB);
    float* X1F = (float*)(ws + OFF_X1F); bf16_t* X1B = (bf16_t*)(ws + OFF_X1B); float* X2F = (float*)(ws + OFF_X2F); bf16_t* X2B = (bf16_t*)(ws + OFF_X2B);
    float* MIX = (float*)(ws + OFF_MIX); bf16_t* Q = (bf16_t*)(ws + OFF_Q); bf16_t* Kb = (bf16_t*)(ws + OFF_K); bf16_t* V = (bf16_t*)(ws + OFF_V); bf16_t* G = (bf16_t*)(ws + OFF_G);
    float* RO = (float*)(ws + OFF_RO); bf16_t* GN = (bf16_t*)(ws + OFF_GN); bf16_t* ACT = (bf16_t*)(ws + OFF_ACT); bf16_t* YB = (bf16_t*)(ws + OFF_YB);
    float* PP = (float*)(ws + OFF_PP); float* GG = (float*)(ws + OFF_GG); int* EL = (int*)(ws + OFF_EL); float* GT = (float*)(ws + OFF_GT);
    float* ROPE = (float*)(ws + OFF_ROPE); float* PROJ = (float*)(ws + OFF_PROJ);

    hipMemsetAsync(ws + OFF_CTL, 0, MiB, stream);
    k_transpose<<<2048, 256, 0, stream>>>(ret_w_in, WRI, 2, DM, RIN);
    k_transpose<<<2048, 256, 0, stream>>>(ret_w_out, WRO, 2, RHV, DM);
    k_transpose<<<2048, 256, 0, stream>>>(sb_w_in, WSI, 2, DM, 3 * DM);
    k_transpose<<<2048, 256, 0, stream>>>(sb_w_out, WSO, 2, DM, DM);
    k_transpose<<<2048, 256, 0, stream>>>(ple_gate_w, WPG, 4, DM, DM);
    k_transpose<<<2048, 256, 0, stream>>>(ple_w, WPW, 4, DPLE, DM);
    k_transpose<<<4096, 256, 0, stream>>>(w_gate_up, WGU, 128, DM, 2 * DF);
    k_transpose<<<4096, 256, 0, stream>>>(w_down, WDN, 128, DF, DM);
    k_cvt<<<4096, 256, 0, stream>>>(x, XB, XF, (size_t)T * DM / 4);
    k_cvt<<<4096, 256, 0, stream>>>(p, PB, nullptr, (size_t)4 * T * DPLE / 4);
    k_rope_table<<<SEQ * 128 / 256, 256, 0, stream>>>(ROPE);

    for (int i = 0; i < DEPTH; ++i) {
        const int j = i >> 1;
        if ((i & 1) == 0) {
            GArgs g{}; g.A = XB; g.Bt = WRI + (size_t)j * RIN * DM; g.M = T; g.N = RIN; g.K = DM; g.C = PROJ; g.ldc = RIN;
            k_gemm<0><<<dim3(RIN / 64, T / 64), 256, 0, stream>>>(g);
            k_ret_post<<<T, 256, 0, stream>>>(PROJ, ROPE, Q, Kb, V, G);
            k_ret_naive<<<NB * RH * 32, 256, 0, stream>>>(Q, Kb, V, RO);
            k_ret_gate<<<T * RH / 4, 256, 0, stream>>>(RO, G, GN);
            GArgs o{}; o.A = GN; o.Bt = WRO + (size_t)j * DM * RHV; o.M = T; o.N = DM; o.K = RHV; o.C = MIX; o.ldc = DM;
            k_gemm<0><<<dim3(DM / 64, T / 64), 256, 0, stream>>>(o);
        } else {
            GArgs g{}; g.A = XB; g.Bt = WSI + (size_t)j * 3 * DM * DM; g.M = T; g.N = 3 * DM; g.K = DM; g.C = PROJ; g.ldc = 3 * DM;
            k_gemm<0><<<dim3(3 * DM / 64, T / 64), 256, 0, stream>>>(g);
            k_sb_post<<<T, 256, 0, stream>>>(PROJ, Q, Kb, V);
            k_sb_naive<<<NB * SH * (SEQ / 256), 256, 0, stream>>>(Q, Kb, V, GN);
            GArgs o{}; o.A = GN; o.Bt = WSO + (size_t)j * DM * DM; o.M = T; o.N = DM; o.K = DM; o.C = MIX; o.ldc = DM;
            k_gemm<0><<<dim3(DM / 64, T / 64), 256, 0, stream>>>(o);
        }
        unsigned* cnt = ctl + CW_CNT + i * 64;
        k_ln1_router<<<T / 4, 256, 0, stream>>>(XF, MIX, ln1_g + (size_t)i * DM, ln1_b + (size_t)i * DM, router_w + (size_t)i * DM * NE, router_b + (size_t)i * NE, X1F, X1B, cnt, EL, GT);
        { GArgs g{}; g.A = X1B; g.Bt = WGU + (size_t)i * NE * 2 * DF * DM; g.M = RPAD; g.N = 2 * DF; g.K = DM; g.cnt = cnt; g.elist = EL; g.bias = b_gate_up + (size_t)i * NE * 2 * DF; g.O = ACT;
          k_gemm<1><<<dim3(2 * DF / 64, RPAD / 64), 256, 0, stream>>>(g); }
        { GArgs g{}; g.A = ACT; g.Bt = WDN + (size_t)i * NE * DM * DF; g.M = RPAD; g.N = DM; g.K = DF; g.cnt = cnt; g.elist = EL; g.bias = b_down + (size_t)i * NE * DM; g.O = YB;
          k_gemm<2><<<dim3(DM / 64, RPAD / 64), 256, 0, stream>>>(g); }
        k_ln2<<<T / 4, 256, 0, stream>>>(X1F, YB, GT, ln2_g + (size_t)i * DM, ln2_b + (size_t)i * DM, X2F, X2B);
        { GArgs g{}; g.A = X2B; g.Bt = WPG + (size_t)i * DM * DM; g.M = T; g.N = DM; g.K = DM; g.C = GG; g.ldc = DM;
          k_gemm<0><<<dim3(DM / 64, T / 64), 256, 0, stream>>>(g); }
        { GArgs g{}; g.A = PB + (size_t)i * T * DPLE; g.Bt = WPW + (size_t)i * DM * DPLE; g.M = T; g.N = DM; g.K = DPLE; g.C = PP; g.ldc = DM;
          k_gemm<0><<<dim3(DM / 64, T / 64), 256, 0, stream>>>(g); }
        k_ple_final<<<T * DM / 4 / 256, 256, 0, stream>>>(X2F, GG, ple_gate_b + (size_t)i * DM, PP, XF, XB, i == DEPTH - 1 ? (float*)d_out : nullptr);
    }
}
```

```cpp
#include <hip/hip_runtime.h>
#include <stdint.h>
#include <cstdio>

typedef unsigned short bf16_t;
typedef short bf16x8 __attribute__((ext_vector_type(8)));
typedef float f32x4 __attribute__((ext_vector_type(4)));
typedef unsigned u32x4 __attribute__((ext_vector_type(4)));
typedef unsigned u32x2 __attribute__((ext_vector_type(2)));

constexpr int DM = 1024, NB = 8, SEQ = 2048, DEPTH = 4, T = NB * SEQ;
constexpr int RH = 4, RDK = 256, RDV = 512, RIN = 6144, RHV = RH * RDV;
constexpr int SH = 16, SD = 64;
constexpr int NE = 32, TOPK = 4, DF = 1024, DPLE = 256;
constexpr int NSLOT = T * TOPK;
constexpr int RPAD = NSLOT + NE * 256;
constexpr float DN_ALPHA = 1.6817928305074290f;
constexpr float LN_EPS = 1e-5f, GN_EPS = 1e-6f;

constexpr size_t MiB = (size_t)1 << 20;
constexpr size_t al(size_t x) { return (x + 255) & ~(size_t)255; }
constexpr size_t OFF_CTL = 0;
constexpr size_t OFF_WRI = OFF_CTL + MiB;
constexpr size_t OFF_WRO = OFF_WRI + al((size_t)2 * RIN * DM * 2);
constexpr size_t OFF_WSI = OFF_WRO + al((size_t)2 * DM * RHV * 2);
constexpr size_t OFF_WSO = OFF_WSI + al((size_t)2 * 3 * DM * DM * 2);
constexpr size_t OFF_WPG = OFF_WSO + al((size_t)2 * DM * DM * 2);
constexpr size_t OFF_WPW = OFF_WPG + al((size_t)4 * DM * DM * 2);
constexpr size_t OFF_WGU = OFF_WPW + al((size_t)4 * DM * DPLE * 2);
constexpr size_t OFF_WDN = OFF_WGU + al((size_t)128 * 2 * DF * DM * 2);
constexpr size_t OFF_PB  = OFF_WDN + al((size_t)128 * DM * DF * 2);
constexpr size_t OFF_XF  = OFF_PB  + al((size_t)4 * T * DPLE * 2);
constexpr size_t OFF_XB  = OFF_XF  + al((size_t)T * DM * 4);
constexpr size_t OFF_X1F = OFF_XB  + al((size_t)T * DM * 2);
constexpr size_t OFF_X1B = OFF_X1F + al((size_t)T * DM * 4);
constexpr size_t OFF_X2F = OFF_X1B + al((size_t)T * DM * 2);
constexpr size_t OFF_X2B = OFF_X2F + al((size_t)T * DM * 4);
constexpr size_t OFF_MIX = OFF_X2B + al((size_t)T * DM * 2);
constexpr size_t OFF_Q   = OFF_MIX + al((size_t)T * DM * 4);
constexpr size_t OFF_K   = OFF_Q   + al((size_t)T * DM * 2);
constexpr size_t OFF_V   = OFF_K   + al((size_t)T * DM * 2);
constexpr size_t OFF_G   = OFF_V   + al((size_t)T * RHV * 2);
constexpr size_t OFF_RO  = OFF_G   + al((size_t)T * RHV * 2);
constexpr size_t OFF_GN  = OFF_RO  + al((size_t)T * RHV * 4);
constexpr size_t OFF_ACT = OFF_GN  + al((size_t)T * RHV * 2);
constexpr size_t OFF_YB  = OFF_ACT + al((size_t)RPAD * DF * 2);
constexpr size_t OFF_PPB = OFF_YB  + al((size_t)NSLOT * DM * 2);
constexpr size_t OFF_EL  = OFF_PPB + al((size_t)4 * T * DM * 2);
constexpr size_t OFF_GT  = OFF_EL  + al((size_t)NE * T * 4);
constexpr size_t OFF_ROPE= OFF_GT  + al((size_t)NSLOT * 4);
constexpr size_t OFF_PROJ= OFF_ROPE+ al((size_t)SEQ * 128 * 2 * 4);
constexpr size_t WS_END  = OFF_PROJ+ al((size_t)T * RIN * 4);
constexpr int CW_CNT = 64;

__device__ __forceinline__ unsigned f2bf(float f) { unsigned u = __float_as_uint(f); return (u + 0x7fffu + ((u >> 16) & 1u)) >> 16; }
__device__ __forceinline__ unsigned pk2(float lo, float hi) { return f2bf(lo) | (f2bf(hi) << 16); }
__device__ __forceinline__ float bf2f(unsigned b) { return __uint_as_float(b << 16); }
__device__ __forceinline__ float wave_sum(float v) {
#pragma unroll
    for (int o = 1; o < 64; o <<= 1) v += __shfl_xor(v, o);
    return v;
}
__device__ __forceinline__ float sigmoidf_(float x) { return 1.0f / (1.0f + __expf(-x)); }

#define LAS __attribute__((address_space(3)))
#define GAS __attribute__((address_space(1)))
namespace pg8 {
constexpr int BM = 256, BK = 64, HALF = 128, HTB = HALF * BK * 2  , STAGE_BYTES = 8 * HTB, NXCD = 8, WGM = 8;
__host__ __device__ __forceinline__ int lds_byte(int r, int c) { const int st = (r >> 4) * 2 + (c >> 5), rr = r & 15, cc = c & 31, ob = rr * 64 + cc * 2; return st * 1024 + (ob ^ (((ob >> 9) & 1) << 5)); }
__host__ __device__ __forceinline__ void stage_rc(int b, int& R, int& C) { const int st = b / 1024, sb = b % 1024, swz = sb ^ (((sb >> 9) & 1) << 5); R = (st >> 1) * 16 + swz / 64; C = (st & 1) * 32 + (swz % 64) / 2; }
__host__ __device__ __forceinline__ int perm32(int rho) { const int n = rho >> 4, i = rho & 15; return 8 * (i >> 2) + 4 * n + (i & 3); }
struct Unit { int pm, pn, e, lrow0, nvalid; };
typedef float f32x2_t __attribute__((ext_vector_type(2))); typedef __bf16 bf16x2_t __attribute__((ext_vector_type(2)));
__device__ __forceinline__ unsigned cvt_pk_bf16(float lo, float hi) { f32x2_t v = {lo, hi}; bf16x2_t b = __builtin_convertvector(v, bf16x2_t); return __builtin_bit_cast(unsigned, b); }

struct DenseOrder {
    int nM, nN, nwg, G, c; const char* A; const char* Bt; size_t tstep;
    __device__ void init(int M, int N, int K, int G_, int c_, const void* A_, const void* Bt_) { nM = M / BM; nN = N / BM; nwg = nM * nN; G = G_; c = c_; A = (const char*)A_; Bt = (const char*)Bt_; tstep = (size_t)BM * K * 2; }
    __device__ bool next(int i, Unit& u) const {
        const long L = (long)i * G + c; if (L >= nwg) return false;
        int wgid = (int)L; { const int q = nwg / NXCD, r = nwg % NXCD, xcd = wgid % NXCD, off = wgid / NXCD; wgid = (xcd < r ? xcd * (q + 1) : r * (q + 1) + (xcd - r) * q) + off; }
        const int nig = WGM * nN, gid = wgid / nig, fm = gid * WGM, gsz = (nM - fm) < WGM ? (nM - fm) : WGM;
        u.pm = fm + ((wgid % nig) % gsz); u.pn = (wgid % nig) / gsz; u.e = 0; u.lrow0 = 0; u.nvalid = BM; return true;
    }
    __device__ __forceinline__ const char* a_base(const Unit& u) const { return A + (size_t)u.pm * tstep; }
    __device__ __forceinline__ const char* b_base(const Unit& u) const { return Bt + (size_t)u.pn * tstep; }
    __device__ __forceinline__ unsigned a_row(const Unit&, int) const { return 0u; }
    LAS unsigned* roff;
};
struct EpiF32 {
    static constexpr bool PERM = false;
    float* C; int ldc;
    __device__ __forceinline__ void operator()(const f32x4 (&acc)[2][2][4][2], const Unit& u, int wr, int wc, int fr, int fq) const {
        const int row0 = u.pm * BM + wr * 64 + fr, col0 = u.pn * BM + wc * 32 + 4 * fq;
#pragma unroll
        for (int ai = 0; ai < 2; ++ai)
#pragma unroll
            for (int m = 0; m < 4; ++m) { float* rowp = C + (size_t)(row0 + ai * HALF + m * 16) * ldc + col0;
#pragma unroll
                for (int bj = 0; bj < 2; ++bj)
#pragma unroll
                    for (int n = 0; n < 2; ++n) *(f32x4*)(rowp + bj * HALF + n * 16) = acc[ai][bj][m][n]; }
    }
};
struct EpiBf16 {
    static constexpr bool PERM = true;
    bf16_t* O; int ldc; int split_cols; size_t split_stride; float scale0; size_t estride;
    __device__ __forceinline__ void operator()(const f32x4 (&acc)[2][2][4][2], const Unit& u, int wr, int wc, int fr, int fq) const {
        const int row0 = u.pm * BM + wr * 64 + fr; int colt = u.pn * BM; bf16_t* base = O + (size_t)u.e * estride;
        float sc = 1.f; if (split_cols) { const int t = colt / split_cols; base += (size_t)t * split_stride; colt -= t * split_cols; if (t == 0) sc = scale0; }
        const int col0 = colt + wc * 32 + 8 * fq;
#pragma unroll
        for (int ai = 0; ai < 2; ++ai)
#pragma unroll
            for (int m = 0; m < 4; ++m) { bf16_t* rowp = base + (size_t)(row0 + ai * HALF + m * 16) * ldc + col0;
#pragma unroll
                for (int bj = 0; bj < 2; ++bj) { const f32x4 v0 = acc[ai][bj][m][0] * sc, v1 = acc[ai][bj][m][1] * sc;
                    u32x4 w; w.x = cvt_pk_bf16(v0[0], v0[1]); w.y = cvt_pk_bf16(v0[2], v0[3]); w.z = cvt_pk_bf16(v1[0], v1[1]); w.w = cvt_pk_bf16(v1[2], v1[3]);
                    *(u32x4*)(rowp + bj * HALF) = w; } }
    }
};
struct EpiRetProj {
    static constexpr bool PERM = true;
    bf16_t *Q, *Kk, *V, *G; const float* rope;
    __device__ __forceinline__ void operator()(const f32x4 (&acc)[2][2][4][2], const Unit& u, int wr, int wc, int fr, int fq) const {
        const int row0 = u.pm * BM + wr * 64 + fr, pn = u.pn;
        if (pn < 8) {
            const int h = pn & 3; bf16_t* dst = pn < 4 ? Q : Kk; const float sc = pn < 4 ? 1.0f : 0.0625f; const int d0 = wc * 32 + 8 * fq;
#pragma unroll
            for (int ai = 0; ai < 2; ++ai)
#pragma unroll
                for (int m = 0; m < 4; ++m) { const int r = row0 + ai * HALF + m * 16, pos = r & (SEQ - 1);
                    const f32x4* rp = (const f32x4*)(rope + ((size_t)pos * 128 + d0) * 2);
                    const f32x4 t0 = rp[0], t1 = rp[1], t2 = rp[2], t3 = rp[3];
                    const f32x4 xa = acc[ai][0][m][0], xb = acc[ai][0][m][1], ya = acc[ai][1][m][0], yb = acc[ai][1][m][1];
                    u32x4 w1, w2;
                    w1.x = cvt_pk_bf16((xa[0] * t0[0] - ya[0] * t0[1]) * sc, (xa[1] * t0[2] - ya[1] * t0[3]) * sc); w1.y = cvt_pk_bf16((xa[2] * t1[0] - ya[2] * t1[1]) * sc, (xa[3] * t1[2] - ya[3] * t1[3]) * sc);
                    w1.z = cvt_pk_bf16((xb[0] * t2[0] - yb[0] * t2[1]) * sc, (xb[1] * t2[2] - yb[1] * t2[3]) * sc); w1.w = cvt_pk_bf16((xb[2] * t3[0] - yb[2] * t3[1]) * sc, (xb[3] * t3[2] - yb[3] * t3[3]) * sc);
                    w2.x = cvt_pk_bf16((xa[0] * t0[1] + ya[0] * t0[0]) * sc, (xa[1] * t0[3] + ya[1] * t0[2]) * sc); w2.y = cvt_pk_bf16((xa[2] * t1[1] + ya[2] * t1[0]) * sc, (xa[3] * t1[3] + ya[3] * t1[2]) * sc);
                    w2.z = cvt_pk_bf16((xb[0] * t2[1] + yb[0] * t2[0]) * sc, (xb[1] * t2[3] + yb[1] * t2[2]) * sc); w2.w = cvt_pk_bf16((xb[2] * t3[1] + yb[2] * t3[0]) * sc, (xb[3] * t3[3] + yb[3] * t3[2]) * sc);
                    bf16_t* o = dst + (size_t)r * DM + h * RDK + d0;
                    *(u32x4*)o = w1; *(u32x4*)(o + 128) = w2; }
        } else {
            bf16_t* dst = pn < 16 ? V : G; const int cb = (pn < 16 ? pn - 8 : pn - 16) * BM + wc * 32 + 8 * fq;
#pragma unroll
            for (int ai = 0; ai < 2; ++ai)
#pragma unroll
                for (int m = 0; m < 4; ++m) { bf16_t* rowp = dst + (size_t)(row0 + ai * HALF + m * 16) * RHV + cb;
#pragma unroll
                    for (int bj = 0; bj < 2; ++bj) { const f32x4 v0 = acc[ai][bj][m][0], v1 = acc[ai][bj][m][1];
                        u32x4 w; w.x = cvt_pk_bf16(v0[0], v0[1]); w.y = cvt_pk_bf16(v0[2], v0[3]); w.z = cvt_pk_bf16(v1[0], v1[1]); w.w = cvt_pk_bf16(v1[2], v1[3]);
                        *(u32x4*)(rowp + bj * HALF) = w; } }
        }
    }
};
struct EpiPle {
    static constexpr bool PERM = false;
    const float* x2f; const bf16_t* pp; const float* bg; float* xf; bf16_t* xb; float* out;
    __device__ __forceinline__ void operator()(const f32x4 (&acc)[2][2][4][2], const Unit& u, int wr, int wc, int fr, int fq) const {
        const int row0 = u.pm * BM + wr * 64 + fr, col0 = u.pn * BM + wc * 32 + 4 * fq;
#pragma unroll
        for (int ai = 0; ai < 2; ++ai)
#pragma unroll
            for (int m = 0; m < 4; ++m) { const size_t ro = (size_t)(row0 + ai * HALF + m * 16) * DM + col0;
#pragma unroll
                for (int bj = 0; bj < 2; ++bj)
#pragma unroll
                    for (int n = 0; n < 2; ++n) { const size_t o = ro + bj * HALF + n * 16; const int c = col0 + bj * HALF + n * 16;
                        const f32x4 x = *(const f32x4*)(x2f + o), b = *(const f32x4*)(bg + c), a = acc[ai][bj][m][n]; const u32x2 pw = *(const u32x2*)(pp + o);
                        f32x4 r;
                        r[0] = x[0] + bf2f(pw.x & 0xffffu) / (1.0f + __expf(-(a[0] + b[0]))); r[1] = x[1] + bf2f(pw.x >> 16) / (1.0f + __expf(-(a[1] + b[1])));
                        r[2] = x[2] + bf2f(pw.y & 0xffffu) / (1.0f + __expf(-(a[2] + b[2]))); r[3] = x[3] + bf2f(pw.y >> 16) / (1.0f + __expf(-(a[3] + b[3])));
                        *(f32x4*)(xf + o) = r; u32x2 w; w.x = cvt_pk_bf16(r[0], r[1]); w.y = cvt_pk_bf16(r[2], r[3]); *(u32x2*)(xb + o) = w;
                        if (out) *(f32x4*)(out + o) = r; } }
    }
};

template <class Epi, class Sched, bool ALIGN_EPI, bool GATHER>
__device__ __forceinline__ void gemm_phase(LAS unsigned char* lds, const int Kin, const Sched& S, const Epi& E) {
    int tid = threadIdx.x; asm volatile("" : "+v"(tid));
    const int wid = __builtin_amdgcn_readfirstlane(tid >> 6), lane = tid & 63, wr = wid >> 2, wc = wid & 3, fr = lane & 15, fq = lane >> 4;
    int K = __builtin_amdgcn_readfirstlane(Kin); asm volatile("" : "+s"(K));
    const int nt = K / BK;
    unsigned voffB[2], voffA[2], vG[2][2], vGn[2][2], Cg[2]; int Rg[2];
#pragma unroll
    for (int i = 0; i < 2; ++i) { int R, C; stage_rc(tid * 16 + i * 8192, R, C); const int Rb = Epi::PERM ? ((R & ~31) + perm32(R & 31)) : R;
        voffB[i] = (unsigned)(Rb * K + C) * 2u; voffA[i] = (unsigned)(R * K + C) * 2u; Rg[i] = R; Cg[i] = (unsigned)C * 2u; }
    const size_t kstep = (size_t)(BK * 2);
    const size_t hstep = (size_t)HALF * K * 2;
    const unsigned ldsw = (unsigned)wid * 1024u;
    const int aoff = lds_byte(wr * 64 + fr, fq * 8), boff = lds_byte(wc * 32 + fr, fq * 8);
#define PG8_SA(b, h) (((b) * 2 + (h)) * HTB)
#define PG8_SB(b, h) ((4 + (b) * 2 + (h)) * HTB)
#define PG8_STAGE(bufoff, gbase, voff) do { _Pragma("unroll") for (int _i = 0; _i < 2; ++_i) { unsigned _o = (voff)[_i]; if constexpr (GATHER) asm volatile("" : "+v"(_o)); \
        __builtin_amdgcn_global_load_lds((const unsigned*)((const char*)(gbase) + _o), (LAS unsigned*)(lds + (bufoff) + ldsw + _i * 8192), 16, 0, 0); } } while (0)
#define PG8_STAGEA(bufoff, gbase, h, vg) do { if constexpr (GATHER) { PG8_STAGE(bufoff, gbase, vg[h]); } else { PG8_STAGE(bufoff, (gbase) + (h) * hstep, voffA); } } while (0)
#define PG8_LDA(dst, b, h) do { _Pragma("unroll") for (int m = 0; m < 4; ++m) _Pragma("unroll") for (int k = 0; k < 2; ++k) dst[m][k] = *(const LAS bf16x8*)(lds + PG8_SA(b, h) + aoff + m * 2048 + k * 1024); } while (0)
#define PG8_LDB(dst, b, h) do { _Pragma("unroll") for (int n = 0; n < 2; ++n) _Pragma("unroll") for (int k = 0; k < 2; ++k) dst[n][k] = *(const LAS bf16x8*)(lds + PG8_SB(b, h) + boff + n * 2048 + k * 1024); } while (0)
#define PG8_MMA(ai, bj, At, Bt) do { __builtin_amdgcn_s_setprio(1); _Pragma("unroll") for (int m = 0; m < 4; ++m) _Pragma("unroll") for (int n = 0; n < 2; ++n) _Pragma("unroll") for (int k = 0; k < 2; ++k) \
        acc[ai][bj][m][n] = __builtin_amdgcn_mfma_f32_16x16x32_bf16(Bt[n][k], At[m][k], acc[ai][bj][m][n], 0, 0, 0); __builtin_amdgcn_s_setprio(0); } while (0)
#define PG8_WAIT_V(n) asm volatile("s_waitcnt vmcnt(" #n ")" ::: "memory")
#define PG8_WAIT_L(n) asm volatile("s_waitcnt lgkmcnt(" #n ")" ::: "memory")
#define PG8_BAR __builtin_amdgcn_s_barrier()
#define PG8_SCHED __builtin_amdgcn_sched_barrier(0)
#define PG8_TABLE(u) do { if (wid < 4) { S.roff[tid] = S.a_row(u, tid) * (unsigned)(K * 2); } } while (0)
#define PG8_GREAD(dst) do { _Pragma("unroll") for (int _h = 0; _h < 2; ++_h) _Pragma("unroll") for (int _i = 0; _i < 2; ++_i) dst[_h][_i] = S.roff[_h * HALF + Rg[_i]] + Cg[_i]; } while (0)
    Unit cur, nxt; int ui = 0;
    if (!S.next(0, cur)) return;
    f32x4 acc[2][2][4][2];
#pragma unroll
    for (int a = 0; a < 2; ++a)
#pragma unroll
        for (int b = 0; b < 2; ++b)
#pragma unroll
            for (int m = 0; m < 4; ++m)
#pragma unroll
                for (int n = 0; n < 2; ++n) acc[a][b][m][n] = (f32x4){0.f, 0.f, 0.f, 0.f};
    bf16x8 At[4][2], B0[2][2], B1[2][2];
    const char* cA = S.a_base(cur); const char* cB = S.b_base(cur);
    if constexpr (GATHER) { PG8_TABLE(cur); asm volatile("s_waitcnt vmcnt(0) lgkmcnt(0)" ::: "memory"); __builtin_amdgcn_s_barrier(); asm volatile("" ::: "memory"); PG8_GREAD(vG); }
    PG8_STAGE(PG8_SB(0, 0), cB, voffB); PG8_STAGE(PG8_SB(0, 1), cB + hstep, voffB); PG8_STAGEA(PG8_SA(0, 0), cA, 0, vG); PG8_STAGEA(PG8_SA(0, 1), cA, 1, vG);
    if (wr == 1) PG8_BAR;
    PG8_WAIT_V(2); PG8_BAR;
    PG8_STAGE(PG8_SB(1, 0), cB + kstep, voffB); PG8_STAGEA(PG8_SA(1, 0), cA + kstep, 0, vG); PG8_STAGE(PG8_SB(1, 1), cB + hstep + kstep, voffB);
    PG8_WAIT_V(6); PG8_BAR;
    for (;;) {
        const bool has_next = S.next(ui + 1, nxt);
        const char* nA = has_next ? S.a_base(nxt) : cA; const char* nB = has_next ? S.b_base(nxt) : cB;
        for (int t = 0; t < nt; t += 2) {
            const bool last = (t == nt - 2);
            const char* a1 = cA + (size_t)(t + 1) * kstep;
            const char* a2 = last ? nA : cA + (size_t)(t + 2) * kstep; const char* b2 = last ? nB : cB + (size_t)(t + 2) * kstep;
            const char* a3 = a2 + kstep; const char* b3 = b2 + kstep;
            if constexpr (GATHER) { if (last && has_next) { PG8_TABLE(nxt); } }
            PG8_LDB(B0, 0, 0); PG8_LDB(B1, 0, 1); PG8_SCHED; PG8_LDA(At, 0, 0); PG8_STAGEA(PG8_SA(1, 1), a1, 1, vG);
            PG8_WAIT_V(8); PG8_WAIT_L(0); PG8_BAR; PG8_MMA(0, 0, At, B0); PG8_MMA(0, 1, At, B1); PG8_BAR; PG8_SCHED;
            if constexpr (GATHER) { if (last && has_next) { PG8_GREAD(vGn); } else {
#pragma unroll
                for (int h = 0; h < 2; ++h)
#pragma unroll
                    for (int i = 0; i < 2; ++i) vGn[h][i] = vG[h][i]; } }
            PG8_LDA(At, 0, 1); PG8_STAGE(PG8_SB(0, 0), b2, voffB); PG8_STAGE(PG8_SB(0, 1), b2 + hstep, voffB); PG8_STAGEA(PG8_SA(0, 0), a2, 0, vGn);
            PG8_WAIT_V(8); PG8_WAIT_L(0); PG8_BAR; PG8_MMA(1, 0, At, B0); PG8_MMA(1, 1, At, B1); PG8_BAR; PG8_SCHED;
            PG8_LDB(B0, 1, 0); PG8_LDB(B1, 1, 1); PG8_SCHED; PG8_LDA(At, 1, 0); PG8_STAGEA(PG8_SA(0, 1), a2, 1, vGn);
            PG8_WAIT_V(8); PG8_WAIT_L(0); PG8_BAR; PG8_MMA(0, 0, At, B0); PG8_MMA(0, 1, At, B1); PG8_BAR; PG8_SCHED;
            PG8_LDA(At, 1, 1); PG8_STAGE(PG8_SB(1, 0), b3, voffB); PG8_STAGE(PG8_SB(1, 1), b3 + hstep, voffB); PG8_STAGEA(PG8_SA(1, 0), a3, 0, vGn);
            PG8_WAIT_V(8); PG8_WAIT_L(0); PG8_BAR; PG8_MMA(1, 0, At, B0); PG8_MMA(1, 1, At, B1); PG8_BAR; PG8_SCHED;
        }
        if constexpr (ALIGN_EPI) { if (wr == 0) PG8_BAR; }
        { int el = lane; asm volatile("" : "+v"(el));
          E(acc, cur, wr, wc, el & 15, el >> 4); }
        if (!has_next) break;
#pragma unroll
        for (int a = 0; a < 2; ++a)
#pragma unroll
            for (int b = 0; b < 2; ++b)
#pragma unroll
                for (int m = 0; m < 4; ++m)
#pragma unroll
                    for (int n = 0; n < 2; ++n) acc[a][b][m][n] = (f32x4){0.f, 0.f, 0.f, 0.f};
        cur = nxt; cA = nA; cB = nB; ++ui;
        if constexpr (GATHER) {
#pragma unroll
            for (int h = 0; h < 2; ++h)
#pragma unroll
                for (int i = 0; i < 2; ++i) vG[h][i] = vGn[h][i]; }
        if constexpr (ALIGN_EPI) { if (wr == 1) PG8_BAR; }
    }
    PG8_WAIT_V(0);
    if constexpr (!ALIGN_EPI) { if (wr == 0) PG8_BAR; }
    PG8_BAR;
#undef PG8_SA
#undef PG8_SB
#undef PG8_STAGE
#undef PG8_STAGEA
#undef PG8_LDA
#undef PG8_LDB
#undef PG8_MMA
#undef PG8_WAIT_V
#undef PG8_WAIT_L
#undef PG8_BAR
#undef PG8_SCHED
#undef PG8_TABLE
#undef PG8_GREAD
}
}
constexpr int NWAVES = 8;
constexpr int RING_OFF = 0, RING_BYTES = 131072;
constexpr int LDSCTL_OFF = RING_BYTES, MISC_OFF = LDSCTL_OFF + 320;
constexpr int LDS_BYTES = 147456;
constexpr int CW_BAR = 4096;
typedef GAS unsigned gu32;
#define RLX_AGENT __ATOMIC_RELAXED, __HIP_MEMORY_SCOPE_AGENT

#define XB_TMO      128
#define XB_XCNT(j)  (256  + 64 * (j))
#define XB_XSUB(j)  (1280 + 64 * (j))
#define XB_XGEN(j)  (2304 + 64 * (j))
#define XB_TOP      3328
#define XB_TOPGEN   3392
#define XCD_BAR_WORDS 3456
#define XB_SPIN_CAP (1u << 18)
__device__ __forceinline__ unsigned xb_ld(unsigned* p)              { return __hip_atomic_load(p, __ATOMIC_RELAXED, __HIP_MEMORY_SCOPE_AGENT); }
__device__ __forceinline__ unsigned xb_add(unsigned* p, unsigned v) { return __hip_atomic_fetch_add(p, v, __ATOMIC_RELAXED, __HIP_MEMORY_SCOPE_AGENT); }
__device__ __forceinline__ unsigned xb_xcc_id() { return (unsigned)__builtin_amdgcn_s_getreg((3 << 11) | 20) & 0xFu; }
#define XB_SPIN(cond, bar) do { unsigned _sp = 0; while (cond) { __builtin_amdgcn_s_sleep(1); \
    if ((++_sp & 255u) == 0u) { if (xb_ld(&(bar)[XB_TMO])) break; if (_sp > XB_SPIN_CAP) { atomicAdd(&(bar)[XB_TMO], 1u); break; } } } } while (0)
struct XcdBarrier { unsigned* bar; unsigned x; volatile LAS unsigned* st; };
__device__ __forceinline__ XcdBarrier xcd_barrier_post(unsigned* bar, volatile LAS unsigned* st) {
    XcdBarrier b; b.bar = bar; b.x = xb_xcc_id(); b.st = st;
    if (threadIdx.x == 0) (void)xb_add(&bar[XB_XCNT(b.x)], 1u);
    return b;
}
__device__ __forceinline__ void xcd_barrier_complete(unsigned* bar, unsigned x, unsigned& nloc, unsigned& nx) {
    const unsigned G = gridDim.x * gridDim.y * gridDim.z;
    unsigned sum, cnt, mine, sp = 0u;
    for (;;) {
        sum = 0u; cnt = 0u; mine = 0u;
#pragma unroll
        for (unsigned j = 0; j < 16; ++j) { const unsigned c = xb_ld(&bar[XB_XCNT(j)]); sum += c; cnt += (c > 0u) ? 1u : 0u; mine = (j == x) ? c : mine; }
        if (sum == G) break;
        __builtin_amdgcn_s_sleep(1);
        if ((++sp & 255u) == 0u) { if (xb_ld(&bar[XB_TMO])) break; if (sp > XB_SPIN_CAP) { atomicAdd(&bar[XB_TMO], 1u); break; } }
    }
    nloc = mine > 0u ? mine : 1u; nx = cnt > 0u ? cnt : 1u;
}
__device__ __forceinline__ void xcd_barrier(const XcdBarrier& b) {
    asm volatile("s_waitcnt vmcnt(0)" ::: "memory");
    __syncthreads();
    if (threadIdx.x == 0) {
        unsigned* bar = b.bar;
        __builtin_amdgcn_s_waitcnt(0);
        unsigned nloc = b.st[0], nx = b.st[1];
        if (nloc == 0u) { xcd_barrier_complete(bar, b.x, nloc, nx); b.st[0] = nloc; b.st[1] = nx; }
        const unsigned old = xb_add(&bar[XB_XSUB(b.x)], 1u);
        const unsigned gen = old / nloc;
        if (old + 1u == (gen + 1u) * nloc) {
            __builtin_amdgcn_fence(__ATOMIC_RELEASE, "agent");
            asm volatile("s_waitcnt vmcnt(0)" ::: "memory");
            const unsigned og = xb_add(&bar[XB_TOP], 1u);
            const unsigned tg = og / nx;
            if (og + 1u == (tg + 1u) * nx) xb_add(&bar[XB_TOPGEN], 1u);
            else XB_SPIN(xb_ld(&bar[XB_TOPGEN]) == tg, bar);
            __builtin_amdgcn_fence(__ATOMIC_ACQUIRE, "agent");
            xb_add(&bar[XB_XGEN(b.x)], 1u);
            asm volatile("s_waitcnt vmcnt(0)" ::: "memory");
        } else {
            XB_SPIN(xb_ld(&bar[XB_XGEN(b.x)]) == gen, bar);
            __builtin_amdgcn_fence(__ATOMIC_ACQUIRE, "agent");
            asm volatile("s_waitcnt vmcnt(0)" ::: "memory");
        }
    }
    __syncthreads();
}

__device__ __forceinline__ void p0_transpose_item(const float* __restrict__ Wm, int K, int N, bf16_t* __restrict__ WTm, LAS float* scr, int item, int lane) {
    const int nblk = N / 32, kb = item / nblk, nbk = item % nblk, k0 = 64 * kb, n0 = 32 * nbk;
#pragma unroll 8
    for (int i = 0; i < 32; ++i) { const int kk = 2 * i + (lane >> 5); scr[kk * 33 + (lane & 31)] = Wm[(size_t)(k0 + kk) * N + n0 + (lane & 31)]; }
    asm volatile("s_waitcnt lgkmcnt(0)" ::: "memory");
    const int c = lane & 7;
#pragma unroll
    for (int j = 0; j < 4; ++j) { const int n = (lane >> 3) + 8 * j; const LAS float* s = scr + (8 * c) * 33 + n;
        u32x4 o; o.x = pk2(s[0 * 33], s[1 * 33]); o.y = pk2(s[2 * 33], s[3 * 33]); o.z = pk2(s[4 * 33], s[5 * 33]); o.w = pk2(s[6 * 33], s[7 * 33]);
        *(u32x4*)(WTm + (size_t)(n0 + n) * K + k0 + 8 * c) = o; }
    asm volatile("s_waitcnt lgkmcnt(0)" ::: "memory");
}
__device__ __forceinline__ void p0_transpose_all(const float* W, bf16_t* WT, int nb, int K, int N, LAS float* scr, int gw, int ngw, int lane) {
    const int per = (K / 64) * (N / 32); const long total = (long)nb * per;
    for (long it = gw; it < total; it += ngw) { const int mb = (int)(it / per), item = (int)(it % per);
        p0_transpose_item(W + (size_t)mb * K * N, K, N, WT + (size_t)mb * K * N, scr, item, lane); }
}

struct PPOrder {
    int G, c; const char* A; const char* Bt;
    __device__ bool next(int i, pg8::Unit& u) const { const int L = i * G + c; if (L >= 1024) return false; u.e = L >> 8; u.pm = (L & 255) >> 2; u.pn = L & 3; u.lrow0 = 0; u.nvalid = 256; return true; }
    __device__ __forceinline__ const char* a_base(const pg8::Unit& u) const { return A + ((size_t)u.e * T + (size_t)u.pm * 256) * DPLE * 2; }
    __device__ __forceinline__ const char* b_base(const pg8::Unit& u) const { return Bt + ((size_t)u.e * DM + (size_t)u.pn * 256) * DPLE * 2; }
    __device__ __forceinline__ unsigned a_row(const pg8::Unit&, int) const { return 0u; }
    LAS unsigned* roff;
};

constexpr int LDS_ROFF = LDSCTL_OFF + 2048;
constexpr int LDS_TP = LDSCTL_OFF + 1024;
struct MoeOrder {
    LAS unsigned* roff; int G, c, nN; const LAS int* tp; const LAS int* cn; const int* elist; const char* A; const char* Bt; size_t bstride_e; bool gather;
    static __device__ __forceinline__ void setup(LAS unsigned char* lds, const unsigned* cnt) {
        LAS int* tp = (LAS int*)(lds + LDS_TP); LAS int* cn = (LAS int*)(lds + LDS_TP + 256);
        __syncthreads();
        if (threadIdx.x == 0) { int a = 0; for (int e = 0; e < NE; ++e) { const int cc = (int)__hip_atomic_load(cnt + e, RLX_AGENT); cn[e] = cc; tp[e] = a; a += (cc + 255) >> 8; } tp[NE] = a; }
        __syncthreads();
    }
    __device__ bool next(int i, pg8::Unit& u) const {
        const int nwg = __builtin_amdgcn_readfirstlane(tp[NE]) * nN; const long L = (long)i * G + c; if (L >= nwg) return false;
        int wgid = (int)L; { const int q = nwg / 8, r = nwg % 8, xcd = wgid % 8, off = wgid / 8; wgid = (xcd < r ? xcd * (q + 1) : r * (q + 1) + (xcd - r) * q) + off; }
        int e = 0; while (wgid >= __builtin_amdgcn_readfirstlane(tp[e + 1]) * nN) ++e;
        const int t0 = __builtin_amdgcn_readfirstlane(tp[e]), t1 = __builtin_amdgcn_readfirstlane(tp[e + 1]), ce = __builtin_amdgcn_readfirstlane(cn[e]);
        const int w = wgid - t0 * nN, te = t1 - t0, m = w % te;
        u.pn = w / te; u.pm = t0 + m; u.e = e; u.lrow0 = m * 256; u.nvalid = ce - m * 256; return true;
    }
    __device__ __forceinline__ const char* a_base(const pg8::Unit& u) const { return gather ? A : A + (size_t)u.pm * 256 * DF * 2; }
    __device__ __forceinline__ const char* b_base(const pg8::Unit& u) const { return Bt + (size_t)u.e * bstride_e + (size_t)u.pn * 256 * DM * 2; }
    __device__ __forceinline__ unsigned a_row(const pg8::Unit& u, int r) const { return r < u.nvalid ? (unsigned)(elist[(size_t)u.e * T + u.lrow0 + r] >> 2) : 0u; }
};
namespace pg8 {
struct EpiMoe1 {
    static constexpr bool PERM = true;
    const float* bias; bf16_t* act;
    __device__ __forceinline__ void operator()(const f32x4 (&acc)[2][2][4][2], const Unit& u, int wr, int wc, int fr, int fq) const {
        const int colg = u.pn * BM + wc * 32 + 8 * fq; const float* bp = bias + (size_t)u.e * 2 * DF + colg;
        f32x4 bv[2][2];
#pragma unroll
        for (int bj = 0; bj < 2; ++bj)
#pragma unroll
            for (int n = 0; n < 2; ++n) bv[bj][n] = *(const f32x4*)(bp + bj * HALF + 4 * n);
#pragma unroll
        for (int ai = 0; ai < 2; ++ai)
#pragma unroll
            for (int m = 0; m < 4; ++m) { const int lr = ai * HALF + wr * 64 + m * 16 + fr; bf16_t* rowp = act + (size_t)(u.pm * BM + lr) * DF + (colg >> 1);
                if (lr < u.nvalid) {
#pragma unroll
                for (int bj = 0; bj < 2; ++bj) { const f32x4 v0 = acc[ai][bj][m][0] + bv[bj][0], v1 = acc[ai][bj][m][1] + bv[bj][1];
                    float a[4];
#pragma unroll
                    for (int q = 0; q < 4; ++q) { const float gt = fminf(q < 2 ? v0[2 * q] : v1[2 * q - 4], 7.0f), up = fminf(fmaxf(q < 2 ? v0[2 * q + 1] : v1[2 * q - 3], -7.0f), 7.0f);
                        a[q] = (up + 1.0f) * (gt / (1.0f + __expf(-1.702f * gt))); }
                    u32x2 w; w.x = cvt_pk_bf16(a[0], a[1]); w.y = cvt_pk_bf16(a[2], a[3]);
                    *(u32x2*)(rowp + bj * (HALF / 2)) = w; } } }
    }
};
struct EpiMoe2 {
    static constexpr bool PERM = true;
    const float* bias; bf16_t* yb; const int* elist;
    __device__ __forceinline__ void operator()(const f32x4 (&acc)[2][2][4][2], const Unit& u, int wr, int wc, int fr, int fq) const {
        const int col = u.pn * BM + wc * 32 + 8 * fq; const float* bp = bias + (size_t)u.e * DM + col;
        f32x4 bv[2][2];
#pragma unroll
        for (int bj = 0; bj < 2; ++bj)
#pragma unroll
            for (int n = 0; n < 2; ++n) bv[bj][n] = *(const f32x4*)(bp + bj * HALF + 4 * n);
#pragma unroll
        for (int ai = 0; ai < 2; ++ai)
#pragma unroll
            for (int m = 0; m < 4; ++m) { const int lr = ai * HALF + wr * 64 + m * 16 + fr;
                if (lr < u.nvalid) { const int slot = elist[(size_t)u.e * T + u.lrow0 + lr]; bf16_t* rowp = yb + (size_t)slot * DM + col;
#pragma unroll
                for (int bj = 0; bj < 2; ++bj) { const f32x4 v0 = acc[ai][bj][m][0] + bv[bj][0], v1 = acc[ai][bj][m][1] + bv[bj][1];
                    u32x4 w; w.x = cvt_pk_bf16(v0[0], v0[1]); w.y = cvt_pk_bf16(v0[2], v0[3]); w.z = cvt_pk_bf16(v1[0], v1[1]); w.w = cvt_pk_bf16(v1[2], v1[3]);
                    *(u32x4*)(rowp + bj * HALF) = w; } } }
    }
};
}

__device__ __forceinline__ void ln1_router_row(int t, int lane, LAS float* xs, const float* __restrict__ xf, const float* __restrict__ mix, const float* __restrict__ lg, const float* __restrict__ lb,
                                               const float* __restrict__ rw, const float* __restrict__ rb, float* __restrict__ x1f, bf16_t* __restrict__ x1b,
                                               unsigned* __restrict__ cnt, int* __restrict__ elist, float* __restrict__ gates) {
    f32x4 y[4]; float s = 0.f;
#pragma unroll
    for (int j = 0; j < 4; ++j) { const int c = 4 * lane + 256 * j; const f32x4 a = *(const f32x4*)(xf + (size_t)t * DM + c), m = *(const f32x4*)(mix + (size_t)t * DM + c);
        y[j] = a * DN_ALPHA + m; s += (y[j].x + y[j].y) + (y[j].z + y[j].w); }
    const float mean = wave_sum(s) * (1.0f / DM); float s2 = 0.f;
#pragma unroll
    for (int j = 0; j < 4; ++j) { y[j] = y[j] - mean; s2 += (y[j].x * y[j].x + y[j].y * y[j].y) + (y[j].z * y[j].z + y[j].w * y[j].w); }
    const float rstd = 1.0f / sqrtf(wave_sum(s2) * (1.0f / DM) + LN_EPS);
#pragma unroll
    for (int j = 0; j < 4; ++j) { const int c = 4 * lane + 256 * j; const f32x4 gv = *(const f32x4*)(lg + c), bv = *(const f32x4*)(lb + c);
        const f32x4 o = y[j] * rstd * gv + bv;
        *(f32x4*)(x1f + (size_t)t * DM + c) = o; u32x2 pb; pb.x = pk2(o.x, o.y); pb.y = pk2(o.z, o.w); *(u32x2*)(x1b + (size_t)t * DM + c) = pb;
        *(LAS f32x4*)(xs + c) = o; }
    asm volatile("s_waitcnt lgkmcnt(0)" ::: "memory");
    const int e = lane & 31, half = lane >> 5; float p = 0.f;
    for (int d = 0; d < 512; d += 4) { const int c = half * 512 + d; const f32x4 xv = *(const LAS f32x4*)(xs + c);
        p += xv.x * rw[(c + 0) * NE + e]; p += xv.y * rw[(c + 1) * NE + e]; p += xv.z * rw[(c + 2) * NE + e]; p += xv.w * rw[(c + 3) * NE + e]; }
    p += __shfl_xor(p, 32);
    float vcur = p + rb[e];
    float topv[4]; int topi[4];
#pragma unroll
    for (int kk = 0; kk < 4; ++kk) {
        float bv = vcur; int bi = e;
#pragma unroll
        for (int off = 1; off < 32; off <<= 1) { const float ov = __shfl_xor(bv, off); const int oi = __shfl_xor(bi, off); if (ov > bv || (ov == bv && oi < bi)) { bv = ov; bi = oi; } }
        topv[kk] = bv; topi[kk] = bi; if (e == bi) vcur = -INFINITY;
    }
    const float e1 = __expf(topv[1] - topv[0]), e2 = __expf(topv[2] - topv[0]), e3 = __expf(topv[3] - topv[0]);
    const float inv = 1.0f / (1.0f + e1 + e2 + e3);
    if (lane < 4) {
        const int ee = lane == 0 ? topi[0] : lane == 1 ? topi[1] : lane == 2 ? topi[2] : topi[3];
        const float gg = (lane == 0 ? 1.0f : lane == 1 ? e1 : lane == 2 ? e2 : e3) * inv;
        const unsigned pos = __hip_atomic_fetch_add(cnt + ee, 1u, RLX_AGENT);
        elist[(size_t)ee * T + pos] = t * 4 + lane; gates[t * 4 + lane] = gg;
    }
    asm volatile("s_waitcnt lgkmcnt(0)" ::: "memory");
}
__device__ __forceinline__ void ln2_row(int t, int lane, const float* __restrict__ x1f, const bf16_t* __restrict__ yb, const float* __restrict__ gates, const float* __restrict__ lg, const float* __restrict__ lb,
                                        float* __restrict__ x2f, bf16_t* __restrict__ x2b) {
    const float g0 = gates[t * 4], g1 = gates[t * 4 + 1], g2 = gates[t * 4 + 2], g3 = gates[t * 4 + 3];
    f32x4 y[4]; float s = 0.f;
#pragma unroll
    for (int j = 0; j < 4; ++j) { const int c = 4 * lane + 256 * j; const f32x4 a = *(const f32x4*)(x1f + (size_t)t * DM + c);
        f32x4 f = (f32x4){0.f, 0.f, 0.f, 0.f};
#pragma unroll
        for (int kk = 0; kk < 4; ++kk) { const u32x2 w = *(const u32x2*)(yb + (size_t)(t * 4 + kk) * DM + c); const float gk = kk == 0 ? g0 : kk == 1 ? g1 : kk == 2 ? g2 : g3;
            f.x += gk * bf2f(w.x & 0xffffu); f.y += gk * bf2f(w.x >> 16); f.z += gk * bf2f(w.y & 0xffffu); f.w += gk * bf2f(w.y >> 16); }
        y[j] = a * DN_ALPHA + f; s += (y[j].x + y[j].y) + (y[j].z + y[j].w); }
    const float mean = wave_sum(s) * (1.0f / DM); float s2 = 0.f;
#pragma unroll
    for (int j = 0; j < 4; ++j) { y[j] = y[j] - mean; s2 += (y[j].x * y[j].x + y[j].y * y[j].y) + (y[j].z * y[j].z + y[j].w * y[j].w); }
    const float rstd = 1.0f / sqrtf(wave_sum(s2) * (1.0f / DM) + LN_EPS);
#pragma unroll
    for (int j = 0; j < 4; ++j) { const int c = 4 * lane + 256 * j; const f32x4 gv = *(const f32x4*)(lg + c), bv = *(const f32x4*)(lb + c);
        const f32x4 o = y[j] * rstd * gv + bv;
        *(f32x4*)(x2f + (size_t)t * DM + c) = o; u32x2 pb; pb.x = pk2(o.x, o.y); pb.y = pk2(o.z, o.w); *(u32x2*)(x2b + (size_t)t * DM + c) = pb; }
}
typedef _Float16 f16x8 __attribute__((ext_vector_type(8)));
typedef float f32x16 __attribute__((ext_vector_type(16)));
typedef short s16x4 __attribute__((ext_vector_type(4)));
__device__ __forceinline__ s16x4 lds_tr16(LAS const unsigned char* p) { return __builtin_bit_cast(s16x4, __builtin_amdgcn_ds_read_tr16_b64_v4i16((LAS s16x4*)p)); }
__device__ __forceinline__ bf16x8 cat4(s16x4 a, s16x4 b) { return __builtin_shufflevector(a, b, 0, 1, 2, 3, 4, 5, 6, 7); }
__device__ __forceinline__ unsigned cvtpk_c(float lo, float hi) { return pg8::cvt_pk_bf16(lo, hi); }
__device__ __forceinline__ float fexp2(float x) { return __builtin_amdgcn_exp2f(x); }
__device__ __forceinline__ float flog2(float x) { return __builtin_amdgcn_logf(x); }

namespace sb {
constexpr int KST = 144, TILE_B = 64 * KST;
__device__ __forceinline__ void attn_phase(LAS unsigned char* lds, const bf16_t* __restrict__ Q, const bf16_t* __restrict__ K, const bf16_t* __restrict__ V, bf16_t* __restrict__ O, int G, int c) {
    int tid = threadIdx.x; asm volatile("" : "+v"(tid));
    const int wid = __builtin_amdgcn_readfirstlane(tid >> 6), lane = tid & 63, n = lane & 31, hi = lane >> 5;
    f16x8 U0, U1, ONE;
#pragma unroll
    for (int j = 0; j < 8; ++j) { const int jp = 8 * (j >> 2) + 4 * hi + (j & 3); U0[j] = (jp > n) ? (_Float16)1.0f : (_Float16)0.0f; U1[j] = (16 + jp > n) ? (_Float16)1.0f : (_Float16)0.0f; ONE[j] = (_Float16)1.0f; }
    const int srow = tid >> 3, sch = tid & 7;
    const int trq = (lane & 15) >> 2, trp = lane & 3, blk = (lane >> 4) & 1;
    for (int it = 0;; ++it) {
        const int L = it * G + c; if (L >= NB * SH * 8) break;
        const int bh = L >> 3, qp = L & 7, qt = ((L >> 8) & 1) ? 7 - qp : qp, b = bh >> 4, h = bh & 15;
        const size_t rowbase = (size_t)b * SEQ;
        const int q0 = qt * 256 + wid * 32;
        bf16x8 qf[4];
        { const bf16_t* qrow = Q + (rowbase + q0 + n) * DM + h * SD + 8 * hi;
#pragma unroll
          for (int ks = 0; ks < 4; ++ks) qf[ks] = *(const bf16x8*)(qrow + 16 * ks); }
        f32x16 o0, o1, carry;
#pragma unroll
        for (int r = 0; r < 16; ++r) { o0[r] = 0.f; o1[r] = 0.f; carry[r] = 0.f; }
        const int nkt = 4 * qt + 4;
        const bf16_t* kg = K + (rowbase + srow) * DM + h * SD + sch * 8; const bf16_t* vg = V + (rowbase + srow) * DM + h * SD + sch * 8;
        { const u32x4 kr = *(const u32x4*)(kg + (size_t)(nkt - 1) * 64 * DM), vr = *(const u32x4*)(vg + (size_t)(nkt - 1) * 64 * DM);
          *(LAS u32x4*)(lds + srow * KST + sch * 16) = kr; *(LAS u32x4*)(lds + 2 * TILE_B + srow * KST + sch * 16) = vr; }
        asm volatile("s_waitcnt lgkmcnt(0)" ::: "memory"); __builtin_amdgcn_s_barrier(); asm volatile("" ::: "memory");
        int cur = 0;
        for (int kt = nkt - 1; kt >= 0; --kt) {
            u32x4 kr, vr;
            if (kt > 0) { kr = *(const u32x4*)(kg + (size_t)(kt - 1) * 64 * DM); vr = *(const u32x4*)(vg + (size_t)(kt - 1) * 64 * DM); }
            LAS const unsigned char* kb = lds + cur * TILE_B; LAS const unsigned char* vb = lds + (2 + cur) * TILE_B;
#pragma unroll
            for (int sub = 1; sub >= 0; --sub) {
                const int key0 = kt * 64 + sub * 32;
                if (key0 <= q0) {
                    const bool diag = (key0 == q0);
                    f32x16 z;
#pragma unroll
                    for (int r = 0; r < 16; ++r) z[r] = 0.f;
                    { LAS const unsigned char* kp = kb + (sub * 32 + n) * KST + hi * 16;
#pragma unroll
                      for (int ks = 0; ks < 4; ++ks) { const bf16x8 kf = *(LAS const bf16x8*)(kp + ks * 32); z = __builtin_amdgcn_mfma_f32_32x32x16_bf16(kf, qf[ks], z, 0, 0, 0); } }
                    f16x8 lf0, lf1;
#pragma unroll
                    for (int r = 0; r < 16; ++r) {
                        const float zz = z[r];
                        float l = -(fmaxf(zz, 0.f) + flog2(1.0f + fexp2(-fabsf(zz))));
                        float zl = zz + l;
                        if (diag) { const bool valid = ((r & 3) + 8 * (r >> 2) + 4 * hi) < n; l = valid ? l : 0.f; zl = valid ? zl : -INFINITY; }
                        z[r] = zl;
                        if (r < 8) lf0[r] = (_Float16)l; else lf1[r - 8] = (_Float16)l;
                    }
                    f32x16 y = carry;
                    y = __builtin_amdgcn_mfma_f32_32x32x16_f16(U0, lf0, y, 0, 0, 0); y = __builtin_amdgcn_mfma_f32_32x32x16_f16(U1, lf1, y, 0, 0, 0);
                    carry = __builtin_amdgcn_mfma_f32_32x32x16_f16(ONE, lf0, carry, 0, 0, 0); carry = __builtin_amdgcn_mfma_f32_32x32x16_f16(ONE, lf1, carry, 0, 0, 0);
                    bf16x8 pf0, pf1;
                    { unsigned w[8];
#pragma unroll
                      for (int r2 = 0; r2 < 8; ++r2) w[r2] = cvtpk_c(fexp2(z[2 * r2] + y[2 * r2]), fexp2(z[2 * r2 + 1] + y[2 * r2 + 1]));
                      pf0 = __builtin_bit_cast(bf16x8, (u32x4){w[0], w[1], w[2], w[3]}); pf1 = __builtin_bit_cast(bf16x8, (u32x4){w[4], w[5], w[6], w[7]}); }
                    LAS const unsigned char* vp = vb + (sub * 32 + 4 * hi + trq) * KST + (16 * blk + 4 * trp) * 2;
#pragma unroll
                    for (int s = 0; s < 2; ++s) {
                        const bf16x8 va = cat4(lds_tr16(vp + (16 * s) * KST), lds_tr16(vp + (16 * s + 8) * KST));
                        const bf16x8 vc = cat4(lds_tr16(vp + (16 * s) * KST + 64), lds_tr16(vp + (16 * s + 8) * KST + 64));
                        o0 = __builtin_amdgcn_mfma_f32_32x32x16_bf16(va, s ? pf1 : pf0, o0, 0, 0, 0);
                        o1 = __builtin_amdgcn_mfma_f32_32x32x16_bf16(vc, s ? pf1 : pf0, o1, 0, 0, 0);
                    }
                }
            }
            if (kt > 0) { *(LAS u32x4*)(lds + (cur ^ 1) * TILE_B + srow * KST + sch * 16) = kr; *(LAS u32x4*)(lds + (2 + (cur ^ 1)) * TILE_B + srow * KST + sch * 16) = vr; }
            asm volatile("s_waitcnt lgkmcnt(0)" ::: "memory"); __builtin_amdgcn_s_barrier(); asm volatile("" ::: "memory");
            cur ^= 1;
        }
        bf16_t* orow = O + (rowbase + q0 + n) * DM + h * SD + 4 * hi;
#pragma unroll
        for (int g4 = 0; g4 < 4; ++g4) {
            u32x2 w0, w1; w0.x = pg8::cvt_pk_bf16(o0[4 * g4], o0[4 * g4 + 1]); w0.y = pg8::cvt_pk_bf16(o0[4 * g4 + 2], o0[4 * g4 + 3]);
            w1.x = pg8::cvt_pk_bf16(o1[4 * g4], o1[4 * g4 + 1]); w1.y = pg8::cvt_pk_bf16(o1[4 * g4 + 2], o1[4 * g4 + 3]);
            *(u32x2*)(orow + 8 * g4) = w0; *(u32x2*)(orow + 32 + 8 * g4) = w1; }
    }
}
}

namespace ret {
constexpr int QST = 528, VST = 144;
constexpr int O_Q = 0, O_K = 64 * QST, O_ST = 2 * 64 * QST, O_V = 3 * 64 * QST, O_VD = O_V + 64 * VST, O_P = O_VD + 64 * VST, LDS_END = O_P + 64 * VST;
static_assert(LDS_END <= 131072, "retention LDS");
__device__ __forceinline__ void scan_phase(LAS unsigned char* lds, const bf16_t* __restrict__ Q, const bf16_t* __restrict__ K, const bf16_t* __restrict__ V, float* __restrict__ RO, int G, int c) {
    int tid = threadIdx.x; asm volatile("" : "+v"(tid));
    const int wid = __builtin_amdgcn_readfirstlane(tid >> 6), lane = tid & 63, lr = lane & 15, g = lane >> 4;
    const int trq = (lane & 15) >> 2, trp = lane & 3;
    const int tqt = wid >> 1, e2 = 2 * (wid & 1);
    for (int it = 0;; ++it) {
        const int L = it * G + c; if (L >= NB * RH * 8) break;
        const int bh = (L & 7) * 4 + (L >> 6), es = (L >> 3) & 7, b = bh >> 2, h = bh & 3;
        const size_t rowbase = (size_t)b * SEQ;
        const float lg2 = flog2(1.0f - fexp2(-5.0f - (float)h));
        const float cdec = fexp2(lg2 * 64.0f);
        f32x4 S[2][4];
#pragma unroll
        for (int a = 0; a < 2; ++a)
#pragma unroll
            for (int e = 0; e < 4; ++e) S[a][e] = (f32x4){0.f, 0.f, 0.f, 0.f};
        const bf16_t* qg = Q + (rowbase + (tid >> 5)) * DM + h * RDK + (tid & 31) * 8; const bf16_t* kg = K + (rowbase + (tid >> 5)) * DM + h * RDK + (tid & 31) * 8;
        const bf16_t* vg = V + (rowbase + (tid >> 3)) * RHV + h * RDV + es * 64 + (tid & 7) * 8;
        const int sq = (tid >> 5) * QST + (tid & 31) * 16, sv = (tid >> 3) * VST + (tid & 7) * 16;
        const float kdv = fexp2(lg2 * (float)(63 - (tid >> 3)));
        u32x4 rq[4], rk[4], rv;
#pragma unroll
        for (int i = 0; i < 4; ++i) { rq[i] = *(const u32x4*)(qg + (size_t)(16 * i) * DM); rk[i] = *(const u32x4*)(kg + (size_t)(16 * i) * DM); }
        rv = *(const u32x4*)vg;
        __builtin_amdgcn_s_barrier();
        for (int ci = 0; ci < SEQ / 64; ++ci) {
#pragma unroll
            for (int i = 0; i < 4; ++i) { *(LAS u32x4*)(lds + O_Q + sq + 16 * i * QST) = rq[i]; *(LAS u32x4*)(lds + O_K + sq + 16 * i * QST) = rk[i]; }
            { *(LAS u32x4*)(lds + O_V + sv) = rv;
              u32x4 d; d.x = pk2(bf2f(rv.x & 0xffffu) * kdv, bf2f(rv.x >> 16) * kdv); d.y = pk2(bf2f(rv.y & 0xffffu) * kdv, bf2f(rv.y >> 16) * kdv);
              d.z = pk2(bf2f(rv.z & 0xffffu) * kdv, bf2f(rv.z >> 16) * kdv); d.w = pk2(bf2f(rv.w & 0xffffu) * kdv, bf2f(rv.w >> 16) * kdv);
              *(LAS u32x4*)(lds + O_VD + sv) = d; }
#pragma unroll
            for (int a = 0; a < 2; ++a)
#pragma unroll
                for (int e = 0; e < 4; ++e) { u32x2 w; w.x = pg8::cvt_pk_bf16(S[a][e][0], S[a][e][1]); w.y = pg8::cvt_pk_bf16(S[a][e][2], S[a][e][3]);
                    *(LAS u32x2*)(lds + O_ST + (16 * e + lr) * QST + (32 * wid + 16 * a + 4 * g) * 2) = w; }
            asm volatile("s_waitcnt lgkmcnt(0)" ::: "memory"); __builtin_amdgcn_s_barrier(); asm volatile("" ::: "memory");
            if (ci + 1 < SEQ / 64) {
#pragma unroll
                for (int i = 0; i < 4; ++i) { rq[i] = *(const u32x4*)(qg + (size_t)((ci + 1) * 64 + 16 * i) * DM); rk[i] = *(const u32x4*)(kg + (size_t)((ci + 1) * 64 + 16 * i) * DM); }
                rv = *(const u32x4*)(vg + (size_t)(ci + 1) * 64 * RHV);
            }
            f32x4 pacc[2], oacc[2];
#pragma unroll
            for (int x = 0; x < 2; ++x) { pacc[x] = (f32x4){0.f, 0.f, 0.f, 0.f}; oacc[x] = (f32x4){0.f, 0.f, 0.f, 0.f}; }
            { LAS const unsigned char* qp = lds + O_Q + (16 * tqt + lr) * QST + 16 * g;
              LAS const unsigned char* kp = lds + O_K + (16 * e2 + lr) * QST + 16 * g;
              LAS const unsigned char* sp = lds + O_ST + (16 * e2 + lr) * QST + 16 * g;
#pragma unroll
              for (int ks = 0; ks < 8; ++ks) {
                  const bf16x8 qa = *(LAS const bf16x8*)(qp + 64 * ks);
                  const bf16x8 k0 = *(LAS const bf16x8*)(kp + 64 * ks), k1 = *(LAS const bf16x8*)(kp + 16 * QST + 64 * ks);
                  const bf16x8 s0 = *(LAS const bf16x8*)(sp + 64 * ks), s1 = *(LAS const bf16x8*)(sp + 16 * QST + 64 * ks);
                  pacc[0] = __builtin_amdgcn_mfma_f32_16x16x32_bf16(k0, qa, pacc[0], 0, 0, 0); pacc[1] = __builtin_amdgcn_mfma_f32_16x16x32_bf16(k1, qa, pacc[1], 0, 0, 0);
                  oacc[0] = __builtin_amdgcn_mfma_f32_16x16x32_bf16(qa, s0, oacc[0], 0, 0, 0); oacc[1] = __builtin_amdgcn_mfma_f32_16x16x32_bf16(qa, s1, oacc[1], 0, 0, 0);
              } }
#pragma unroll
            for (int x = 0; x < 2; ++x) { float pv[4];
#pragma unroll
                for (int i = 0; i < 4; ++i) { const int dist = (16 * tqt + lr) - (16 * (e2 + x) + 4 * g + i); pv[i] = pacc[x][i] * fexp2(lg2 * fabsf((float)dist)); }
                u32x2 w; w.x = pg8::cvt_pk_bf16(pv[0], pv[1]); w.y = pg8::cvt_pk_bf16(pv[2], pv[3]);
                *(LAS u32x2*)(lds + O_P + (16 * tqt + lr) * VST + (16 * (e2 + x) + 4 * g) * 2) = w; }
#pragma unroll
            for (int i = 0; i < 4; ++i) { const float qd = fexp2(lg2 * (float)(16 * tqt + 4 * g + i + 1)); oacc[0][i] *= qd; oacc[1][i] *= qd; }
            asm volatile("s_waitcnt lgkmcnt(0)" ::: "memory"); __builtin_amdgcn_s_barrier(); asm volatile("" ::: "memory");
            { LAS const unsigned char* pp = lds + O_P + (16 * tqt + lr) * VST + 16 * g;
              LAS const unsigned char* vp = lds + O_V + (8 * g + trq) * VST + (16 * e2 + 4 * trp) * 2;
#pragma unroll
              for (int ks = 0; ks < 2; ++ks) {
                  const bf16x8 pa = *(LAS const bf16x8*)(pp + 64 * ks);
                  const bf16x8 v0 = cat4(lds_tr16(vp + (32 * ks) * VST), lds_tr16(vp + (32 * ks + 4) * VST));
                  const bf16x8 v1 = cat4(lds_tr16(vp + (32 * ks) * VST + 32), lds_tr16(vp + (32 * ks + 4) * VST + 32));
                  oacc[0] = __builtin_amdgcn_mfma_f32_16x16x32_bf16(pa, v0, oacc[0], 0, 0, 0); oacc[1] = __builtin_amdgcn_mfma_f32_16x16x32_bf16(pa, v1, oacc[1], 0, 0, 0);
              } }
            { float* op = RO + (rowbase + ci * 64 + 16 * tqt + 4 * g) * RHV + h * RDV + es * 64 + 16 * e2 + lr;
#pragma unroll
              for (int i = 0; i < 4; ++i) { op[(size_t)i * RHV] = oacc[0][i]; op[(size_t)i * RHV + 16] = oacc[1][i]; } }
#pragma unroll
            for (int a = 0; a < 2; ++a)
#pragma unroll
                for (int e = 0; e < 4; ++e) S[a][e] = S[a][e] * cdec;
            { LAS const unsigned char* ktp = lds + O_K + (8 * g + trq) * QST + (32 * wid + 4 * trp) * 2;
              LAS const unsigned char* vtp = lds + O_VD + (8 * g + trq) * VST + (4 * trp) * 2;
#pragma unroll
              for (int ks = 0; ks < 2; ++ks) {
                  bf16x8 ka[2], vb[4];
#pragma unroll
                  for (int a = 0; a < 2; ++a) ka[a] = cat4(lds_tr16(ktp + (32 * ks) * QST + 32 * a), lds_tr16(ktp + (32 * ks + 4) * QST + 32 * a));
#pragma unroll
                  for (int e = 0; e < 4; ++e) vb[e] = cat4(lds_tr16(vtp + (32 * ks) * VST + 32 * e), lds_tr16(vtp + (32 * ks + 4) * VST + 32 * e));
#pragma unroll
                  for (int a = 0; a < 2; ++a)
#pragma unroll
                      for (int e = 0; e < 4; ++e) S[a][e] = __builtin_amdgcn_mfma_f32_16x16x32_bf16(ka[a], vb[e], S[a][e], 0, 0, 0);
              } }
            asm volatile("s_waitcnt lgkmcnt(0)" ::: "memory"); __builtin_amdgcn_s_barrier(); asm volatile("" ::: "memory");
        }
    }
}
__device__ __forceinline__ void gate_row(int w, int lane, const float* __restrict__ ro, const bf16_t* __restrict__ g, bf16_t* __restrict__ gn) {
    const float* r = ro + (size_t)w * RDV; const bf16_t* gg = g + (size_t)w * RDV; bf16_t* o = gn + (size_t)w * RDV;
    const f32x4 a = *(const f32x4*)(r + 8 * lane), b = *(const f32x4*)(r + 8 * lane + 4);
    float s = (a.x + a.y) + (a.z + a.w) + (b.x + b.y) + (b.z + b.w);
    const float mean = wave_sum(s) * (1.0f / RDV);
    const f32x4 da = a - mean, db = b - mean;
    const float rstd = 1.0f / sqrtf(wave_sum((da.x * da.x + da.y * da.y) + (da.z * da.z + da.w * da.w) + (db.x * db.x + db.y * db.y) + (db.z * db.z + db.w * db.w)) * (1.0f / RDV) + GN_EPS);
    const u32x4 gw = *(const u32x4*)(gg + 8 * lane);
    float gv[8] = {bf2f(gw.x & 0xffffu), bf2f(gw.x >> 16), bf2f(gw.y & 0xffffu), bf2f(gw.y >> 16), bf2f(gw.z & 0xffffu), bf2f(gw.z >> 16), bf2f(gw.w & 0xffffu), bf2f(gw.w >> 16)};
    float xv[8] = {da.x, da.y, da.z, da.w, db.x, db.y, db.z, db.w};
    unsigned wv[4];
#pragma unroll
    for (int j = 0; j < 4; ++j) { const float g0 = gv[2 * j], g1 = gv[2 * j + 1];
        wv[j] = pg8::cvt_pk_bf16(g0 / (1.0f + __expf(-g0)) * (xv[2 * j] * rstd), g1 / (1.0f + __expf(-g1)) * (xv[2 * j + 1] * rstd)); }
    *(u32x4*)(o + 8 * lane) = (u32x4){wv[0], wv[1], wv[2], wv[3]};
}
}
struct Args { const float* in[19]; float* out; unsigned char* ws; int ph_lo, ph_hi, bar_region, pad; };
#define CAS __attribute__((address_space(4)))
#define PHASE_ARGS() const CAS Args* ka = (const CAS Args*)__builtin_amdgcn_kernarg_segment_ptr(); asm volatile("" : "+s"(ka) :: "memory"); unsigned char* const ws = ka->ws; (void)ws; int ptid = threadIdx.x; asm volatile("" : "+v"(ptid)); const int lane = ptid & 63, wave = __builtin_amdgcn_readfirstlane(ptid >> 6); (void)lane; (void)wave
#define WSP(type, off) ((type*)(ws + (off)))
#ifndef PH_MASK
#define PH_MASK 0xffff
#endif
#define ON(b) ((PH_MASK >> (b)) & 1)
__global__ void __launch_bounds__(NWAVES * 64, 2) mega(Args args) {
    extern __shared__ __attribute__((aligned(16))) unsigned char lds_raw[];
    LAS unsigned char* lds = (LAS unsigned char*)lds_raw;
    const int tid = threadIdx.x;
    const int G = gridDim.x;
    for (int u = tid; u < (LDS_BYTES - LDSCTL_OFF) / 4; u += NWAVES * 64) ((LAS unsigned*)(lds + LDSCTL_OFF))[u] = 0u;
    __syncthreads();
    XcdBarrier bar = xcd_barrier_post((unsigned*)(args.ws + OFF_CTL) + CW_BAR + args.bar_region * XCD_BAR_WORDS, (volatile LAS unsigned*)(lds + MISC_OFF) + 8);
    const int lo = args.ph_lo, hi = args.ph_hi;
#define IN(k) (lo <= (k) && (k) < hi)
#define SEAM(k) do { if (IN(k) && IN((k) + 1)) xcd_barrier(bar); } while (0)

    if (ON(0) && IN(0)) {
        PHASE_ARGS();
        LAS float* scr = (LAS float*)(lds + RING_OFF + wave * 16384);
        const int gw = blockIdx.x * NWAVES + wave, ngw = G * NWAVES;
        p0_transpose_all(ka->in[2], WSP(bf16_t, OFF_WRI), 2, DM, RIN, scr, gw, ngw, lane);
        p0_transpose_all(ka->in[3], WSP(bf16_t, OFF_WRO), 2, RHV, DM, scr, gw, ngw, lane);
        p0_transpose_all(ka->in[4], WSP(bf16_t, OFF_WSI), 2, DM, 3 * DM, scr, gw, ngw, lane);
        p0_transpose_all(ka->in[5], WSP(bf16_t, OFF_WSO), 2, DM, DM, scr, gw, ngw, lane);
        p0_transpose_all(ka->in[17], WSP(bf16_t, OFF_WPG), 4, DM, DM, scr, gw, ngw, lane);
        p0_transpose_all(ka->in[16], WSP(bf16_t, OFF_WPW), 4, DPLE, DM, scr, gw, ngw, lane);
        p0_transpose_all(ka->in[10], WSP(bf16_t, OFF_WGU), 128, DM, 2 * DF, scr, gw, ngw, lane);
        p0_transpose_all(ka->in[12], WSP(bf16_t, OFF_WDN), 128, DF, DM, scr, gw, ngw, lane);
        const size_t gt = (size_t)blockIdx.x * (NWAVES * 64) + ptid, ngt = (size_t)G * NWAVES * 64;
        { const f32x4* x = (const f32x4*)ka->in[0]; u32x2* xb = WSP(u32x2, OFF_XB); f32x4* xf = WSP(f32x4, OFF_XF);
          for (size_t i = gt; i < (size_t)T * DM / 4; i += ngt) { const f32x4 v = x[i]; u32x2 o; o.x = pk2(v.x, v.y); o.y = pk2(v.z, v.w); xb[i] = o; xf[i] = v; } }
        { const f32x4* p = (const f32x4*)ka->in[1]; u32x2* pb = WSP(u32x2, OFF_PB);
          for (size_t i = gt; i < (size_t)4 * T * DPLE / 4; i += ngt) { const f32x4 v = p[i]; u32x2 o; o.x = pk2(v.x, v.y); o.y = pk2(v.z, v.w); pb[i] = o; } }
        { float* rope = WSP(float, OFF_ROPE);
          for (size_t i = gt; i < (size_t)SEQ * 128; i += ngt) { const int pos = (int)(i >> 7), d = (int)(i & 127);
            const float invf = 1.0f / powf(10000.0f, (float)d / 128.0f); const float ang = (float)pos * invf;
            rope[2 * i] = (float)cos((double)ang); rope[2 * i + 1] = (float)sin((double)ang); } }
    }
    SEAM(0);
    if (ON(1) && IN(1)) {
        PHASE_ARGS();
        PPOrder S; S.G = G; S.c = (int)blockIdx.x; S.A = (const char*)WSP(bf16_t, OFF_PB); S.Bt = (const char*)WSP(bf16_t, OFF_WPW);
        pg8::EpiBf16 E{WSP(bf16_t, OFF_PPB), DM, 0, 0, 1.0f, (size_t)T * DM};
        pg8::gemm_phase<pg8::EpiBf16, PPOrder, true, false>(lds + RING_OFF, DPLE, S, E);
    }
    SEAM(1);
#pragma unroll 1
    for (int i = 0; i < DEPTH; ++i) {
        const int pb = 2 + 10 * i, j = i >> 1;
        if (IN(pb)) {
            if (ON(2) && (i & 1) == 0) {
                PHASE_ARGS();
                pg8::DenseOrder S; S.init(T, RIN, DM, G, (int)blockIdx.x, WSP(bf16_t, OFF_XB), WSP(bf16_t, OFF_WRI) + (size_t)j * RIN * DM);
                pg8::EpiRetProj E{WSP(bf16_t, OFF_Q), WSP(bf16_t, OFF_K), WSP(bf16_t, OFF_V), WSP(bf16_t, OFF_G), WSP(float, OFF_ROPE)};
                pg8::gemm_phase<pg8::EpiRetProj, pg8::DenseOrder, true, false>(lds + RING_OFF, DM, S, E);
            } else if (ON(3) && (i & 1) == 1) {
                PHASE_ARGS();
                pg8::DenseOrder S; S.init(T, 3 * DM, DM, G, (int)blockIdx.x, WSP(bf16_t, OFF_XB), WSP(bf16_t, OFF_WSI) + (size_t)j * 3 * DM * DM);
                pg8::EpiBf16 E{WSP(bf16_t, OFF_Q), DM, DM, (size_t)(OFF_K - OFF_Q) / 2, 0.125f * 1.4426950408889634f, 0};
                pg8::gemm_phase<pg8::EpiBf16, pg8::DenseOrder, true, false>(lds + RING_OFF, DM, S, E);
            }
        }
        SEAM(pb);
        if (IN(pb + 1)) {
            if (ON(10) && (i & 1) == 0) { PHASE_ARGS(); ret::scan_phase(lds + RING_OFF, WSP(bf16_t, OFF_Q), WSP(bf16_t, OFF_K), WSP(bf16_t, OFF_V), WSP(float, OFF_RO), G, (int)blockIdx.x); }
            else if (ON(11) && (i & 1) == 1) { PHASE_ARGS(); sb::attn_phase(lds + RING_OFF, WSP(bf16_t, OFF_Q), WSP(bf16_t, OFF_K), WSP(bf16_t, OFF_V), WSP(bf16_t, OFF_GN), G, (int)blockIdx.x); }
        }
        SEAM(pb + 1);
        if (ON(12) && IN(pb + 2) && (i & 1) == 0) {
            PHASE_ARGS();
            for (int w = blockIdx.x * NWAVES + wave; w < T * RH; w += G * NWAVES) ret::gate_row(w, lane, WSP(float, OFF_RO), WSP(bf16_t, OFF_G), WSP(bf16_t, OFF_GN));
        }
        SEAM(pb + 2);
        if (ON(4) && IN(pb + 3)) {
            PHASE_ARGS();
            pg8::EpiF32 E{WSP(float, OFF_MIX), DM};
            const int Kx = (i & 1) ? DM : RHV;
            pg8::DenseOrder S; S.init(T, DM, Kx, G, (int)blockIdx.x, WSP(bf16_t, OFF_GN), (i & 1) ? (const void*)(WSP(bf16_t, OFF_WSO) + (size_t)j * DM * DM) : (const void*)(WSP(bf16_t, OFF_WRO) + (size_t)j * DM * RHV));
            pg8::gemm_phase<pg8::EpiF32, pg8::DenseOrder, false, false>(lds + RING_OFF, Kx, S, E);
        }
        SEAM(pb + 3);
        if (ON(6) && IN(pb + 4)) {
            PHASE_ARGS();
            LAS float* xs = (LAS float*)(lds + RING_OFF + wave * 4096);
            unsigned* cnt = WSP(unsigned, OFF_CTL) + CW_CNT + i * 64;
            const float* lg = ka->in[6] + (size_t)i * DM; const float* lb = ka->in[7] + (size_t)i * DM; const float* rw = ka->in[8] + (size_t)i * DM * NE; const float* rb = ka->in[9] + (size_t)i * NE;
            for (int t = blockIdx.x * NWAVES + wave; t < T; t += G * NWAVES)
                ln1_router_row(t, lane, xs, WSP(float, OFF_XF), WSP(float, OFF_MIX), lg, lb, rw, rb, WSP(float, OFF_X1F), WSP(bf16_t, OFF_X1B), cnt, WSP(int, OFF_EL), WSP(float, OFF_GT));
        }
        SEAM(pb + 4);
        if (ON(7) && IN(pb + 5)) {
            PHASE_ARGS();
            MoeOrder::setup(lds, WSP(unsigned, OFF_CTL) + CW_CNT + i * 64);
            MoeOrder S; S.G = G; S.c = (int)blockIdx.x; S.nN = 2 * DF / 256; S.tp = (const LAS int*)(lds + LDS_TP); S.cn = (const LAS int*)(lds + LDS_TP + 256); S.elist = WSP(int, OFF_EL);
            S.A = (const char*)WSP(bf16_t, OFF_X1B); S.Bt = (const char*)(WSP(bf16_t, OFF_WGU) + (size_t)i * NE * 2 * DF * DM); S.bstride_e = (size_t)2 * DF * DM * 2; S.gather = true; S.roff = (LAS unsigned*)(lds + LDS_ROFF);
            pg8::EpiMoe1 E{ka->in[11] + (size_t)i * NE * 2 * DF, WSP(bf16_t, OFF_ACT)};
            pg8::gemm_phase<pg8::EpiMoe1, MoeOrder, true, true>(lds + RING_OFF, DM, S, E);
        }
        SEAM(pb + 5);
        if (ON(8) && IN(pb + 6)) {
            PHASE_ARGS();
            MoeOrder::setup(lds, WSP(unsigned, OFF_CTL) + CW_CNT + i * 64);
            MoeOrder S; S.G = G; S.c = (int)blockIdx.x; S.nN = DM / 256; S.tp = (const LAS int*)(lds + LDS_TP); S.cn = (const LAS int*)(lds + LDS_TP + 256); S.elist = WSP(int, OFF_EL);
            S.A = (const char*)WSP(bf16_t, OFF_ACT); S.Bt = (const char*)(WSP(bf16_t, OFF_WDN) + (size_t)i * NE * DM * DF); S.bstride_e = (size_t)DM * DF * 2; S.gather = false; S.roff = (LAS unsigned*)(lds + LDS_ROFF);
            pg8::EpiMoe2 E{ka->in[13] + (size_t)i * NE * DM, WSP(bf16_t, OFF_YB), WSP(int, OFF_EL)};
            pg8::gemm_phase<pg8::EpiMoe2, MoeOrder, true, false>(lds + RING_OFF, DF, S, E);
        }
        SEAM(pb + 6);
        if (ON(9) && IN(pb + 7)) {
            PHASE_ARGS();
            const float* lg = ka->in[14] + (size_t)i * DM; const float* lb = ka->in[15] + (size_t)i * DM;
            for (int t = blockIdx.x * NWAVES + wave; t < T; t += G * NWAVES)
                ln2_row(t, lane, WSP(float, OFF_X1F), WSP(bf16_t, OFF_YB), WSP(float, OFF_GT), lg, lb, WSP(float, OFF_X2F), WSP(bf16_t, OFF_X2B));
        }
        SEAM(pb + 7);
        if (ON(5) && IN(pb + 8)) {
            PHASE_ARGS();
            pg8::DenseOrder S; S.init(T, DM, DM, G, (int)blockIdx.x, WSP(bf16_t, OFF_X2B), WSP(bf16_t, OFF_WPG) + (size_t)i * DM * DM);
            pg8::EpiPle E{WSP(float, OFF_X2F), WSP(bf16_t, OFF_PPB) + (size_t)i * T * DM, ka->in[18] + (size_t)i * DM, WSP(float, OFF_XF), WSP(bf16_t, OFF_XB), i == DEPTH - 1 ? ka->out : nullptr};
            pg8::gemm_phase<pg8::EpiPle, pg8::DenseOrder, false, false>(lds + RING_OFF, DM, S, E);
        }
        SEAM(pb + 8);
    }
#undef IN
#undef SEAM
}
static int g_grid = 0;
extern "C" void kernel_launch(void* const* d_in, const int* in_sizes, int n_in, void* d_out, int out_size, void* d_ws, size_t ws_size, hipStream_t stream) {
    if (n_in != 19 || ws_size < WS_END || out_size != T * DM) { fprintf(stderr, "kernel_launch: unexpected arguments (n_in %d, ws %zu need %zu, out %d)\n", n_in, ws_size, (size_t)WS_END, out_size); return; }
    if (g_grid == 0) {
        int dev = 0, cus = 0;
        if (hipGetDevice(&dev) != hipSuccess || hipDeviceGetAttribute(&cus, hipDeviceAttributeMultiprocessorCount, dev) != hipSuccess) { g_grid = -1; return; }
        if (hipFuncSetAttribute((const void*)mega, hipFuncAttributeMaxDynamicSharedMemorySize, LDS_BYTES) != hipSuccess) { g_grid = -1; return; }
        int per_cu = 0; (void)hipOccupancyMaxActiveBlocksPerMultiprocessor(&per_cu, (const void*)mega, NWAVES * 64, LDS_BYTES); (void)hipGetLastError();
        if (per_cu < 1) fprintf(stderr, "kernel_launch: occupancy query reports %d workgroups per CU\n", per_cu);
        g_grid = cus;
    }
    if (g_grid < 0) return;
    (void)hipMemsetAsync((unsigned char*)d_ws + OFF_CTL, 0, MiB, stream);
    Args a{};
    for (int i = 0; i < 19; ++i) a.in[i] = (const float*)d_in[i];
    a.out = (float*)d_out; a.ws = (unsigned char*)d_ws; a.ph_lo = 0; a.ph_hi = 2 + 10 * DEPTH; a.bar_region = 0; a.pad = 0;
    hipLaunchKernelGGL(mega, dim3(g_grid), dim3(NWAVES * 64), LDS_BYTES, stream, a);
}
```

```cpp
#include <hip/hip_runtime.h>
#include <stdint.h>
#include <cstdio>

typedef unsigned short bf16_t;
typedef short bf16x8 __attribute__((ext_vector_type(8)));
typedef float f32x4 __attribute__((ext_vector_type(4)));
typedef unsigned u32x4 __attribute__((ext_vector_type(4)));
typedef unsigned u32x2 __attribute__((ext_vector_type(2)));

constexpr int DM = 1024, NB = 8, SEQ = 2048, DEPTH = 4, T = NB * SEQ;
constexpr int RH = 4, RDK = 256, RDV = 512, RIN = 6144, RHV = RH * RDV;
constexpr int SH = 16, SD = 64;
constexpr int NE = 32, TOPK = 4, DF = 1024, DPLE = 256;
constexpr int NSLOT = T * TOPK;
constexpr int RPAD = NSLOT + NE * 256;
constexpr float DN_ALPHA = 1.6817928305074290f;
constexpr float LN_EPS = 1e-5f, GN_EPS = 1e-6f;

constexpr size_t MiB = (size_t)1 << 20;
constexpr size_t al(size_t x) { return (x + 255) & ~(size_t)255; }
constexpr size_t OFF_CTL = 0;
constexpr size_t OFF_WRI = OFF_CTL + MiB;
constexpr size_t OFF_WRO = OFF_WRI + al((size_t)2 * RIN * DM * 2);
constexpr size_t OFF_WSI = OFF_WRO + al((size_t)2 * DM * RHV * 2);
constexpr size_t OFF_WSO = OFF_WSI + al((size_t)2 * 3 * DM * DM * 2);
constexpr size_t OFF_WPG = OFF_WSO + al((size_t)2 * DM * DM * 2);
constexpr size_t OFF_WPW = OFF_WPG + al((size_t)4 * DM * DM * 2);
constexpr size_t OFF_WGU = OFF_WPW + al((size_t)4 * DM * DPLE * 2);
constexpr size_t OFF_WDN = OFF_WGU + al((size_t)128 * 2 * DF * DM * 2);
constexpr size_t OFF_PB  = OFF_WDN + al((size_t)128 * DM * DF * 2);
constexpr size_t OFF_XF  = OFF_PB  + al((size_t)4 * T * DPLE * 2);
constexpr size_t OFF_XB  = OFF_XF  + al((size_t)T * DM * 4);
constexpr size_t OFF_X1F = OFF_XB  + al((size_t)T * DM * 2);
constexpr size_t OFF_X1B = OFF_X1F + al((size_t)T * DM * 4);
constexpr size_t OFF_X2F = OFF_X1B + al((size_t)T * DM * 2);
constexpr size_t OFF_X2B = OFF_X2F + al((size_t)T * DM * 4);
constexpr size_t OFF_MIX = OFF_X2B + al((size_t)T * DM * 2);
constexpr size_t OFF_Q   = OFF_MIX + al((size_t)T * DM * 4);
constexpr size_t OFF_K   = OFF_Q   + al((size_t)T * DM * 2);
constexpr size_t OFF_V   = OFF_K   + al((size_t)T * DM * 2);
constexpr size_t OFF_G   = OFF_V   + al((size_t)T * RHV * 2);
constexpr size_t OFF_RO  = OFF_G   + al((size_t)T * RHV * 2);
constexpr size_t OFF_GN  = OFF_RO  + al((size_t)T * RHV * 4);
constexpr size_t OFF_ACT = OFF_GN  + al((size_t)T * RHV * 2);
constexpr size_t OFF_YB  = OFF_ACT + al((size_t)RPAD * DF * 2);
constexpr size_t OFF_PPB = OFF_YB  + al((size_t)NSLOT * DM * 2);
constexpr size_t OFF_EL  = OFF_PPB + al((size_t)4 * T * DM * 2);
constexpr size_t OFF_GT  = OFF_EL  + al((size_t)NE * T * 4);
constexpr size_t OFF_ROPE= OFF_GT  + al((size_t)NSLOT * 4);
constexpr size_t OFF_PROJ= OFF_ROPE+ al((size_t)SEQ * 128 * 2 * 4);
constexpr size_t WS_END  = OFF_PROJ+ al((size_t)T * RIN * 4);
constexpr int CW_CNT = 64;

__device__ __forceinline__ unsigned f2bf(float f) { unsigned u = __float_as_uint(f); return (u + 0x7fffu + ((u >> 16) & 1u)) >> 16; }
__device__ __forceinline__ unsigned pk2(float lo, float hi) { return f2bf(lo) | (f2bf(hi) << 16); }
__device__ __forceinline__ float bf2f(unsigned b) { return __uint_as_float(b << 16); }
__device__ __forceinline__ float wave_sum(float v) {
#pragma unroll
    for (int o = 1; o < 64; o <<= 1) v += __shfl_xor(v, o);
    return v;
}
__device__ __forceinline__ float sigmoidf_(float x) { return 1.0f / (1.0f + __expf(-x)); }

#define LAS __attribute__((address_space(3)))
#define GAS __attribute__((address_space(1)))
namespace pg8 {
constexpr int BM = 256, BK = 64, HALF = 128, HTB = HALF * BK * 2  , STAGE_BYTES = 8 * HTB, NXCD = 8, WGM = 8;
__host__ __device__ __forceinline__ int lds_byte(int r, int c) { const int st = (r >> 4) * 2 + (c >> 5), rr = r & 15, cc = c & 31, ob = rr * 64 + cc * 2; return st * 1024 + (ob ^ (((ob >> 9) & 1) << 5)); }
__host__ __device__ __forceinline__ void stage_rc(int b, int& R, int& C) { const int st = b / 1024, sb = b % 1024, swz = sb ^ (((sb >> 9) & 1) << 5); R = (st >> 1) * 16 + swz / 64; C = (st & 1) * 32 + (swz % 64) / 2; }
__host__ __device__ __forceinline__ int perm32(int rho) { const int n = rho >> 4, i = rho & 15; return 8 * (i >> 2) + 4 * n + (i & 3); }
struct Unit { int pm, pn, e, lrow0, nvalid; };
typedef float f32x2_t __attribute__((ext_vector_type(2))); typedef __bf16 bf16x2_t __attribute__((ext_vector_type(2)));
__device__ __forceinline__ unsigned cvt_pk_bf16(float lo, float hi) { f32x2_t v = {lo, hi}; bf16x2_t b = __builtin_convertvector(v, bf16x2_t); return __builtin_bit_cast(unsigned, b); }

struct DenseOrder {
    int nM, nN, nwg, G, c; const char* A; const char* Bt; size_t tstep;
    __device__ void init(int M, int N, int K, int G_, int c_, const void* A_, const void* Bt_) { nM = M / BM; nN = N / BM; nwg = nM * nN; G = G_; c = c_; A = (const char*)A_; Bt = (const char*)Bt_; tstep = (size_t)BM * K * 2; }
    __device__ bool next(int i, Unit& u) const {
        const long L = (long)i * G + c; if (L >= nwg) return false;
        int wgid = (int)L; { const int q = nwg / NXCD, r = nwg % NXCD, xcd = wgid % NXCD, off = wgid / NXCD; wgid = (xcd < r ? xcd * (q + 1) : r * (q + 1) + (xcd - r) * q) + off; }
        const int nig = WGM * nN, gid = wgid / nig, fm = gid * WGM, gsz = (nM - fm) < WGM ? (nM - fm) : WGM;
        u.pm = fm + ((wgid % nig) % gsz); u.pn = (wgid % nig) / gsz; u.e = 0; u.lrow0 = 0; u.nvalid = BM; return true;
    }
    __device__ __forceinline__ const char* a_base(const Unit& u) const { return A + (size_t)u.pm * tstep; }
    __device__ __forceinline__ const char* b_base(const Unit& u) const { return Bt + (size_t)u.pn * tstep; }
    __device__ __forceinline__ unsigned a_row(const Unit&, int) const { return 0u; }
    LAS unsigned* roff;
};
struct EpiF32 {
    static constexpr bool PERM = false;
    float* C; int ldc;
    __device__ __forceinline__ void operator()(const f32x4 (&acc)[2][2][4][2], const Unit& u, int wr, int wc, int fr, int fq) const {
        const int row0 = u.pm * BM + wr * 64 + fr, col0 = u.pn * BM + wc * 32 + 4 * fq;
#pragma unroll
        for (int ai = 0; ai < 2; ++ai)
#pragma unroll
            for (int m = 0; m < 4; ++m) { float* rowp = C + (size_t)(row0 + ai * HALF + m * 16) * ldc + col0;
#pragma unroll
                for (int bj = 0; bj < 2; ++bj)
#pragma unroll
                    for (int n = 0; n < 2; ++n) *(f32x4*)(rowp + bj * HALF + n * 16) = acc[ai][bj][m][n]; }
    }
};
struct EpiBf16 {
    static constexpr bool PERM = true;
    bf16_t* O; int ldc; int split_cols; size_t split_stride; float scale0; size_t estride;
    __device__ __forceinline__ void operator()(const f32x4 (&acc)[2][2][4][2], const Unit& u, int wr, int wc, int fr, int fq) const {
        const int row0 = u.pm * BM + wr * 64 + fr; int colt = u.pn * BM; bf16_t* base = O + (size_t)u.e * estride;
        float sc = 1.f; if (split_cols) { const int t = colt / split_cols; base += (size_t)t * split_stride; colt -= t * split_cols; if (t == 0) sc = scale0; }
        const int col0 = colt + wc * 32 + 8 * fq;
#pragma unroll
        for (int ai = 0; ai < 2; ++ai)
#pragma unroll
            for (int m = 0; m < 4; ++m) { bf16_t* rowp = base + (size_t)(row0 + ai * HALF + m * 16) * ldc + col0;
#pragma unroll
                for (int bj = 0; bj < 2; ++bj) { const f32x4 v0 = acc[ai][bj][m][0] * sc, v1 = acc[ai][bj][m][1] * sc;
                    u32x4 w; w.x = cvt_pk_bf16(v0[0], v0[1]); w.y = cvt_pk_bf16(v0[2], v0[3]); w.z = cvt_pk_bf16(v1[0], v1[1]); w.w = cvt_pk_bf16(v1[2], v1[3]);
                    *(u32x4*)(rowp + bj * HALF) = w; } }
    }
};
struct EpiRetProj {
    static constexpr bool PERM = true;
    bf16_t *Q, *Kk, *V, *G; const float* rope;
    __device__ __forceinline__ void operator()(const f32x4 (&acc)[2][2][4][2], const Unit& u, int wr, int wc, int fr, int fq) const {
        const int row0 = u.pm * BM + wr * 64 + fr, pn = u.pn;
        if (pn < 8) {
            const int h = pn & 3; bf16_t* dst = pn < 4 ? Q : Kk; const float sc = pn < 4 ? 1.0f : 0.0625f; const int d0 = wc * 32 + 8 * fq;
#pragma unroll
            for (int ai = 0; ai < 2; ++ai)
#pragma unroll
                for (int m = 0; m < 4; ++m) { const int r = row0 + ai * HALF + m * 16, pos = r & (SEQ - 1);
                    const f32x4* rp = (const f32x4*)(rope + ((size_t)pos * 128 + d0) * 2);
                    const f32x4 t0 = rp[0], t1 = rp[1], t2 = rp[2], t3 = rp[3];
                    const f32x4 xa = acc[ai][0][m][0], xb = acc[ai][0][m][1], ya = acc[ai][1][m][0], yb = acc[ai][1][m][1];
                    u32x4 w1, w2;
                    w1.x = cvt_pk_bf16((xa[0] * t0[0] - ya[0] * t0[1]) * sc, (xa[1] * t0[2] - ya[1] * t0[3]) * sc); w1.y = cvt_pk_bf16((xa[2] * t1[0] - ya[2] * t1[1]) * sc, (xa[3] * t1[2] - ya[3] * t1[3]) * sc);
                    w1.z = cvt_pk_bf16((xb[0] * t2[0] - yb[0] * t2[1]) * sc, (xb[1] * t2[2] - yb[1] * t2[3]) * sc); w1.w = cvt_pk_bf16((xb[2] * t3[0] - yb[2] * t3[1]) * sc, (xb[3] * t3[2] - yb[3] * t3[3]) * sc);
                    w2.x = cvt_pk_bf16((xa[0] * t0[1] + ya[0] * t0[0]) * sc, (xa[1] * t0[3] + ya[1] * t0[2]) * sc); w2.y = cvt_pk_bf16((xa[2] * t1[1] + ya[2] * t1[0]) * sc, (xa[3] * t1[3] + ya[3] * t1[2]) * sc);
                    w2.z = cvt_pk_bf16((xb[0] * t2[1] + yb[0] * t2[0]) * sc, (xb[1] * t2[3] + yb[1] * t2[2]) * sc); w2.w = cvt_pk_bf16((xb[2] * t3[1] + yb[2] * t3[0]) * sc, (xb[3] * t3[3] + yb[3] * t3[2]) * sc);
                    bf16_t* o = dst + (size_t)r * DM + h * RDK + d0;
                    *(u32x4*)o = w1; *(u32x4*)(o + 128) = w2; }
        } else {
            bf16_t* dst = pn < 16 ? V : G; const int cb = (pn < 16 ? pn - 8 : pn - 16) * BM + wc * 32 + 8 * fq;
#pragma unroll
            for (int ai = 0; ai < 2; ++ai)
#pragma unroll
                for (int m = 0; m < 4; ++m) { bf16_t* rowp = dst + (size_t)(row0 + ai * HALF + m * 16) * RHV + cb;
#pragma unroll
                    for (int bj = 0; bj < 2; ++bj) { const f32x4 v0 = acc[ai][bj][m][0], v1 = acc[ai][bj][m][1];
                        u32x4 w; w.x = cvt_pk_bf16(v0[0], v0[1]); w.y = cvt_pk_bf16(v0[2], v0[3]); w.z = cvt_pk_bf16(v1[0], v1[1]); w.w = cvt_pk_bf16(v1[2], v1[3]);
                        *(u32x4*)(rowp + bj * HALF) = w; } }
        }
    }
};
struct EpiPle {
    static constexpr bool PERM = false;
    const float* x2f; const bf16_t* pp; const float* bg; float* xf; bf16_t* xb; float* out;
    __device__ __forceinline__ void operator()(const f32x4 (&acc)[2][2][4][2], const Unit& u, int wr, int wc, int fr, int fq) const {
        const int row0 = u.pm * BM + wr * 64 + fr, col0 = u.pn * BM + wc * 32 + 4 * fq;
#pragma unroll
        for (int ai = 0; ai < 2; ++ai)
#pragma unroll
            for (int m = 0; m < 4; ++m) { const size_t ro = (size_t)(row0 + ai * HALF + m * 16) * DM + col0;
#pragma unroll
                for (int bj = 0; bj < 2; ++bj)
#pragma unroll
                    for (int n = 0; n < 2; ++n) { const size_t o = ro + bj * HALF + n * 16; const int c = col0 + bj * HALF + n * 16;
                        const f32x4 x = *(const f32x4*)(x2f + o), b = *(const f32x4*)(bg + c), a = acc[ai][bj][m][n]; const u32x2 pw = *(const u32x2*)(pp + o);
                        f32x4 r;
                        r[0] = x[0] + bf2f(pw.x & 0xffffu) / (1.0f + __expf(-(a[0] + b[0]))); r[1] = x[1] + bf2f(pw.x >> 16) / (1.0f + __expf(-(a[1] + b[1])));
                        r[2] = x[2] + bf2f(pw.y & 0xffffu) / (1.0f + __expf(-(a[2] + b[2]))); r[3] = x[3] + bf2f(pw.y >> 16) / (1.0f + __expf(-(a[3] + b[3])));
                        *(f32x4*)(xf + o) = r; u32x2 w; w.x = cvt_pk_bf16(r[0], r[1]); w.y = cvt_pk_bf16(r[2], r[3]); *(u32x2*)(xb + o) = w;
                        if (out) *(f32x4*)(out + o) = r; } }
    }
};

template <class Epi, class Sched, bool ALIGN_EPI, bool GATHER>
__device__ __forceinline__ void gemm_phase(LAS unsigned char* lds, const int Kin, const Sched& S, const Epi& E) {
    int tid = threadIdx.x; asm volatile("" : "+v"(tid));
    const int wid = __builtin_amdgcn_readfirstlane(tid >> 6), lane = tid & 63, wr = wid >> 2, wc = wid & 3, fr = lane & 15, fq = lane >> 4;
    int K = __builtin_amdgcn_readfirstlane(Kin); asm volatile("" : "+s"(K));
    const int nt = K / BK;
    unsigned voffB[2], voffA[2], vG[2][2];
#pragma unroll
    for (int i = 0; i < 2; ++i) { int R, C; stage_rc(tid * 16 + i * 8192, R, C); const int Rb = Epi::PERM ? ((R & ~31) + perm32(R & 31)) : R;
        voffB[i] = (unsigned)(Rb * K + C) * 2u; voffA[i] = (unsigned)(R * K + C) * 2u; }
    const size_t kstep = (size_t)(BK * 2);
    const size_t hstep = (size_t)HALF * K * 2;
    const unsigned ldsw = (unsigned)wid * 1024u;
    const int aoff = lds_byte(wr * 64 + fr, fq * 8), boff = lds_byte(wc * 32 + fr, fq * 8);
#define PG8_SA(b, h) (((b) * 2 + (h)) * HTB)
#define PG8_SB(b, h) ((4 + (b) * 2 + (h)) * HTB)
#define PG8_STAGE(bufoff, gbase, voff) do { _Pragma("unroll") for (int _i = 0; _i < 2; ++_i) { unsigned _o = (voff)[_i]; if constexpr (GATHER) asm volatile("" : "+v"(_o)); \
        __builtin_amdgcn_global_load_lds((const unsigned*)((const char*)(gbase) + _o), (LAS unsigned*)(lds + (bufoff) + ldsw + _i * 8192), 16, 0, 0); } } while (0)
#define PG8_STAGEA(bufoff, gbase, h, vg) do { if constexpr (GATHER) { PG8_STAGE(bufoff, gbase, vg[h]); } else { PG8_STAGE(bufoff, (gbase) + (h) * hstep, voffA); } } while (0)
#define PG8_LDA(dst, b, h) do { _Pragma("unroll") for (int m = 0; m < 4; ++m) _Pragma("unroll") for (int k = 0; k < 2; ++k) dst[m][k] = *(const LAS bf16x8*)(lds + PG8_SA(b, h) + aoff + m * 2048 + k * 1024); } while (0)
#define PG8_LDB(dst, b, h) do { _Pragma("unroll") for (int n = 0; n < 2; ++n) _Pragma("unroll") for (int k = 0; k < 2; ++k) dst[n][k] = *(const LAS bf16x8*)(lds + PG8_SB(b, h) + boff + n * 2048 + k * 1024); } while (0)
#define PG8_MMA(ai, bj, At, Bt) do { __builtin_amdgcn_s_setprio(1); _Pragma("unroll") for (int m = 0; m < 4; ++m) _Pragma("unroll") for (int n = 0; n < 2; ++n) _Pragma("unroll") for (int k = 0; k < 2; ++k) \
        acc[ai][bj][m][n] = __builtin_amdgcn_mfma_f32_16x16x32_bf16(Bt[n][k], At[m][k], acc[ai][bj][m][n], 0, 0, 0); __builtin_amdgcn_s_setprio(0); } while (0)
#define PG8_WAIT_V(n) asm volatile("s_waitcnt vmcnt(" #n ")" ::: "memory")
#define PG8_WAIT_L(n) asm volatile("s_waitcnt lgkmcnt(" #n ")" ::: "memory")
#define PG8_BAR __builtin_amdgcn_s_barrier()
#define PG8_SCHED __builtin_amdgcn_sched_barrier(0)
#define PG8_TABLE(u) do { if (wid < 4) { S.roff[tid] = S.a_row(u, tid) * (unsigned)(K * 2); } } while (0)
#define PG8_GREAD(dst) do { _Pragma("unroll") for (int _i = 0; _i < 2; ++_i) { int _R, _C; stage_rc(tid * 16 + _i * 8192, _R, _C); _Pragma("unroll") for (int _h = 0; _h < 2; ++_h) dst[_h][_i] = S.roff[_h * HALF + _R] + (unsigned)_C * 2u; } } while (0)
    Unit cur, nxt; int ui = 0;
    if (!S.next(0, cur)) return;
    f32x4 acc[2][2][4][2];
#pragma unroll
    for (int a = 0; a < 2; ++a)
#pragma unroll
        for (int b = 0; b < 2; ++b)
#pragma unroll
            for (int m = 0; m < 4; ++m)
#pragma unroll
                for (int n = 0; n < 2; ++n) acc[a][b][m][n] = (f32x4){0.f, 0.f, 0.f, 0.f};
    bf16x8 At[4][2], B0[2][2], B1[2][2];
    const char* cA = S.a_base(cur); const char* cB = S.b_base(cur);
    if constexpr (GATHER) { PG8_TABLE(cur); asm volatile("s_waitcnt vmcnt(0) lgkmcnt(0)" ::: "memory"); __builtin_amdgcn_s_barrier(); asm volatile("" ::: "memory"); PG8_GREAD(vG); }
    PG8_STAGE(PG8_SB(0, 0), cB, voffB); PG8_STAGE(PG8_SB(0, 1), cB + hstep, voffB); PG8_STAGEA(PG8_SA(0, 0), cA, 0, vG); PG8_STAGEA(PG8_SA(0, 1), cA, 1, vG);
    if (wr == 1) PG8_BAR;
    PG8_WAIT_V(2); PG8_BAR;
    PG8_STAGE(PG8_SB(1, 0), cB + kstep, voffB); PG8_STAGEA(PG8_SA(1, 0), cA + kstep, 0, vG); PG8_STAGE(PG8_SB(1, 1), cB + hstep + kstep, voffB);
    PG8_WAIT_V(6); PG8_BAR;
    for (;;) {
        const bool has_next = S.next(ui + 1, nxt);
        const char* nA = has_next ? S.a_base(nxt) : cA; const char* nB = has_next ? S.b_base(nxt) : cB;
        for (int t = 0; t < nt; t += 2) {
            const bool last = (t == nt - 2);
            const char* a1 = cA + (size_t)(t + 1) * kstep;
            const char* a2 = last ? nA : cA + (size_t)(t + 2) * kstep; const char* b2 = last ? nB : cB + (size_t)(t + 2) * kstep;
            const char* a3 = a2 + kstep; const char* b3 = b2 + kstep;
            if constexpr (GATHER) { if (last && has_next) { PG8_TABLE(nxt); } }
            PG8_LDB(B0, 0, 0); PG8_LDB(B1, 0, 1); PG8_SCHED; PG8_LDA(At, 0, 0); PG8_STAGEA(PG8_SA(1, 1), a1, 1, vG);
            PG8_WAIT_V(8); PG8_WAIT_L(0); PG8_BAR; PG8_MMA(0, 0, At, B0); PG8_MMA(0, 1, At, B1); PG8_BAR; PG8_SCHED;
            if constexpr (GATHER) { if (last && has_next) { PG8_GREAD(vG); } }
            PG8_LDA(At, 0, 1); PG8_STAGE(PG8_SB(0, 0), b2, voffB); PG8_STAGE(PG8_SB(0, 1), b2 + hstep, voffB); PG8_STAGEA(PG8_SA(0, 0), a2, 0, vG);
            PG8_WAIT_V(8); PG8_WAIT_L(0); PG8_BAR; PG8_MMA(1, 0, At, B0); PG8_MMA(1, 1, At, B1); PG8_BAR; PG8_SCHED;
            PG8_LDB(B0, 1, 0); PG8_LDB(B1, 1, 1); PG8_SCHED; PG8_LDA(At, 1, 0); PG8_STAGEA(PG8_SA(0, 1), a2, 1, vG);
            PG8_WAIT_V(8); PG8_WAIT_L(0); PG8_BAR; PG8_MMA(0, 0, At, B0); PG8_MMA(0, 1, At, B1); PG8_BAR; PG8_SCHED;
            PG8_LDA(At, 1, 1); PG8_STAGE(PG8_SB(1, 0), b3, voffB); PG8_STAGE(PG8_SB(1, 1), b3 + hstep, voffB); PG8_STAGEA(PG8_SA(1, 0), a3, 0, vG);
            PG8_WAIT_V(8); PG8_WAIT_L(0); PG8_BAR; PG8_MMA(1, 0, At, B0); PG8_MMA(1, 1, At, B1); PG8_BAR; PG8_SCHED;
        }
        if constexpr (ALIGN_EPI) { if (wr == 0) PG8_BAR; }
        { int el = lane; asm volatile("" : "+v"(el));
          E(acc, cur, wr, wc, el & 15, el >> 4); }
        if (!has_next) break;
#pragma unroll
        for (int a = 0; a < 2; ++a)
#pragma unroll
            for (int b = 0; b < 2; ++b)
#pragma unroll
                for (int m = 0; m < 4; ++m)
#pragma unroll
                    for (int n = 0; n < 2; ++n) acc[a][b][m][n] = (f32x4){0.f, 0.f, 0.f, 0.f};
        cur = nxt; cA = nA; cB = nB; ++ui;
        if constexpr (ALIGN_EPI) { if (wr == 1) PG8_BAR; }
    }
    PG8_WAIT_V(0);
    if constexpr (!ALIGN_EPI) { if (wr == 0) PG8_BAR; }
    PG8_BAR;
#undef PG8_SA
#undef PG8_SB
#undef PG8_STAGE
#undef PG8_STAGEA
#undef PG8_LDA
#undef PG8_LDB
#undef PG8_MMA
#undef PG8_WAIT_V
#undef PG8_WAIT_L
#undef PG8_BAR
#undef PG8_SCHED
#undef PG8_TABLE
#undef PG8_GREAD
}
}
typedef float f32x2 __attribute__((ext_vector_type(2)));
constexpr int NWAVES = 8;
constexpr int RING_OFF = 0, RING_BYTES = 139264;
constexpr int LDSCTL_OFF = RING_BYTES, MISC_OFF = LDSCTL_OFF + 320;
constexpr int LDS_BYTES = 147456;
constexpr int CW_BAR = 4096;
typedef GAS unsigned gu32;
#define RLX_AGENT __ATOMIC_RELAXED, __HIP_MEMORY_SCOPE_AGENT

#define XB_TMO      128
#define XB_XCNT(j)  (256  + 64 * (j))
#define XB_XSUB(j)  (1280 + 64 * (j))
#define XB_XGEN(j)  (2304 + 64 * (j))
#define XB_TOP      3328
#define XB_TOPGEN   3392
#define XCD_BAR_WORDS 3456
#define XB_SPIN_CAP (1u << 18)
__device__ __forceinline__ unsigned xb_ld(unsigned* p)              { return __hip_atomic_load(p, __ATOMIC_RELAXED, __HIP_MEMORY_SCOPE_AGENT); }
__device__ __forceinline__ unsigned xb_add(unsigned* p, unsigned v) { return __hip_atomic_fetch_add(p, v, __ATOMIC_RELAXED, __HIP_MEMORY_SCOPE_AGENT); }
__device__ __forceinline__ unsigned xb_xcc_id() { return (unsigned)__builtin_amdgcn_s_getreg((3 << 11) | 20) & 0xFu; }
#define XB_SPIN(cond, bar) do { unsigned _sp = 0; while (cond) { __builtin_amdgcn_s_sleep(1); \
    if ((++_sp & 255u) == 0u) { if (xb_ld(&(bar)[XB_TMO])) break; if (_sp > XB_SPIN_CAP) { atomicAdd(&(bar)[XB_TMO], 1u); break; } } } } while (0)
struct XcdBarrier { unsigned* bar; unsigned x; volatile LAS unsigned* st; };
__device__ __forceinline__ XcdBarrier xcd_barrier_post(unsigned* bar, volatile LAS unsigned* st) {
    XcdBarrier b; b.bar = bar; b.x = xb_xcc_id(); b.st = st;
    if (threadIdx.x == 0) (void)xb_add(&bar[XB_XCNT(b.x)], 1u);
    return b;
}
__device__ __forceinline__ void xcd_barrier_complete(unsigned* bar, unsigned x, unsigned& nloc, unsigned& nx) {
    const unsigned G = gridDim.x * gridDim.y * gridDim.z;
    unsigned sum, cnt, mine, sp = 0u;
    for (;;) {
        sum = 0u; cnt = 0u; mine = 0u;
#pragma unroll
        for (unsigned j = 0; j < 16; ++j) { const unsigned c = xb_ld(&bar[XB_XCNT(j)]); sum += c; cnt += (c > 0u) ? 1u : 0u; mine = (j == x) ? c : mine; }
        if (sum == G) break;
        __builtin_amdgcn_s_sleep(1);
        if ((++sp & 255u) == 0u) { if (xb_ld(&bar[XB_TMO])) break; if (sp > XB_SPIN_CAP) { atomicAdd(&bar[XB_TMO], 1u); break; } }
    }
    nloc = mine > 0u ? mine : 1u; nx = cnt > 0u ? cnt : 1u;
}
__device__ __forceinline__ void xcd_barrier(const XcdBarrier& b) {
    asm volatile("s_waitcnt vmcnt(0)" ::: "memory");
    __syncthreads();
    if (threadIdx.x == 0) {
        unsigned* bar = b.bar;
        __builtin_amdgcn_s_waitcnt(0);
        unsigned nloc = b.st[0], nx = b.st[1];
        if (nloc == 0u) { xcd_barrier_complete(bar, b.x, nloc, nx); b.st[0] = nloc; b.st[1] = nx; }
        const unsigned old = xb_add(&bar[XB_XSUB(b.x)], 1u);
        const unsigned gen = old / nloc;
        if (old + 1u == (gen + 1u) * nloc) {
            __builtin_amdgcn_fence(__ATOMIC_RELEASE, "agent");
            asm volatile("s_waitcnt vmcnt(0)" ::: "memory");
            const unsigned og = xb_add(&bar[XB_TOP], 1u);
            const unsigned tg = og / nx;
            if (og + 1u == (tg + 1u) * nx) xb_add(&bar[XB_TOPGEN], 1u);
            else XB_SPIN(xb_ld(&bar[XB_TOPGEN]) == tg, bar);
            __builtin_amdgcn_fence(__ATOMIC_ACQUIRE, "agent");
            xb_add(&bar[XB_XGEN(b.x)], 1u);
            asm volatile("s_waitcnt vmcnt(0)" ::: "memory");
        } else {
            XB_SPIN(xb_ld(&bar[XB_XGEN(b.x)]) == gen, bar);
            __builtin_amdgcn_fence(__ATOMIC_ACQUIRE, "agent");
            asm volatile("s_waitcnt vmcnt(0)" ::: "memory");
        }
    }
    __syncthreads();
}

__device__ __forceinline__ void p0_transpose_item(const float* __restrict__ Wm, int K, int N, bf16_t* __restrict__ WTm, LAS float* scr, int item, int lane) {
    const int nblk = N / 32, kb = item / nblk, nbk = item % nblk, k0 = 64 * kb, n0 = 32 * nbk;
#pragma unroll 8
    for (int i = 0; i < 32; ++i) { const int kk = 2 * i + (lane >> 5); scr[kk * 33 + (lane & 31)] = Wm[(size_t)(k0 + kk) * N + n0 + (lane & 31)]; }
    asm volatile("s_waitcnt lgkmcnt(0)" ::: "memory");
    const int c = lane & 7;
#pragma unroll
    for (int j = 0; j < 4; ++j) { const int n = (lane >> 3) + 8 * j; const LAS float* s = scr + (8 * c) * 33 + n;
        u32x4 o; o.x = pk2(s[0 * 33], s[1 * 33]); o.y = pk2(s[2 * 33], s[3 * 33]); o.z = pk2(s[4 * 33], s[5 * 33]); o.w = pk2(s[6 * 33], s[7 * 33]);
        *(u32x4*)(WTm + (size_t)(n0 + n) * K + k0 + 8 * c) = o; }
    asm volatile("s_waitcnt lgkmcnt(0)" ::: "memory");
}
__device__ __forceinline__ void p0_transpose_all(const float* W, bf16_t* WT, int nb, int K, int N, LAS float* scr, int gw, int ngw, int lane) {
    const int per = (K / 64) * (N / 32); const long total = (long)nb * per;
    for (long it = gw; it < total; it += ngw) { const int mb = (int)(it / per), item = (int)(it % per);
        p0_transpose_item(W + (size_t)mb * K * N, K, N, WT + (size_t)mb * K * N, scr, item, lane); }
}

struct PPOrder {
    int G, c; const char* A; const char* Bt;
    __device__ bool next(int i, pg8::Unit& u) const { const int L = i * G + c; if (L >= 1024) return false; u.e = L >> 8; u.pm = (L & 255) >> 2; u.pn = L & 3; u.lrow0 = 0; u.nvalid = 256; return true; }
    __device__ __forceinline__ const char* a_base(const pg8::Unit& u) const { return A + ((size_t)u.e * T + (size_t)u.pm * 256) * DPLE * 2; }
    __device__ __forceinline__ const char* b_base(const pg8::Unit& u) const { return Bt + ((size_t)u.e * DM + (size_t)u.pn * 256) * DPLE * 2; }
    __device__ __forceinline__ unsigned a_row(const pg8::Unit&, int) const { return 0u; }
    LAS unsigned* roff;
};

constexpr int LDS_ROFF = LDSCTL_OFF + 2048;
constexpr int LDS_TP = LDSCTL_OFF + 1024;
struct MoeOrder {
    LAS unsigned* roff; int G, c, nN; const LAS int* tp; const LAS int* cn; const int* elist; const char* A; const char* Bt; size_t bstride_e; bool gather;
    static __device__ __forceinline__ void setup(LAS unsigned char* lds, const unsigned* cnt) {
        LAS int* tp = (LAS int*)(lds + LDS_TP); LAS int* cn = (LAS int*)(lds + LDS_TP + 256);
        __syncthreads();
        if (threadIdx.x == 0) { int a = 0; for (int e = 0; e < NE; ++e) { const int cc = (int)__hip_atomic_load(cnt + e, RLX_AGENT); cn[e] = cc; tp[e] = a; a += (cc + 255) >> 8; } tp[NE] = a; }
        __syncthreads();
    }
    __device__ bool next(int i, pg8::Unit& u) const {
        const int nwg = __builtin_amdgcn_readfirstlane(tp[NE]) * nN; const long L = (long)i * G + c; if (L >= nwg) return false;
        int wgid = (int)L; { const int q = nwg / 8, r = nwg % 8, xcd = wgid % 8, off = wgid / 8; wgid = (xcd < r ? xcd * (q + 1) : r * (q + 1) + (xcd - r) * q) + off; }
        int e = 0; while (wgid >= __builtin_amdgcn_readfirstlane(tp[e + 1]) * nN) ++e;
        const int t0 = __builtin_amdgcn_readfirstlane(tp[e]), t1 = __builtin_amdgcn_readfirstlane(tp[e + 1]), ce = __builtin_amdgcn_readfirstlane(cn[e]);
        const int w = wgid - t0 * nN, te = t1 - t0, m = w % te;
        u.pn = w / te; u.pm = t0 + m; u.e = e; u.lrow0 = m * 256; u.nvalid = ce - m * 256; return true;
    }
    __device__ __forceinline__ const char* a_base(const pg8::Unit& u) const { return gather ? A : A + (size_t)u.pm * 256 * DF * 2; }
    __device__ __forceinline__ const char* b_base(const pg8::Unit& u) const { return Bt + (size_t)u.e * bstride_e + (size_t)u.pn * 256 * DM * 2; }
    __device__ __forceinline__ unsigned a_row(const pg8::Unit& u, int r) const { return r < u.nvalid ? (unsigned)(elist[(size_t)u.e * T + u.lrow0 + r] >> 2) : 0u; }
};
namespace pg8 {
struct EpiMoe1 {
    static constexpr bool PERM = true;
    const float* bias; bf16_t* act;
    __device__ __forceinline__ void operator()(const f32x4 (&acc)[2][2][4][2], const Unit& u, int wr, int wc, int fr, int fq) const {
        const int colg = u.pn * BM + wc * 32 + 8 * fq; const float* bp = bias + (size_t)u.e * 2 * DF + colg;
        f32x4 bv[2][2];
#pragma unroll
        for (int bj = 0; bj < 2; ++bj)
#pragma unroll
            for (int n = 0; n < 2; ++n) bv[bj][n] = *(const f32x4*)(bp + bj * HALF + 4 * n);
#pragma unroll
        for (int ai = 0; ai < 2; ++ai)
#pragma unroll
            for (int m = 0; m < 4; ++m) { const int lr = ai * HALF + wr * 64 + m * 16 + fr; bf16_t* rowp = act + (size_t)(u.pm * BM + lr) * DF + (colg >> 1);
                if (lr < u.nvalid) {
#pragma unroll
                for (int bj = 0; bj < 2; ++bj) { const f32x4 v0 = acc[ai][bj][m][0] + bv[bj][0], v1 = acc[ai][bj][m][1] + bv[bj][1];
                    float a[4];
#pragma unroll
                    for (int q = 0; q < 4; ++q) { const float gt = fminf(q < 2 ? v0[2 * q] : v1[2 * q - 4], 7.0f), up = fminf(fmaxf(q < 2 ? v0[2 * q + 1] : v1[2 * q - 3], -7.0f), 7.0f);
                        a[q] = (up + 1.0f) * (gt / (1.0f + __expf(-1.702f * gt))); }
                    u32x2 w; w.x = cvt_pk_bf16(a[0], a[1]); w.y = cvt_pk_bf16(a[2], a[3]);
                    *(u32x2*)(rowp + bj * (HALF / 2)) = w; } } }
    }
};
struct EpiMoe2 {
    static constexpr bool PERM = true;
    const float* bias; bf16_t* yb; const int* elist;
    __device__ __forceinline__ void operator()(const f32x4 (&acc)[2][2][4][2], const Unit& u, int wr, int wc, int fr, int fq) const {
        const int col = u.pn * BM + wc * 32 + 8 * fq; const float* bp = bias + (size_t)u.e * DM + col;
        f32x4 bv[2][2];
#pragma unroll
        for (int bj = 0; bj < 2; ++bj)
#pragma unroll
            for (int n = 0; n < 2; ++n) bv[bj][n] = *(const f32x4*)(bp + bj * HALF + 4 * n);
#pragma unroll
        for (int ai = 0; ai < 2; ++ai)
#pragma unroll
            for (int m = 0; m < 4; ++m) { const int lr = ai * HALF + wr * 64 + m * 16 + fr;
                if (lr < u.nvalid) { const int slot = elist[(size_t)u.e * T + u.lrow0 + lr]; bf16_t* rowp = yb + (size_t)slot * DM + col;
#pragma unroll
                for (int bj = 0; bj < 2; ++bj) { const f32x4 v0 = acc[ai][bj][m][0] + bv[bj][0], v1 = acc[ai][bj][m][1] + bv[bj][1];
                    u32x4 w; w.x = cvt_pk_bf16(v0[0], v0[1]); w.y = cvt_pk_bf16(v0[2], v0[3]); w.z = cvt_pk_bf16(v1[0], v1[1]); w.w = cvt_pk_bf16(v1[2], v1[3]);
                    *(u32x4*)(rowp + bj * HALF) = w; } } }
    }
};
}

constexpr int RW_ST = 136;
__device__ __forceinline__ void ln1_router_pair(int t, int lane, LAS const unsigned char* wimg, const float* __restrict__ xf, const float* __restrict__ mix, const float* __restrict__ lg, const float* __restrict__ lb,
                                                const float* __restrict__ rb, float* __restrict__ x1f, bf16_t* __restrict__ x1b, unsigned* __restrict__ cnt, int* __restrict__ elist, float* __restrict__ gates) {
    f32x4 xa[4], xb[4];
#pragma unroll
    for (int r = 0; r < 2; ++r) {
        f32x4 y[4]; float s = 0.f; const size_t ro = (size_t)(t + r) * DM;
#pragma unroll
        for (int j = 0; j < 4; ++j) { const int c = 4 * lane + 256 * j; const f32x4 a = *(const f32x4*)(xf + ro + c), m = *(const f32x4*)(mix + ro + c);
            y[j] = a * DN_ALPHA + m; s += (y[j].x + y[j].y) + (y[j].z + y[j].w); }
        const float mean = wave_sum(s) * (1.0f / DM); float s2 = 0.f;
#pragma unroll
        for (int j = 0; j < 4; ++j) { y[j] = y[j] - mean; s2 += (y[j].x * y[j].x + y[j].y * y[j].y) + (y[j].z * y[j].z + y[j].w * y[j].w); }
        const float rstd = 1.0f / sqrtf(wave_sum(s2) * (1.0f / DM) + LN_EPS);
#pragma unroll
        for (int j = 0; j < 4; ++j) { const int c = 4 * lane + 256 * j; const f32x4 gv = *(const f32x4*)(lg + c), bv = *(const f32x4*)(lb + c);
            const f32x4 o = y[j] * rstd * gv + bv;
            *(f32x4*)(x1f + ro + c) = o; u32x2 pb; pb.x = pk2(o.x, o.y); pb.y = pk2(o.z, o.w); *(u32x2*)(x1b + ro + c) = pb;
            if (r == 0) xa[j] = o; else xb[j] = o; }
    }
    float a0[32], a1[32];
#pragma unroll
    for (int e = 0; e < 32; ++e) { a0[e] = 0.f; a1[e] = 0.f; }
#pragma unroll
    for (int j = 0; j < 4; ++j)
#pragma unroll
        for (int k = 0; k < 4; ++k) {
            const float x0 = xa[j][k], x1 = xb[j][k];
            LAS const unsigned char* wr = wimg + (k * 256 + lane + 64 * j) * RW_ST;
#pragma unroll
            for (int q = 0; q < 16; ++q) { const f32x2 w = *(LAS const f32x2*)(wr + 8 * q);
                a0[2 * q] += x0 * w.x; a0[2 * q + 1] += x0 * w.y; a1[2 * q] += x1 * w.x; a1[2 * q + 1] += x1 * w.y; }
            __builtin_amdgcn_sched_barrier(0);
        }
    float v[32];
    { const bool up = lane >= 32;
#pragma unroll
      for (int e = 0; e < 32; ++e) { const float mine = up ? a1[e] : a0[e], send = up ? a0[e] : a1[e]; v[e] = mine + __shfl_xor(send, 32); } }
#pragma unroll
    for (int n = 16; n >= 1; n >>= 1) { const bool up = (lane & n) != 0;
#pragma unroll
        for (int e = 0; e < n; ++e) { const float mine = up ? v[e + n] : v[e], send = up ? v[e] : v[e + n]; v[e] = mine + __shfl_xor(send, n); } }
    const int e = lane & 31, row = t + (lane >> 5);
    float vcur = v[0] + rb[e];
    float topv[4]; int topi[4];
#pragma unroll
    for (int kk = 0; kk < 4; ++kk) {
        float bv = vcur; int bi = e;
#pragma unroll
        for (int off = 1; off < 32; off <<= 1) { const float ov = __shfl_xor(bv, off); const int oi = __shfl_xor(bi, off); if (ov > bv || (ov == bv && oi < bi)) { bv = ov; bi = oi; } }
        topv[kk] = bv; topi[kk] = bi; if (e == bi) vcur = -INFINITY;
    }
    const float e1 = __expf(topv[1] - topv[0]), e2 = __expf(topv[2] - topv[0]), e3 = __expf(topv[3] - topv[0]);
    const float inv = 1.0f / (1.0f + e1 + e2 + e3);
    if (e < 4) {
        const int ee = e == 0 ? topi[0] : e == 1 ? topi[1] : e == 2 ? topi[2] : topi[3];
        const float gg = (e == 0 ? 1.0f : e == 1 ? e1 : e == 2 ? e2 : e3) * inv;
        const unsigned pos = __hip_atomic_fetch_add(cnt + ee, 1u, RLX_AGENT);
        elist[(size_t)ee * T + pos] = row * 4 + e; gates[row * 4 + e] = gg;
    }
}
__device__ __forceinline__ void ln2_row(int t, int lane, const float* __restrict__ x1f, const bf16_t* __restrict__ yb, const float* __restrict__ gates, const float* __restrict__ lg, const float* __restrict__ lb,
                                        float* __restrict__ x2f, bf16_t* __restrict__ x2b) {
    const float g0 = gates[t * 4], g1 = gates[t * 4 + 1], g2 = gates[t * 4 + 2], g3 = gates[t * 4 + 3];
    f32x4 y[4]; float s = 0.f;
#pragma unroll
    for (int j = 0; j < 4; ++j) { const int c = 4 * lane + 256 * j; const f32x4 a = *(const f32x4*)(x1f + (size_t)t * DM + c);
        f32x4 f = (f32x4){0.f, 0.f, 0.f, 0.f};
#pragma unroll
        for (int kk = 0; kk < 4; ++kk) { const u32x2 w = *(const u32x2*)(yb + (size_t)(t * 4 + kk) * DM + c); const float gk = kk == 0 ? g0 : kk == 1 ? g1 : kk == 2 ? g2 : g3;
            f.x += gk * bf2f(w.x & 0xffffu); f.y += gk * bf2f(w.x >> 16); f.z += gk * bf2f(w.y & 0xffffu); f.w += gk * bf2f(w.y >> 16); }
        y[j] = a * DN_ALPHA + f; s += (y[j].x + y[j].y) + (y[j].z + y[j].w); }
    const float mean = wave_sum(s) * (1.0f / DM); float s2 = 0.f;
#pragma unroll
    for (int j = 0; j < 4; ++j) { y[j] = y[j] - mean; s2 += (y[j].x * y[j].x + y[j].y * y[j].y) + (y[j].z * y[j].z + y[j].w * y[j].w); }
    const float rstd = 1.0f / sqrtf(wave_sum(s2) * (1.0f / DM) + LN_EPS);
#pragma unroll
    for (int j = 0; j < 4; ++j) { const int c = 4 * lane + 256 * j; const f32x4 gv = *(const f32x4*)(lg + c), bv = *(const f32x4*)(lb + c);
        const f32x4 o = y[j] * rstd * gv + bv;
        *(f32x4*)(x2f + (size_t)t * DM + c) = o; u32x2 pb; pb.x = pk2(o.x, o.y); pb.y = pk2(o.z, o.w); *(u32x2*)(x2b + (size_t)t * DM + c) = pb; }
}
typedef _Float16 f16x8 __attribute__((ext_vector_type(8)));
typedef float f32x16 __attribute__((ext_vector_type(16)));
typedef short s16x4 __attribute__((ext_vector_type(4)));
__device__ __forceinline__ s16x4 lds_tr16(LAS const unsigned char* p) { return __builtin_bit_cast(s16x4, __builtin_amdgcn_ds_read_tr16_b64_v4i16((LAS s16x4*)p)); }
__device__ __forceinline__ bf16x8 cat4(s16x4 a, s16x4 b) { return __builtin_shufflevector(a, b, 0, 1, 2, 3, 4, 5, 6, 7); }
__device__ __forceinline__ unsigned cvtpk_c(float lo, float hi) { return pg8::cvt_pk_bf16(lo, hi); }
__device__ __forceinline__ float fexp2(float x) { return __builtin_amdgcn_exp2f(x); }
__device__ __forceinline__ float flog2(float x) { return __builtin_amdgcn_logf(x); }

namespace sb {
constexpr int KST = 144, TILE_B = 64 * KST;
__device__ __forceinline__ void attn_phase(LAS unsigned char* lds, const bf16_t* __restrict__ Q, const bf16_t* __restrict__ K, const bf16_t* __restrict__ V, bf16_t* __restrict__ O, int G, int c) {
    int tid = threadIdx.x; asm volatile("" : "+v"(tid));
    const int wid = __builtin_amdgcn_readfirstlane(tid >> 6), lane = tid & 63, n = lane & 31, hi = lane >> 5;
    f16x8 U0, U1, ONE;
#pragma unroll
    for (int j = 0; j < 8; ++j) { const int jp = 8 * (j >> 2) + 4 * hi + (j & 3); U0[j] = (jp > n) ? (_Float16)1.0f : (_Float16)0.0f; U1[j] = (16 + jp > n) ? (_Float16)1.0f : (_Float16)0.0f; ONE[j] = (_Float16)1.0f; }
    const int srow = tid >> 3, sch = tid & 7;
    const int trq = (lane & 15) >> 2, trp = lane & 3, blk = (lane >> 4) & 1;
    for (int it = 0;; ++it) {
        const int L = it * G + c; if (L >= NB * SH * 8) break;
        const int bh = L >> 3, qp = L & 7, qt = ((L >> 8) & 1) ? 7 - qp : qp, b = bh >> 4, h = bh & 15;
        const size_t rowbase = (size_t)b * SEQ;
        const int q0 = qt * 256 + wid * 32;
        bf16x8 qf[4];
        { const bf16_t* qrow = Q + (rowbase + q0 + n) * DM + h * SD + 8 * hi;
#pragma unroll
          for (int ks = 0; ks < 4; ++ks) qf[ks] = *(const bf16x8*)(qrow + 16 * ks); }
        f32x16 o0, o1, carry;
#pragma unroll
        for (int r = 0; r < 16; ++r) { o0[r] = 0.f; o1[r] = 0.f; carry[r] = 0.f; }
        const int nkt = 4 * qt + 4;
        const bf16_t* kg = K + (rowbase + srow) * DM + h * SD + sch * 8; const bf16_t* vg = V + (rowbase + srow) * DM + h * SD + sch * 8;
        { const u32x4 kr = *(const u32x4*)(kg + (size_t)(nkt - 1) * 64 * DM), vr = *(const u32x4*)(vg + (size_t)(nkt - 1) * 64 * DM);
          *(LAS u32x4*)(lds + srow * KST + sch * 16) = kr; *(LAS u32x4*)(lds + 2 * TILE_B + srow * KST + sch * 16) = vr; }
        asm volatile("s_waitcnt lgkmcnt(0)" ::: "memory"); __builtin_amdgcn_s_barrier(); asm volatile("" ::: "memory");
        int cur = 0, par = 0, wdone = 0;
        LAS unsigned* flg = (LAS unsigned*)(lds + 4 * TILE_B);
        for (int kt = nkt - 1; kt >= 0; --kt) {
            if (kt != nkt - 1) { const unsigned f = lane < 8 ? flg[(par ^ 1) * 8 + lane] : 1u; if (__all(f != 0u)) break; }
            u32x4 kr, vr;
            if (kt > 0) { kr = *(const u32x4*)(kg + (size_t)(kt - 1) * 64 * DM); vr = *(const u32x4*)(vg + (size_t)(kt - 1) * 64 * DM); }
            LAS const unsigned char* kb = lds + cur * TILE_B; LAS const unsigned char* vb = lds + (2 + cur) * TILE_B;
#pragma unroll
            for (int sub = 1; sub >= 0; --sub) {
                const int key0 = kt * 64 + sub * 32;
                if (key0 <= q0 && !wdone) {
                    const bool diag = (key0 == q0);
                    f32x16 z;
#pragma unroll
                    for (int r = 0; r < 16; ++r) z[r] = 0.f;
                    { LAS const unsigned char* kp = kb + (sub * 32 + n) * KST + hi * 16;
#pragma unroll
                      for (int ks = 0; ks < 4; ++ks) { const bf16x8 kf = *(LAS const bf16x8*)(kp + ks * 32); z = __builtin_amdgcn_mfma_f32_32x32x16_bf16(kf, qf[ks], z, 0, 0, 0); } }
                    f16x8 lf0, lf1;
#pragma unroll
                    for (int r = 0; r < 16; ++r) {
                        const float zz = z[r];
                        float l = -(fmaxf(zz, 0.f) + flog2(1.0f + fexp2(-fabsf(zz))));
                        float zl = zz + l;
                        if (diag) { const bool valid = ((r & 3) + 8 * (r >> 2) + 4 * hi) < n; l = valid ? l : 0.f; zl = valid ? zl : -INFINITY; }
                        z[r] = zl;
                        if (r < 8) lf0[r] = (_Float16)l; else lf1[r - 8] = (_Float16)l;
                    }
                    f32x16 y = carry;
                    y = __builtin_amdgcn_mfma_f32_32x32x16_f16(U0, lf0, y, 0, 0, 0); y = __builtin_amdgcn_mfma_f32_32x32x16_f16(U1, lf1, y, 0, 0, 0);
                    carry = __builtin_amdgcn_mfma_f32_32x32x16_f16(ONE, lf0, carry, 0, 0, 0); carry = __builtin_amdgcn_mfma_f32_32x32x16_f16(ONE, lf1, carry, 0, 0, 0);
                    bf16x8 pf0, pf1;
                    { unsigned w[8];
#pragma unroll
                      for (int r2 = 0; r2 < 8; ++r2) w[r2] = cvtpk_c(fexp2(z[2 * r2] + y[2 * r2]), fexp2(z[2 * r2 + 1] + y[2 * r2 + 1]));
                      pf0 = __builtin_bit_cast(bf16x8, (u32x4){w[0], w[1], w[2], w[3]}); pf1 = __builtin_bit_cast(bf16x8, (u32x4){w[4], w[5], w[6], w[7]}); }
                    LAS const unsigned char* vp = vb + (sub * 32 + 4 * hi + trq) * KST + (16 * blk + 4 * trp) * 2;
#pragma unroll
                    for (int s = 0; s < 2; ++s) {
                        const bf16x8 va = cat4(lds_tr16(vp + (16 * s) * KST), lds_tr16(vp + (16 * s + 8) * KST));
                        const bf16x8 vc = cat4(lds_tr16(vp + (16 * s) * KST + 64), lds_tr16(vp + (16 * s + 8) * KST + 64));
                        o0 = __builtin_amdgcn_mfma_f32_32x32x16_bf16(va, s ? pf1 : pf0, o0, 0, 0, 0);
                        o1 = __builtin_amdgcn_mfma_f32_32x32x16_bf16(vc, s ? pf1 : pf0, o1, 0, 0, 0);
                    }
                    if (__all(carry[0] < -160.0f)) wdone = 1;
                }
            }
            if (lane == 0) flg[par * 8 + wid] = (unsigned)wdone;
            if (kt > 0) { *(LAS u32x4*)(lds + (cur ^ 1) * TILE_B + srow * KST + sch * 16) = kr; *(LAS u32x4*)(lds + (2 + (cur ^ 1)) * TILE_B + srow * KST + sch * 16) = vr; }
            asm volatile("s_waitcnt lgkmcnt(0)" ::: "memory"); __builtin_amdgcn_s_barrier(); asm volatile("" ::: "memory");
            cur ^= 1; par ^= 1;
        }
        bf16_t* orow = O + (rowbase + q0 + n) * DM + h * SD + 4 * hi;
#pragma unroll
        for (int g4 = 0; g4 < 4; ++g4) {
            u32x2 w0, w1; w0.x = pg8::cvt_pk_bf16(o0[4 * g4], o0[4 * g4 + 1]); w0.y = pg8::cvt_pk_bf16(o0[4 * g4 + 2], o0[4 * g4 + 3]);
            w1.x = pg8::cvt_pk_bf16(o1[4 * g4], o1[4 * g4 + 1]); w1.y = pg8::cvt_pk_bf16(o1[4 * g4 + 2], o1[4 * g4 + 3]);
            *(u32x2*)(orow + 8 * g4) = w0; *(u32x2*)(orow + 32 + 8 * g4) = w1; }
    }
}
}

namespace ret {
constexpr int QST = 528, VST = 144;
constexpr int O_Q = 0, O_K = 64 * QST, O_ST = 2 * 64 * QST, O_V = 3 * 64 * QST, O_VD = O_V + 64 * VST, O_P = O_VD + 64 * VST, LDS_END = O_P + 64 * VST;
static_assert(LDS_END <= 131072, "retention LDS");
__device__ __forceinline__ void scan_phase(LAS unsigned char* lds, const bf16_t* __restrict__ Q, const bf16_t* __restrict__ K, const bf16_t* __restrict__ V, float* __restrict__ RO, int G, int c) {
    int tid = threadIdx.x; asm volatile("" : "+v"(tid));
    const int wid = __builtin_amdgcn_readfirstlane(tid >> 6), lane = tid & 63, lr = lane & 15, g = lane >> 4;
    const int trq = (lane & 15) >> 2, trp = lane & 3;
    const int tqt = wid >> 1, e2 = 2 * (wid & 1);
    for (int it = 0;; ++it) {
        const int L = it * G + c; if (L >= NB * RH * 8) break;
        const int bh = (L & 7) * 4 + (L >> 6), es = (L >> 3) & 7, b = bh >> 2, h = bh & 3;
        const size_t rowbase = (size_t)b * SEQ;
        const float lg2 = flog2(1.0f - fexp2(-5.0f - (float)h));
        const float cdec = fexp2(lg2 * 64.0f);
        f32x4 S[2][4];
#pragma unroll
        for (int a = 0; a < 2; ++a)
#pragma unroll
            for (int e = 0; e < 4; ++e) S[a][e] = (f32x4){0.f, 0.f, 0.f, 0.f};
        const bf16_t* qg = Q + (rowbase + (tid >> 5)) * DM + h * RDK + (tid & 31) * 8; const bf16_t* kg = K + (rowbase + (tid >> 5)) * DM + h * RDK + (tid & 31) * 8;
        const bf16_t* vg = V + (rowbase + (tid >> 3)) * RHV + h * RDV + es * 64 + (tid & 7) * 8;
        const int sq = (tid >> 5) * QST + (tid & 31) * 16, sv = (tid >> 3) * VST + (tid & 7) * 16;
        const float kdv = fexp2(lg2 * (float)(63 - (tid >> 3)));
        u32x4 rq[4], rk[4], rv;
#pragma unroll
        for (int i = 0; i < 4; ++i) { rq[i] = *(const u32x4*)(qg + (size_t)(16 * i) * DM); rk[i] = *(const u32x4*)(kg + (size_t)(16 * i) * DM); }
        rv = *(const u32x4*)vg;
        __builtin_amdgcn_s_barrier();
        for (int ci = 0; ci < SEQ / 64; ++ci) {
#pragma unroll
            for (int i = 0; i < 4; ++i) { *(LAS u32x4*)(lds + O_Q + sq + 16 * i * QST) = rq[i]; *(LAS u32x4*)(lds + O_K + sq + 16 * i * QST) = rk[i]; }
            { *(LAS u32x4*)(lds + O_V + sv) = rv;
              u32x4 d; d.x = pk2(bf2f(rv.x & 0xffffu) * kdv, bf2f(rv.x >> 16) * kdv); d.y = pk2(bf2f(rv.y & 0xffffu) * kdv, bf2f(rv.y >> 16) * kdv);
              d.z = pk2(bf2f(rv.z & 0xffffu) * kdv, bf2f(rv.z >> 16) * kdv); d.w = pk2(bf2f(rv.w & 0xffffu) * kdv, bf2f(rv.w >> 16) * kdv);
              *(LAS u32x4*)(lds + O_VD + sv) = d; }
#pragma unroll
            for (int a = 0; a < 2; ++a)
#pragma unroll
                for (int e = 0; e < 4; ++e) { u32x2 w; w.x = pg8::cvt_pk_bf16(S[a][e][0], S[a][e][1]); w.y = pg8::cvt_pk_bf16(S[a][e][2], S[a][e][3]);
                    *(LAS u32x2*)(lds + O_ST + (16 * e + lr) * QST + (32 * wid + 16 * a + 4 * g) * 2) = w; }
            asm volatile("s_waitcnt lgkmcnt(0)" ::: "memory"); __builtin_amdgcn_s_barrier(); asm volatile("" ::: "memory");
            if (ci + 1 < SEQ / 64) {
#pragma unroll
                for (int i = 0; i < 4; ++i) { rq[i] = *(const u32x4*)(qg + (size_t)((ci + 1) * 64 + 16 * i) * DM); rk[i] = *(const u32x4*)(kg + (size_t)((ci + 1) * 64 + 16 * i) * DM); }
                rv = *(const u32x4*)(vg + (size_t)(ci + 1) * 64 * RHV);
            }
            f32x4 pacc[2], oacc[2];
#pragma unroll
            for (int x = 0; x < 2; ++x) { pacc[x] = (f32x4){0.f, 0.f, 0.f, 0.f}; oacc[x] = (f32x4){0.f, 0.f, 0.f, 0.f}; }
            { LAS const unsigned char* qp = lds + O_Q + (16 * tqt + lr) * QST + 16 * g;
              LAS const unsigned char* kp = lds + O_K + (16 * e2 + lr) * QST + 16 * g;
              LAS const unsigned char* sp = lds + O_ST + (16 * e2 + lr) * QST + 16 * g;
#pragma unroll
              for (int ks = 0; ks < 8; ++ks) {
                  const bf16x8 qa = *(LAS const bf16x8*)(qp + 64 * ks);
                  const bf16x8 k0 = *(LAS const bf16x8*)(kp + 64 * ks), k1 = *(LAS const bf16x8*)(kp + 16 * QST + 64 * ks);
                  const bf16x8 s0 = *(LAS const bf16x8*)(sp + 64 * ks), s1 = *(LAS const bf16x8*)(sp + 16 * QST + 64 * ks);
                  pacc[0] = __builtin_amdgcn_mfma_f32_16x16x32_bf16(k0, qa, pacc[0], 0, 0, 0); pacc[1] = __builtin_amdgcn_mfma_f32_16x16x32_bf16(k1, qa, pacc[1], 0, 0, 0);
                  oacc[0] = __builtin_amdgcn_mfma_f32_16x16x32_bf16(qa, s0, oacc[0], 0, 0, 0); oacc[1] = __builtin_amdgcn_mfma_f32_16x16x32_bf16(qa, s1, oacc[1], 0, 0, 0);
              } }
#pragma unroll
            for (int x = 0; x < 2; ++x) { float pv[4];
#pragma unroll
                for (int i = 0; i < 4; ++i) { const int dist = (16 * tqt + lr) - (16 * (e2 + x) + 4 * g + i); pv[i] = pacc[x][i] * fexp2(lg2 * fabsf((float)dist)); }
                u32x2 w; w.x = pg8::cvt_pk_bf16(pv[0], pv[1]); w.y = pg8::cvt_pk_bf16(pv[2], pv[3]);
                *(LAS u32x2*)(lds + O_P + (16 * tqt + lr) * VST + (16 * (e2 + x) + 4 * g) * 2) = w; }
#pragma unroll
            for (int i = 0; i < 4; ++i) { const float qd = fexp2(lg2 * (float)(16 * tqt + 4 * g + i + 1)); oacc[0][i] *= qd; oacc[1][i] *= qd; }
            asm volatile("s_waitcnt lgkmcnt(0)" ::: "memory"); __builtin_amdgcn_s_barrier(); asm volatile("" ::: "memory");
            { LAS const unsigned char* pp = lds + O_P + (16 * tqt + lr) * VST + 16 * g;
              LAS const unsigned char* vp = lds + O_V + (8 * g + trq) * VST + (16 * e2 + 4 * trp) * 2;
#pragma unroll
              for (int ks = 0; ks < 2; ++ks) {
                  const bf16x8 pa = *(LAS const bf16x8*)(pp + 64 * ks);
                  const bf16x8 v0 = cat4(lds_tr16(vp + (32 * ks) * VST), lds_tr16(vp + (32 * ks + 4) * VST));
                  const bf16x8 v1 = cat4(lds_tr16(vp + (32 * ks) * VST + 32), lds_tr16(vp + (32 * ks + 4) * VST + 32));
                  oacc[0] = __builtin_amdgcn_mfma_f32_16x16x32_bf16(pa, v0, oacc[0], 0, 0, 0); oacc[1] = __builtin_amdgcn_mfma_f32_16x16x32_bf16(pa, v1, oacc[1], 0, 0, 0);
              } }
            { float* op = RO + (rowbase + ci * 64 + 16 * tqt + 4 * g) * RHV + h * RDV + es * 64 + 16 * e2 + lr;
#pragma unroll
              for (int i = 0; i < 4; ++i) { op[(size_t)i * RHV] = oacc[0][i]; op[(size_t)i * RHV + 16] = oacc[1][i]; } }
#pragma unroll
            for (int a = 0; a < 2; ++a)
#pragma unroll
                for (int e = 0; e < 4; ++e) S[a][e] = S[a][e] * cdec;
            { LAS const unsigned char* ktp = lds + O_K + (8 * g + trq) * QST + (32 * wid + 4 * trp) * 2;
              LAS const unsigned char* vtp = lds + O_VD + (8 * g + trq) * VST + (4 * trp) * 2;
#pragma unroll
              for (int ks = 0; ks < 2; ++ks) {
                  bf16x8 ka[2], vb[4];
#pragma unroll
                  for (int a = 0; a < 2; ++a) ka[a] = cat4(lds_tr16(ktp + (32 * ks) * QST + 32 * a), lds_tr16(ktp + (32 * ks + 4) * QST + 32 * a));
#pragma unroll
                  for (int e = 0; e < 4; ++e) vb[e] = cat4(lds_tr16(vtp + (32 * ks) * VST + 32 * e), lds_tr16(vtp + (32 * ks + 4) * VST + 32 * e));
#pragma unroll
                  for (int a = 0; a < 2; ++a)
#pragma unroll
                      for (int e = 0; e < 4; ++e) S[a][e] = __builtin_amdgcn_mfma_f32_16x16x32_bf16(ka[a], vb[e], S[a][e], 0, 0, 0);
              } }
            asm volatile("s_waitcnt lgkmcnt(0)" ::: "memory"); __builtin_amdgcn_s_barrier(); asm volatile("" ::: "memory");
        }
    }
}
__device__ __forceinline__ void gate_row(int w, int lane, const float* __restrict__ ro, const bf16_t* __restrict__ g, bf16_t* __restrict__ gn) {
    const float* r = ro + (size_t)w * RDV; const bf16_t* gg = g + (size_t)w * RDV; bf16_t* o = gn + (size_t)w * RDV;
    const f32x4 a = *(const f32x4*)(r + 8 * lane), b = *(const f32x4*)(r + 8 * lane + 4);
    float s = (a.x + a.y) + (a.z + a.w) + (b.x + b.y) + (b.z + b.w);
    const float mean = wave_sum(s) * (1.0f / RDV);
    const f32x4 da = a - mean, db = b - mean;
    const float rstd = 1.0f / sqrtf(wave_sum((da.x * da.x + da.y * da.y) + (da.z * da.z + da.w * da.w) + (db.x * db.x + db.y * db.y) + (db.z * db.z + db.w * db.w)) * (1.0f / RDV) + GN_EPS);
    const u32x4 gw = *(const u32x4*)(gg + 8 * lane);
    float gv[8] = {bf2f(gw.x & 0xffffu), bf2f(gw.x >> 16), bf2f(gw.y & 0xffffu), bf2f(gw.y >> 16), bf2f(gw.z & 0xffffu), bf2f(gw.z >> 16), bf2f(gw.w & 0xffffu), bf2f(gw.w >> 16)};
    float xv[8] = {da.x, da.y, da.z, da.w, db.x, db.y, db.z, db.w};
    unsigned wv[4];
#pragma unroll
    for (int j = 0; j < 4; ++j) { const float g0 = gv[2 * j], g1 = gv[2 * j + 1];
        wv[j] = pg8::cvt_pk_bf16(g0 / (1.0f + __expf(-g0)) * (xv[2 * j] * rstd), g1 / (1.0f + __expf(-g1)) * (xv[2 * j + 1] * rstd)); }
    *(u32x4*)(o + 8 * lane) = (u32x4){wv[0], wv[1], wv[2], wv[3]};
}
}
struct Args { const float* in[19]; float* out; unsigned char* ws; int ph_lo, ph_hi, bar_region, pad; };
#define CAS __attribute__((address_space(4)))
#define PHASE_ARGS() const CAS Args* ka = (const CAS Args*)__builtin_amdgcn_kernarg_segment_ptr(); asm volatile("" : "+s"(ka) :: "memory"); unsigned char* const ws = ka->ws; (void)ws; int ptid = threadIdx.x; asm volatile("" : "+v"(ptid)); const int lane = ptid & 63, wave = __builtin_amdgcn_readfirstlane(ptid >> 6); (void)lane; (void)wave
#define WSP(type, off) ((type*)(ws + (off)))
#ifndef PH_MASK
#define PH_MASK 0xffff
#endif
#define ON(b) ((PH_MASK >> (b)) & 1)
__global__ void __launch_bounds__(NWAVES * 64, 2) mega(Args args) {
    extern __shared__ __attribute__((aligned(16))) unsigned char lds_raw[];
    LAS unsigned char* lds = (LAS unsigned char*)lds_raw;
    const int tid = threadIdx.x;
    const int G = gridDim.x;
    for (int u = tid; u < (LDS_BYTES - LDSCTL_OFF) / 4; u += NWAVES * 64) ((LAS unsigned*)(lds + LDSCTL_OFF))[u] = 0u;
    __syncthreads();
    XcdBarrier bar = xcd_barrier_post((unsigned*)(args.ws + OFF_CTL) + CW_BAR + args.bar_region * XCD_BAR_WORDS, (volatile LAS unsigned*)(lds + MISC_OFF) + 8);
    const int lo = args.ph_lo, hi = args.ph_hi;
#define IN(k) (lo <= (k) && (k) < hi)
#define SEAM(k) do { if (IN(k) && IN((k) + 1)) xcd_barrier(bar); } while (0)

    if (ON(0) && IN(0)) {
        PHASE_ARGS();
        LAS float* scr = (LAS float*)(lds + RING_OFF + wave * 16384);
        const int gw = blockIdx.x * NWAVES + wave, ngw = G * NWAVES;
        p0_transpose_all(ka->in[2], WSP(bf16_t, OFF_WRI), 2, DM, RIN, scr, gw, ngw, lane);
        p0_transpose_all(ka->in[3], WSP(bf16_t, OFF_WRO), 2, RHV, DM, scr, gw, ngw, lane);
        p0_transpose_all(ka->in[4], WSP(bf16_t, OFF_WSI), 2, DM, 3 * DM, scr, gw, ngw, lane);
        p0_transpose_all(ka->in[5], WSP(bf16_t, OFF_WSO), 2, DM, DM, scr, gw, ngw, lane);
        p0_transpose_all(ka->in[17], WSP(bf16_t, OFF_WPG), 4, DM, DM, scr, gw, ngw, lane);
        p0_transpose_all(ka->in[16], WSP(bf16_t, OFF_WPW), 4, DPLE, DM, scr, gw, ngw, lane);
        p0_transpose_all(ka->in[10], WSP(bf16_t, OFF_WGU), 128, DM, 2 * DF, scr, gw, ngw, lane);
        p0_transpose_all(ka->in[12], WSP(bf16_t, OFF_WDN), 128, DF, DM, scr, gw, ngw, lane);
        const size_t gt = (size_t)blockIdx.x * (NWAVES * 64) + ptid, ngt = (size_t)G * NWAVES * 64;
        { const f32x4* x = (const f32x4*)ka->in[0]; u32x2* xb = WSP(u32x2, OFF_XB); f32x4* xf = WSP(f32x4, OFF_XF);
          for (size_t i = gt; i < (size_t)T * DM / 4; i += ngt) { const f32x4 v = x[i]; u32x2 o; o.x = pk2(v.x, v.y); o.y = pk2(v.z, v.w); xb[i] = o; xf[i] = v; } }
        { const f32x4* p = (const f32x4*)ka->in[1]; u32x2* pb = WSP(u32x2, OFF_PB);
          for (size_t i = gt; i < (size_t)4 * T * DPLE / 4; i += ngt) { const f32x4 v = p[i]; u32x2 o; o.x = pk2(v.x, v.y); o.y = pk2(v.z, v.w); pb[i] = o; } }
        { float* rope = WSP(float, OFF_ROPE);
          for (size_t i = gt; i < (size_t)SEQ * 128; i += ngt) { const int pos = (int)(i >> 7), d = (int)(i & 127);
            const float invf = 1.0f / powf(10000.0f, (float)d / 128.0f); const float ang = (float)pos * invf;
            rope[2 * i] = (float)cos((double)ang); rope[2 * i + 1] = (float)sin((double)ang); } }
    }
    SEAM(0);
    if (ON(1) && IN(1)) {
        PHASE_ARGS();
        PPOrder S; S.G = G; S.c = (int)blockIdx.x; S.A = (const char*)WSP(bf16_t, OFF_PB); S.Bt = (const char*)WSP(bf16_t, OFF_WPW);
        pg8::EpiBf16 E{WSP(bf16_t, OFF_PPB), DM, 0, 0, 1.0f, (size_t)T * DM};
        pg8::gemm_phase<pg8::EpiBf16, PPOrder, true, false>(lds + RING_OFF, DPLE, S, E);
    }
    SEAM(1);
#pragma unroll 1
    for (int i = 0; i < DEPTH; ++i) {
        const int pb = 2 + 10 * i, j = i >> 1;
        if (IN(pb)) {
            if (ON(2) && (i & 1) == 0) {
                PHASE_ARGS();
                pg8::DenseOrder S; S.init(T, RIN, DM, G, (int)blockIdx.x, WSP(bf16_t, OFF_XB), WSP(bf16_t, OFF_WRI) + (size_t)j * RIN * DM);
                pg8::EpiRetProj E{WSP(bf16_t, OFF_Q), WSP(bf16_t, OFF_K), WSP(bf16_t, OFF_V), WSP(bf16_t, OFF_G), WSP(float, OFF_ROPE)};
                pg8::gemm_phase<pg8::EpiRetProj, pg8::DenseOrder, true, false>(lds + RING_OFF, DM, S, E);
            } else if (ON(3) && (i & 1) == 1) {
                PHASE_ARGS();
                pg8::DenseOrder S; S.init(T, 3 * DM, DM, G, (int)blockIdx.x, WSP(bf16_t, OFF_XB), WSP(bf16_t, OFF_WSI) + (size_t)j * 3 * DM * DM);
                pg8::EpiBf16 E{WSP(bf16_t, OFF_Q), DM, DM, (size_t)(OFF_K - OFF_Q) / 2, 0.125f * 1.4426950408889634f, 0};
                pg8::gemm_phase<pg8::EpiBf16, pg8::DenseOrder, true, false>(lds + RING_OFF, DM, S, E);
            }
        }
        SEAM(pb);
        if (IN(pb + 1)) {
            if (ON(10) && (i & 1) == 0) { PHASE_ARGS(); ret::scan_phase(lds + RING_OFF, WSP(bf16_t, OFF_Q), WSP(bf16_t, OFF_K), WSP(bf16_t, OFF_V), WSP(float, OFF_RO), G, (int)blockIdx.x); }
            else if (ON(11) && (i & 1) == 1) { PHASE_ARGS(); sb::attn_phase(lds + RING_OFF, WSP(bf16_t, OFF_Q), WSP(bf16_t, OFF_K), WSP(bf16_t, OFF_V), WSP(bf16_t, OFF_GN), G, (int)blockIdx.x); }
        }
        SEAM(pb + 1);
        if (ON(12) && IN(pb + 2) && (i & 1) == 0) {
            PHASE_ARGS();
            for (int w = blockIdx.x * NWAVES + wave; w < T * RH; w += G * NWAVES) ret::gate_row(w, lane, WSP(float, OFF_RO), WSP(bf16_t, OFF_G), WSP(bf16_t, OFF_GN));
        }
        if ((i & 1) == 0) SEAM(pb + 2);
        if (ON(4) && IN(pb + 3)) {
            PHASE_ARGS();
            pg8::EpiF32 E{WSP(float, OFF_MIX), DM};
            const int Kx = (i & 1) ? DM : RHV;
            pg8::DenseOrder S; S.init(T, DM, Kx, G, (int)blockIdx.x, WSP(bf16_t, OFF_GN), (i & 1) ? (const void*)(WSP(bf16_t, OFF_WSO) + (size_t)j * DM * DM) : (const void*)(WSP(bf16_t, OFF_WRO) + (size_t)j * DM * RHV));
            pg8::gemm_phase<pg8::EpiF32, pg8::DenseOrder, false, false>(lds + RING_OFF, Kx, S, E);
        }
        SEAM(pb + 3);
        if (ON(6) && IN(pb + 4)) {
            PHASE_ARGS();
            { const f32x4* rw4 = (const f32x4*)(ka->in[8] + (size_t)i * DM * NE);
              for (int q = ptid; q < DM * NE / 4; q += NWAVES * 64) { const int c = q >> 3, ch = q & 7; const f32x4 w = rw4[q];
                  LAS unsigned char* d = lds + RING_OFF + ((c & 3) * 256 + (c >> 2)) * RW_ST + ch * 16; *(LAS f32x2*)d = (f32x2){w.x, w.y}; *(LAS f32x2*)(d + 8) = (f32x2){w.z, w.w}; } }
            __syncthreads();
            unsigned* cnt = WSP(unsigned, OFF_CTL) + CW_CNT + i * 64;
            const float* lg = ka->in[6] + (size_t)i * DM; const float* lb = ka->in[7] + (size_t)i * DM; const float* rb = ka->in[9] + (size_t)i * NE;
            for (int t = 2 * (blockIdx.x * NWAVES + wave); t < T; t += 2 * G * NWAVES)
                ln1_router_pair(t, lane, lds + RING_OFF, WSP(float, OFF_XF), WSP(float, OFF_MIX), lg, lb, rb, WSP(float, OFF_X1F), WSP(bf16_t, OFF_X1B), cnt, WSP(int, OFF_EL), WSP(float, OFF_GT));
            __syncthreads();
        }
        SEAM(pb + 4);
        if (ON(7) && IN(pb + 5)) {
            PHASE_ARGS();
            MoeOrder::setup(lds, WSP(unsigned, OFF_CTL) + CW_CNT + i * 64);
            MoeOrder S; S.G = G; S.c = (int)blockIdx.x; S.nN = 2 * DF / 256; S.tp = (const LAS int*)(lds + LDS_TP); S.cn = (const LAS int*)(lds + LDS_TP + 256); S.elist = WSP(int, OFF_EL);
            S.A = (const char*)WSP(bf16_t, OFF_X1B); S.Bt = (const char*)(WSP(bf16_t, OFF_WGU) + (size_t)i * NE * 2 * DF * DM); S.bstride_e = (size_t)2 * DF * DM * 2; S.gather = true; S.roff = (LAS unsigned*)(lds + LDS_ROFF);
            pg8::EpiMoe1 E{ka->in[11] + (size_t)i * NE * 2 * DF, WSP(bf16_t, OFF_ACT)};
            pg8::gemm_phase<pg8::EpiMoe1, MoeOrder, true, true>(lds + RING_OFF, DM, S, E);
        }
        SEAM(pb + 5);
        if (ON(8) && IN(pb + 6)) {
            PHASE_ARGS();
            MoeOrder::setup(lds, WSP(unsigned, OFF_CTL) + CW_CNT + i * 64);
            MoeOrder S; S.G = G; S.c = (int)blockIdx.x; S.nN = DM / 256; S.tp = (const LAS int*)(lds + LDS_TP); S.cn = (const LAS int*)(lds + LDS_TP + 256); S.elist = WSP(int, OFF_EL);
            S.A = (const char*)WSP(bf16_t, OFF_ACT); S.Bt = (const char*)(WSP(bf16_t, OFF_WDN) + (size_t)i * NE * DM * DF); S.bstride_e = (size_t)DM * DF * 2; S.gather = false; S.roff = (LAS unsigned*)(lds + LDS_ROFF);
            pg8::EpiMoe2 E{ka->in[13] + (size_t)i * NE * DM, WSP(bf16_t, OFF_YB), WSP(int, OFF_EL)};
            pg8::gemm_phase<pg8::EpiMoe2, MoeOrder, true, false>(lds + RING_OFF, DF, S, E);
        }
        SEAM(pb + 6);
        if (ON(9) && IN(pb + 7)) {
            PHASE_ARGS();
            const float* lg = ka->in[14] + (size_t)i * DM; const float* lb = ka->in[15] + (size_t)i * DM;
            for (int t = blockIdx.x * NWAVES + wave; t < T; t += G * NWAVES)
                ln2_row(t, lane, WSP(float, OFF_X1F), WSP(bf16_t, OFF_YB), WSP(float, OFF_GT), lg, lb, WSP(float, OFF_X2F), WSP(bf16_t, OFF_X2B));
        }
        SEAM(pb + 7);
        if (ON(5) && IN(pb + 8)) {
            PHASE_ARGS();
            pg8::DenseOrder S; S.init(T, DM, DM, G, (int)blockIdx.x, WSP(bf16_t, OFF_X2B), WSP(bf16_t, OFF_WPG) + (size_t)i * DM * DM);
            pg8::EpiPle E{WSP(float, OFF_X2F), WSP(bf16_t, OFF_PPB) + (size_t)i * T * DM, ka->in[18] + (size_t)i * DM, WSP(float, OFF_XF), WSP(bf16_t, OFF_XB), i == DEPTH - 1 ? ka->out : nullptr};
            pg8::gemm_phase<pg8::EpiPle, pg8::DenseOrder, false, false>(lds + RING_OFF, DM, S, E);
        }
        SEAM(pb + 8);
    }
#undef IN
#undef SEAM
}
static int g_grid = 0;
extern "C" void kernel_launch(void* const* d_in, const int* in_sizes, int n_in, void* d_out, int out_size, void* d_ws, size_t ws_size, hipStream_t stream) {
    if (n_in != 19 || ws_size < WS_END || out_size != T * DM) { fprintf(stderr, "kernel_launch: unexpected arguments (n_in %d, ws %zu need %zu, out %d)\n", n_in, ws_size, (size_t)WS_END, out_size); return; }
    if (g_grid == 0) {
        int dev = 0, cus = 0;
        if (hipGetDevice(&dev) != hipSuccess || hipDeviceGetAttribute(&cus, hipDeviceAttributeMultiprocessorCount, dev) != hipSuccess) { g_grid = -1; return; }
        if (hipFuncSetAttribute((const void*)mega, hipFuncAttributeMaxDynamicSharedMemorySize, LDS_BYTES) != hipSuccess) { g_grid = -1; return; }
        int per_cu = 0; (void)hipOccupancyMaxActiveBlocksPerMultiprocessor(&per_cu, (const void*)mega, NWAVES * 64, LDS_BYTES); (void)hipGetLastError();
        if (per_cu < 1) fprintf(stderr, "kernel_launch: occupancy query reports %d workgroups per CU\n", per_cu);
        g_grid = cus;
    }
    if (g_grid < 0) return;
    (void)hipMemsetAsync((unsigned char*)d_ws + OFF_CTL, 0, MiB, stream);
    Args a{};
    for (int i = 0; i < 19; ++i) a.in[i] = (const float*)d_in[i];
    a.out = (float*)d_out; a.ws = (unsigned char*)d_ws; a.ph_lo = 0; a.ph_hi = 2 + 10 * DEPTH; a.bar_region = 0; a.pad = 0;
    hipLaunchKernelGGL(mega, dim3(g_grid), dim3(NWAVES * 64), LDS_BYTES, stream, a);
}
```

```cpp
#include <hip/hip_runtime.h>
#include <stdint.h>
#include <cstdio>

typedef unsigned short bf16_t;
typedef short bf16x8 __attribute__((ext_vector_type(8)));
typedef float f32x4 __attribute__((ext_vector_type(4)));
typedef unsigned u32x4 __attribute__((ext_vector_type(4)));
typedef unsigned u32x2 __attribute__((ext_vector_type(2)));

constexpr int DM = 1024, NB = 8, SEQ = 2048, DEPTH = 4, T = NB * SEQ;
constexpr int RH = 4, RDK = 256, RDV = 512, RIN = 6144, RHV = RH * RDV;
constexpr int SH = 16, SD = 64;
constexpr int NE = 32, TOPK = 4, DF = 1024, DPLE = 256;
constexpr int NSLOT = T * TOPK;
constexpr int RPAD = NSLOT + NE * 256;
constexpr float DN_ALPHA = 1.6817928305074290f;
constexpr float LN_EPS = 1e-5f, GN_EPS = 1e-6f;

constexpr size_t MiB = (size_t)1 << 20;
constexpr size_t al(size_t x) { return (x + 255) & ~(size_t)255; }
constexpr size_t OFF_CTL = 0;
constexpr size_t OFF_WRI = OFF_CTL + MiB;
constexpr size_t OFF_WRO = OFF_WRI + al((size_t)2 * RIN * DM * 2);
constexpr size_t OFF_WSI = OFF_WRO + al((size_t)2 * DM * RHV * 2);
constexpr size_t OFF_WSO = OFF_WSI + al((size_t)2 * 3 * DM * DM * 2);
constexpr size_t OFF_WPG = OFF_WSO + al((size_t)2 * DM * DM * 2);
constexpr size_t OFF_WPW = OFF_WPG + al((size_t)4 * DM * DM * 2);
constexpr size_t OFF_WGU = OFF_WPW + al((size_t)4 * DM * DPLE * 2);
constexpr size_t OFF_WDN = OFF_WGU + al((size_t)128 * 2 * DF * DM * 2);
constexpr size_t OFF_PB  = OFF_WDN + al((size_t)128 * DM * DF * 2);
constexpr size_t OFF_XF  = OFF_PB  + al((size_t)4 * T * DPLE * 2);
constexpr size_t OFF_XB  = OFF_XF  + al((size_t)T * DM * 4);
constexpr size_t OFF_X1F = OFF_XB  + al((size_t)T * DM * 2);
constexpr size_t OFF_X1B = OFF_X1F + al((size_t)T * DM * 4);
constexpr size_t OFF_X2F = OFF_X1B + al((size_t)T * DM * 2);
constexpr size_t OFF_X2B = OFF_X2F + al((size_t)T * DM * 4);
constexpr size_t OFF_MIX = OFF_X2B + al((size_t)T * DM * 2);
constexpr size_t OFF_Q   = OFF_MIX + al((size_t)T * DM * 4);
constexpr size_t OFF_K   = OFF_Q   + al((size_t)T * DM * 2);
constexpr size_t OFF_V   = OFF_K   + al((size_t)T * DM * 2);
constexpr size_t OFF_G   = OFF_V   + al((size_t)T * RHV * 2);
constexpr size_t OFF_RO  = OFF_G   + al((size_t)T * RHV * 2);
constexpr size_t OFF_GN  = OFF_RO  + al((size_t)T * RHV * 4);
constexpr size_t OFF_ACT = OFF_GN  + al((size_t)T * RHV * 2);
constexpr size_t OFF_YB  = OFF_ACT + al((size_t)RPAD * DF * 2);
constexpr size_t OFF_PPB = OFF_YB  + al((size_t)NSLOT * DM * 2);
constexpr size_t OFF_EL  = OFF_PPB + al((size_t)4 * T * DM * 2);
constexpr size_t OFF_GT  = OFF_EL  + al((size_t)NE * T * 4);
constexpr size_t OFF_ROPE= OFF_GT  + al((size_t)NSLOT * 4);
constexpr size_t OFF_PROJ= OFF_ROPE+ al((size_t)SEQ * 128 * 2 * 4);
constexpr size_t WS_END  = OFF_PROJ+ al((size_t)T * RIN * 4);
constexpr int CW_CNT = 64;

__device__ __forceinline__ unsigned f2bf(float f) { unsigned u = __float_as_uint(f); return (u + 0x7fffu + ((u >> 16) & 1u)) >> 16; }
__device__ __forceinline__ unsigned pk2(float lo, float hi) { return f2bf(lo) | (f2bf(hi) << 16); }
__device__ __forceinline__ float bf2f(unsigned b) { return __uint_as_float(b << 16); }
__device__ __forceinline__ float wave_sum(float v) {
#pragma unroll
    for (int o = 1; o < 64; o <<= 1) v += __shfl_xor(v, o);
    return v;
}
__device__ __forceinline__ float sigmoidf_(float x) { return 1.0f / (1.0f + __expf(-x)); }

#define LAS __attribute__((address_space(3)))
#define GAS __attribute__((address_space(1)))
namespace pg8 {
constexpr int BM = 256, BK = 64, HALF = 128, HTB = HALF * BK * 2  , STAGE_BYTES = 8 * HTB, NXCD = 8, WGM = 8;
__host__ __device__ __forceinline__ int lds_byte(int r, int c) { const int st = (r >> 4) * 2 + (c >> 5), rr = r & 15, cc = c & 31, ob = rr * 64 + cc * 2; return st * 1024 + (ob ^ (((ob >> 9) & 1) << 5)); }
__host__ __device__ __forceinline__ void stage_rc(int b, int& R, int& C) { const int st = b / 1024, sb = b % 1024, swz = sb ^ (((sb >> 9) & 1) << 5); R = (st >> 1) * 16 + swz / 64; C = (st & 1) * 32 + (swz % 64) / 2; }
__host__ __device__ __forceinline__ int perm32(int rho) { const int n = rho >> 4, i = rho & 15; return 8 * (i >> 2) + 4 * n + (i & 3); }
struct Unit { int pm, pn, e, lrow0, nvalid; };
typedef float f32x2_t __attribute__((ext_vector_type(2))); typedef __bf16 bf16x2_t __attribute__((ext_vector_type(2)));
__device__ __forceinline__ unsigned cvt_pk_bf16(float lo, float hi) { f32x2_t v = {lo, hi}; bf16x2_t b = __builtin_convertvector(v, bf16x2_t); return __builtin_bit_cast(unsigned, b); }

struct DenseOrder {
    int nM, nN, nwg, G, c; const char* A; const char* Bt; size_t tstep;
    __device__ void init(int M, int N, int K, int G_, int c_, const void* A_, const void* Bt_) { nM = M / BM; nN = N / BM; nwg = nM * nN; G = G_; c = c_; A = (const char*)A_; Bt = (const char*)Bt_; tstep = (size_t)BM * K * 2; }
    __device__ bool next(int i, Unit& u) const {
        const long L = (long)i * G + c; if (L >= nwg) return false;
        int wgid = (int)L; { const int q = nwg / NXCD, r = nwg % NXCD, xcd = wgid % NXCD, off = wgid / NXCD; wgid = (xcd < r ? xcd * (q + 1) : r * (q + 1) + (xcd - r) * q) + off; }
        const int nig = WGM * nN, gid = wgid / nig, fm = gid * WGM, gsz = (nM - fm) < WGM ? (nM - fm) : WGM;
        u.pm = fm + ((wgid % nig) % gsz); u.pn = (wgid % nig) / gsz; u.e = 0; u.lrow0 = 0; u.nvalid = BM; return true;
    }
    __device__ __forceinline__ const char* a_base(const Unit& u) const { return A + (size_t)u.pm * tstep; }
    __device__ __forceinline__ const char* b_base(const Unit& u) const { return Bt + (size_t)u.pn * tstep; }
    __device__ __forceinline__ unsigned a_row(const Unit&, int) const { return 0u; }
    LAS unsigned* roff;
};
struct EpiF32 {
    static constexpr bool PERM = false;
    float* C; int ldc;
    __device__ __forceinline__ void operator()(const f32x4 (&acc)[2][2][4][2], const Unit& u, int wr, int wc, int fr, int fq) const {
        const int row0 = u.pm * BM + wr * 64 + fr, col0 = u.pn * BM + wc * 32 + 4 * fq;
#pragma unroll
        for (int ai = 0; ai < 2; ++ai)
#pragma unroll
            for (int m = 0; m < 4; ++m) { float* rowp = C + (size_t)(row0 + ai * HALF + m * 16) * ldc + col0;
#pragma unroll
                for (int bj = 0; bj < 2; ++bj)
#pragma unroll
                    for (int n = 0; n < 2; ++n) *(f32x4*)(rowp + bj * HALF + n * 16) = acc[ai][bj][m][n]; }
    }
};
struct EpiBf16 {
    static constexpr bool PERM = true;
    bf16_t* O; int ldc; int split_cols; size_t split_stride; float scale0; size_t estride;
    __device__ __forceinline__ void operator()(const f32x4 (&acc)[2][2][4][2], const Unit& u, int wr, int wc, int fr, int fq) const {
        const int row0 = u.pm * BM + wr * 64 + fr; int colt = u.pn * BM; bf16_t* base = O + (size_t)u.e * estride;
        float sc = 1.f; if (split_cols) { const int t = colt / split_cols; base += (size_t)t * split_stride; colt -= t * split_cols; if (t == 0) sc = scale0; }
        const int col0 = colt + wc * 32 + 8 * fq;
#pragma unroll
        for (int ai = 0; ai < 2; ++ai)
#pragma unroll
            for (int m = 0; m < 4; ++m) { bf16_t* rowp = base + (size_t)(row0 + ai * HALF + m * 16) * ldc + col0;
#pragma unroll
                for (int bj = 0; bj < 2; ++bj) { const f32x4 v0 = acc[ai][bj][m][0] * sc, v1 = acc[ai][bj][m][1] * sc;
                    u32x4 w; w.x = cvt_pk_bf16(v0[0], v0[1]); w.y = cvt_pk_bf16(v0[2], v0[3]); w.z = cvt_pk_bf16(v1[0], v1[1]); w.w = cvt_pk_bf16(v1[2], v1[3]);
                    *(u32x4*)(rowp + bj * HALF) = w; } }
    }
};
struct EpiRetProj {
    static constexpr bool PERM = true;
    bf16_t *Q, *Kk, *V, *G; const float* rope;
    __device__ __forceinline__ void operator()(const f32x4 (&acc)[2][2][4][2], const Unit& u, int wr, int wc, int fr, int fq) const {
        const int row0 = u.pm * BM + wr * 64 + fr, pn = u.pn;
        if (pn < 8) {
            const int h = pn & 3; bf16_t* dst = pn < 4 ? Q : Kk; const float sc = pn < 4 ? 1.0f : 0.0625f; const int d0 = wc * 32 + 8 * fq;
#pragma unroll
            for (int ai = 0; ai < 2; ++ai)
#pragma unroll
                for (int m = 0; m < 4; ++m) { const int r = row0 + ai * HALF + m * 16, pos = r & (SEQ - 1);
                    const f32x4* rp = (const f32x4*)(rope + ((size_t)pos * 128 + d0) * 2);
                    const f32x4 t0 = rp[0], t1 = rp[1], t2 = rp[2], t3 = rp[3];
                    const f32x4 xa = acc[ai][0][m][0], xb = acc[ai][0][m][1], ya = acc[ai][1][m][0], yb = acc[ai][1][m][1];
                    u32x4 w1, w2;
                    w1.x = cvt_pk_bf16((xa[0] * t0[0] - ya[0] * t0[1]) * sc, (xa[1] * t0[2] - ya[1] * t0[3]) * sc); w1.y = cvt_pk_bf16((xa[2] * t1[0] - ya[2] * t1[1]) * sc, (xa[3] * t1[2] - ya[3] * t1[3]) * sc);
                    w1.z = cvt_pk_bf16((xb[0] * t2[0] - yb[0] * t2[1]) * sc, (xb[1] * t2[2] - yb[1] * t2[3]) * sc); w1.w = cvt_pk_bf16((xb[2] * t3[0] - yb[2] * t3[1]) * sc, (xb[3] * t3[2] - yb[3] * t3[3]) * sc);
                    w2.x = cvt_pk_bf16((xa[0] * t0[1] + ya[0] * t0[0]) * sc, (xa[1] * t0[3] + ya[1] * t0[2]) * sc); w2.y = cvt_pk_bf16((xa[2] * t1[1] + ya[2] * t1[0]) * sc, (xa[3] * t1[3] + ya[3] * t1[2]) * sc);
                    w2.z = cvt_pk_bf16((xb[0] * t2[1] + yb[0] * t2[0]) * sc, (xb[1] * t2[3] + yb[1] * t2[2]) * sc); w2.w = cvt_pk_bf16((xb[2] * t3[1] + yb[2] * t3[0]) * sc, (xb[3] * t3[3] + yb[3] * t3[2]) * sc);
                    bf16_t* o = dst + (size_t)r * DM + h * RDK + d0;
                    *(u32x4*)o = w1; *(u32x4*)(o + 128) = w2; }
        } else {
            bf16_t* dst = pn < 16 ? V : G; const int cb = (pn < 16 ? pn - 8 : pn - 16) * BM + wc * 32 + 8 * fq;
#pragma unroll
            for (int ai = 0; ai < 2; ++ai)
#pragma unroll
                for (int m = 0; m < 4; ++m) { bf16_t* rowp = dst + (size_t)(row0 + ai * HALF + m * 16) * RHV + cb;
#pragma unroll
                    for (int bj = 0; bj < 2; ++bj) { const f32x4 v0 = acc[ai][bj][m][0], v1 = acc[ai][bj][m][1];
                        u32x4 w; w.x = cvt_pk_bf16(v0[0], v0[1]); w.y = cvt_pk_bf16(v0[2], v0[3]); w.z = cvt_pk_bf16(v1[0], v1[1]); w.w = cvt_pk_bf16(v1[2], v1[3]);
                        *(u32x4*)(rowp + bj * HALF) = w; } }
        }
    }
};
struct EpiPle {
    static constexpr bool PERM = true;
    const bf16_t* x2b; const bf16_t* pp; const float* bg; bf16_t* xb; float* out;
    __device__ __forceinline__ void operator()(const f32x4 (&acc)[2][2][4][2], const Unit& u, int wr, int wc, int fr, int fq) const {
        const int row0 = u.pm * BM + wr * 64 + fr, col0 = u.pn * BM + wc * 32 + 8 * fq;
        f32x4 bv[2][2];
#pragma unroll
        for (int bj = 0; bj < 2; ++bj)
#pragma unroll
            for (int n = 0; n < 2; ++n) bv[bj][n] = *(const f32x4*)(bg + col0 + bj * HALF + 4 * n);
#pragma unroll
        for (int ai = 0; ai < 2; ++ai)
#pragma unroll
            for (int m = 0; m < 4; ++m) { const size_t ro = (size_t)(row0 + ai * HALF + m * 16) * DM + col0;
#pragma unroll
                for (int bj = 0; bj < 2; ++bj) { const size_t o = ro + bj * HALF;
                    const u32x4 xw = *(const u32x4*)(x2b + o), pw = *(const u32x4*)(pp + o);
                    const unsigned xs[4] = {xw.x, xw.y, xw.z, xw.w}, ps[4] = {pw.x, pw.y, pw.z, pw.w};
                    float r[8];
#pragma unroll
                    for (int q = 0; q < 4; ++q) { const f32x4 a = acc[ai][bj][m][q >> 1] + bv[bj][q >> 1]; const int e0 = 2 * (q & 1);
                        r[2 * q] = bf2f(xs[q] & 0xffffu) + bf2f(ps[q] & 0xffffu) / (1.0f + __expf(-a[e0])); r[2 * q + 1] = bf2f(xs[q] >> 16) + bf2f(ps[q] >> 16) / (1.0f + __expf(-a[e0 + 1])); }
                    u32x4 w; w.x = cvt_pk_bf16(r[0], r[1]); w.y = cvt_pk_bf16(r[2], r[3]); w.z = cvt_pk_bf16(r[4], r[5]); w.w = cvt_pk_bf16(r[6], r[7]);
                    *(u32x4*)(xb + o) = w;
                    if (out) { *(f32x4*)(out + o) = (f32x4){r[0], r[1], r[2], r[3]}; *(f32x4*)(out + o + 4) = (f32x4){r[4], r[5], r[6], r[7]}; } } }
    }
};

template <class Epi, class Sched, bool ALIGN_EPI, bool GATHER>
__device__ __forceinline__ void gemm_phase(LAS unsigned char* lds, const int Kin, const Sched& S, const Epi& E) {
    int tid = threadIdx.x; asm volatile("" : "+v"(tid));
    const int wid = __builtin_amdgcn_readfirstlane(tid >> 6), lane = tid & 63, wr = wid >> 2, wc = wid & 3, fr = lane & 15, fq = lane >> 4;
    int K = __builtin_amdgcn_readfirstlane(Kin); asm volatile("" : "+s"(K));
    const int nt = K / BK;
    unsigned voffB[2], voffA[2], vG[2][2];
#pragma unroll
    for (int i = 0; i < 2; ++i) { int R, C; stage_rc(tid * 16 + i * 8192, R, C); const int Rb = Epi::PERM ? ((R & ~31) + perm32(R & 31)) : R;
        voffB[i] = (unsigned)(Rb * K + C) * 2u; voffA[i] = (unsigned)(R * K + C) * 2u; }
    const size_t kstep = (size_t)(BK * 2);
    const size_t hstep = (size_t)HALF * K * 2;
    const unsigned ldsw = (unsigned)wid * 1024u;
    const int aoff = lds_byte(wr * 64 + fr, fq * 8), boff = lds_byte(wc * 32 + fr, fq * 8);
#define PG8_SA(b, h) (((b) * 2 + (h)) * HTB)
#define PG8_SB(b, h) ((4 + (b) * 2 + (h)) * HTB)
#define PG8_STAGE(bufoff, gbase, voff) do { _Pragma("unroll") for (int _i = 0; _i < 2; ++_i) { unsigned _o = (voff)[_i]; if constexpr (GATHER) asm volatile("" : "+v"(_o)); \
        __builtin_amdgcn_global_load_lds((const unsigned*)((const char*)(gbase) + _o), (LAS unsigned*)(lds + (bufoff) + ldsw + _i * 8192), 16, 0, 0); } } while (0)
#define PG8_STAGEA(bufoff, gbase, h, vg) do { if constexpr (GATHER) { PG8_STAGE(bufoff, gbase, vg[h]); } else { PG8_STAGE(bufoff, (gbase) + (h) * hstep, voffA); } } while (0)
#define PG8_LDA(dst, b, h) do { _Pragma("unroll") for (int m = 0; m < 4; ++m) _Pragma("unroll") for (int k = 0; k < 2; ++k) dst[m][k] = *(const LAS bf16x8*)(lds + PG8_SA(b, h) + aoff + m * 2048 + k * 1024); } while (0)
#define PG8_LDB(dst, b, h) do { _Pragma("unroll") for (int n = 0; n < 2; ++n) _Pragma("unroll") for (int k = 0; k < 2; ++k) dst[n][k] = *(const LAS bf16x8*)(lds + PG8_SB(b, h) + boff + n * 2048 + k * 1024); } while (0)
#define PG8_MMA(ai, bj, At, Bt) do { __builtin_amdgcn_s_setprio(1); _Pragma("unroll") for (int m = 0; m < 4; ++m) _Pragma("unroll") for (int n = 0; n < 2; ++n) _Pragma("unroll") for (int k = 0; k < 2; ++k) \
        acc[ai][bj][m][n] = __builtin_amdgcn_mfma_f32_16x16x32_bf16(Bt[n][k], At[m][k], acc[ai][bj][m][n], 0, 0, 0); __builtin_amdgcn_s_setprio(0); } while (0)
#define PG8_WAIT_V(n) asm volatile("s_waitcnt vmcnt(" #n ")" ::: "memory")
#define PG8_WAIT_L(n) asm volatile("s_waitcnt lgkmcnt(" #n ")" ::: "memory")
#define PG8_BAR __builtin_amdgcn_s_barrier()
#define PG8_SCHED __builtin_amdgcn_sched_barrier(0)
#define PG8_TABLE(u) do { if (wid < 4) { S.roff[tid] = S.a_row(u, tid) * (unsigned)(K * 2); } } while (0)
#define PG8_GREAD(dst) do { _Pragma("unroll") for (int _i = 0; _i < 2; ++_i) { int _R, _C; stage_rc(tid * 16 + _i * 8192, _R, _C); _Pragma("unroll") for (int _h = 0; _h < 2; ++_h) dst[_h][_i] = S.roff[_h * HALF + _R] + (unsigned)_C * 2u; } } while (0)
    Unit cur, nxt; int ui = 0;
    if (!S.next(0, cur)) return;
    f32x4 acc[2][2][4][2];
#pragma unroll
    for (int a = 0; a < 2; ++a)
#pragma unroll
        for (int b = 0; b < 2; ++b)
#pragma unroll
            for (int m = 0; m < 4; ++m)
#pragma unroll
                for (int n = 0; n < 2; ++n) acc[a][b][m][n] = (f32x4){0.f, 0.f, 0.f, 0.f};
    bf16x8 At[4][2], B0[2][2], B1[2][2];
    const char* cA = S.a_base(cur); const char* cB = S.b_base(cur);
    if constexpr (GATHER) { PG8_TABLE(cur); asm volatile("s_waitcnt vmcnt(0) lgkmcnt(0)" ::: "memory"); __builtin_amdgcn_s_barrier(); asm volatile("" ::: "memory"); PG8_GREAD(vG); }
    PG8_STAGE(PG8_SB(0, 0), cB, voffB); PG8_STAGE(PG8_SB(0, 1), cB + hstep, voffB); PG8_STAGEA(PG8_SA(0, 0), cA, 0, vG); PG8_STAGEA(PG8_SA(0, 1), cA, 1, vG);
    if (wr == 1) PG8_BAR;
    PG8_WAIT_V(2); PG8_BAR;
    PG8_STAGE(PG8_SB(1, 0), cB + kstep, voffB); PG8_STAGEA(PG8_SA(1, 0), cA + kstep, 0, vG); PG8_STAGE(PG8_SB(1, 1), cB + hstep + kstep, voffB);
    PG8_WAIT_V(6); PG8_BAR;
    for (;;) {
        const bool has_next = S.next(ui + 1, nxt);
        const char* nA = has_next ? S.a_base(nxt) : cA; const char* nB = has_next ? S.b_base(nxt) : cB;
        for (int t = 0; t < nt; t += 2) {
            const bool last = (t == nt - 2);
            const char* a1 = cA + (size_t)(t + 1) * kstep;
            const char* a2 = last ? nA : cA + (size_t)(t + 2) * kstep; const char* b2 = last ? nB : cB + (size_t)(t + 2) * kstep;
            const char* a3 = a2 + kstep; const char* b3 = b2 + kstep;
            if constexpr (GATHER) { if (last && has_next) { PG8_TABLE(nxt); } }
            PG8_LDB(B0, 0, 0); PG8_LDB(B1, 0, 1); PG8_SCHED; PG8_LDA(At, 0, 0); PG8_STAGEA(PG8_SA(1, 1), a1, 1, vG);
            PG8_WAIT_V(8); PG8_WAIT_L(0); PG8_BAR; PG8_MMA(0, 0, At, B0); PG8_MMA(0, 1, At, B1); PG8_BAR; PG8_SCHED;
            if constexpr (GATHER) { if (last && has_next) { PG8_GREAD(vG); } }
            PG8_LDA(At, 0, 1); PG8_STAGE(PG8_SB(0, 0), b2, voffB); PG8_STAGE(PG8_SB(0, 1), b2 + hstep, voffB); PG8_STAGEA(PG8_SA(0, 0), a2, 0, vG);
            PG8_WAIT_V(8); PG8_WAIT_L(0); PG8_BAR; PG8_MMA(1, 0, At, B0); PG8_MMA(1, 1, At, B1); PG8_BAR; PG8_SCHED;
            PG8_LDB(B0, 1, 0); PG8_LDB(B1, 1, 1); PG8_SCHED; PG8_LDA(At, 1, 0); PG8_STAGEA(PG8_SA(0, 1), a2, 1, vG);
            PG8_WAIT_V(8); PG8_WAIT_L(0); PG8_BAR; PG8_MMA(0, 0, At, B0); PG8_MMA(0, 1, At, B1); PG8_BAR; PG8_SCHED;
            PG8_LDA(At, 1, 1); PG8_STAGE(PG8_SB(1, 0), b3, voffB); PG8_STAGE(PG8_SB(1, 1), b3 + hstep, voffB); PG8_STAGEA(PG8_SA(1, 0), a3, 0, vG);
            PG8_WAIT_V(8); PG8_WAIT_L(0); PG8_BAR; PG8_MMA(1, 0, At, B0); PG8_MMA(1, 1, At, B1); PG8_BAR; PG8_SCHED;
        }
        if constexpr (ALIGN_EPI) { if (wr == 0) PG8_BAR; }
        { int el = lane; asm volatile("" : "+v"(el));
          E(acc, cur, wr, wc, el & 15, el >> 4); }
        if (!has_next) break;
#pragma unroll
        for (int a = 0; a < 2; ++a)
#pragma unroll
            for (int b = 0; b < 2; ++b)
#pragma unroll
                for (int m = 0; m < 4; ++m)
#pragma unroll
                    for (int n = 0; n < 2; ++n) acc[a][b][m][n] = (f32x4){0.f, 0.f, 0.f, 0.f};
        cur = nxt; cA = nA; cB = nB; ++ui;
        if constexpr (ALIGN_EPI) { if (wr == 1) PG8_BAR; }
    }
    PG8_WAIT_V(0);
    if constexpr (!ALIGN_EPI) { if (wr == 0) PG8_BAR; }
    PG8_BAR;
#undef PG8_SA
#undef PG8_SB
#undef PG8_STAGE
#undef PG8_STAGEA
#undef PG8_LDA
#undef PG8_LDB
#undef PG8_MMA
#undef PG8_WAIT_V
#undef PG8_WAIT_L
#undef PG8_BAR
#undef PG8_SCHED
#undef PG8_TABLE
#undef PG8_GREAD
}
}
typedef float f32x2 __attribute__((ext_vector_type(2)));
constexpr int NWAVES = 8;
constexpr int RING_OFF = 0, RING_BYTES = 139264;
constexpr int LDSCTL_OFF = RING_BYTES, MISC_OFF = LDSCTL_OFF + 320;
constexpr int LDS_BYTES = 147456;
constexpr int CW_BAR = 4096;
typedef GAS unsigned gu32;
#define RLX_AGENT __ATOMIC_RELAXED, __HIP_MEMORY_SCOPE_AGENT

#define XB_TMO      128
#define XB_XCNT(j)  (256  + 64 * (j))
#define XB_XSUB(j)  (1280 + 64 * (j))
#define XB_XGEN(j)  (2304 + 64 * (j))
#define XB_TOP      3328
#define XB_TOPGEN   3392
#define XCD_BAR_WORDS 3456
#define XB_SPIN_CAP (1u << 18)
__device__ __forceinline__ unsigned xb_ld(unsigned* p)              { return __hip_atomic_load(p, __ATOMIC_RELAXED, __HIP_MEMORY_SCOPE_AGENT); }
__device__ __forceinline__ unsigned xb_add(unsigned* p, unsigned v) { return __hip_atomic_fetch_add(p, v, __ATOMIC_RELAXED, __HIP_MEMORY_SCOPE_AGENT); }
__device__ __forceinline__ unsigned xb_xcc_id() { return (unsigned)__builtin_amdgcn_s_getreg((3 << 11) | 20) & 0xFu; }
#define XB_SPIN(cond, bar) do { unsigned _sp = 0; while (cond) { __builtin_amdgcn_s_sleep(1); \
    if ((++_sp & 255u) == 0u) { if (xb_ld(&(bar)[XB_TMO])) break; if (_sp > XB_SPIN_CAP) { atomicAdd(&(bar)[XB_TMO], 1u); break; } } } } while (0)
struct XcdBarrier { unsigned* bar; unsigned x; volatile LAS unsigned* st; };
__device__ __forceinline__ XcdBarrier xcd_barrier_post(unsigned* bar, volatile LAS unsigned* st) {
    XcdBarrier b; b.bar = bar; b.x = xb_xcc_id(); b.st = st;
    if (threadIdx.x == 0) (void)xb_add(&bar[XB_XCNT(b.x)], 1u);
    return b;
}
__device__ __forceinline__ void xcd_barrier_complete(unsigned* bar, unsigned x, unsigned& nloc, unsigned& nx) {
    const unsigned G = gridDim.x * gridDim.y * gridDim.z;
    unsigned sum, cnt, mine, sp = 0u;
    for (;;) {
        sum = 0u; cnt = 0u; mine = 0u;
#pragma unroll
        for (unsigned j = 0; j < 16; ++j) { const unsigned c = xb_ld(&bar[XB_XCNT(j)]); sum += c; cnt += (c > 0u) ? 1u : 0u; mine = (j == x) ? c : mine; }
        if (sum == G) break;
        __builtin_amdgcn_s_sleep(1);
        if ((++sp & 255u) == 0u) { if (xb_ld(&bar[XB_TMO])) break; if (sp > XB_SPIN_CAP) { atomicAdd(&bar[XB_TMO], 1u); break; } }
    }
    nloc = mine > 0u ? mine : 1u; nx = cnt > 0u ? cnt : 1u;
}
__device__ __forceinline__ void xcd_barrier(const XcdBarrier& b) {
    asm volatile("s_waitcnt vmcnt(0)" ::: "memory");
    __syncthreads();
    if (threadIdx.x == 0) {
        unsigned* bar = b.bar;
        __builtin_amdgcn_s_waitcnt(0);
        unsigned nloc = b.st[0], nx = b.st[1];
        if (nloc == 0u) { xcd_barrier_complete(bar, b.x, nloc, nx); b.st[0] = nloc; b.st[1] = nx; }
        const unsigned old = xb_add(&bar[XB_XSUB(b.x)], 1u);
        const unsigned gen = old / nloc;
        if (old + 1u == (gen + 1u) * nloc) {
            __builtin_amdgcn_fence(__ATOMIC_RELEASE, "agent");
            asm volatile("s_waitcnt vmcnt(0)" ::: "memory");
            const unsigned og = xb_add(&bar[XB_TOP], 1u);
            const unsigned tg = og / nx;
            if (og + 1u == (tg + 1u) * nx) xb_add(&bar[XB_TOPGEN], 1u);
            else XB_SPIN(xb_ld(&bar[XB_TOPGEN]) == tg, bar);
            __builtin_amdgcn_fence(__ATOMIC_ACQUIRE, "agent");
            xb_add(&bar[XB_XGEN(b.x)], 1u);
            asm volatile("s_waitcnt vmcnt(0)" ::: "memory");
        } else {
            XB_SPIN(xb_ld(&bar[XB_XGEN(b.x)]) == gen, bar);
            __builtin_amdgcn_fence(__ATOMIC_ACQUIRE, "agent");
            asm volatile("s_waitcnt vmcnt(0)" ::: "memory");
        }
    }
    __syncthreads();
}

__device__ __forceinline__ void p0_transpose_item(const float* __restrict__ Wm, int K, int N, bf16_t* __restrict__ WTm, LAS float* scr, int item, int lane) {
    const int nblk = N / 32, kb = item / nblk, nbk = item % nblk, k0 = 64 * kb, n0 = 32 * nbk;
#pragma unroll 8
    for (int i = 0; i < 32; ++i) { const int kk = 2 * i + (lane >> 5); scr[kk * 33 + (lane & 31)] = Wm[(size_t)(k0 + kk) * N + n0 + (lane & 31)]; }
    asm volatile("s_waitcnt lgkmcnt(0)" ::: "memory");
    const int c = lane & 7;
#pragma unroll
    for (int j = 0; j < 4; ++j) { const int n = (lane >> 3) + 8 * j; const LAS float* s = scr + (8 * c) * 33 + n;
        u32x4 o; o.x = pk2(s[0 * 33], s[1 * 33]); o.y = pk2(s[2 * 33], s[3 * 33]); o.z = pk2(s[4 * 33], s[5 * 33]); o.w = pk2(s[6 * 33], s[7 * 33]);
        *(u32x4*)(WTm + (size_t)(n0 + n) * K + k0 + 8 * c) = o; }
    asm volatile("s_waitcnt lgkmcnt(0)" ::: "memory");
}
__device__ __forceinline__ void p0_transpose_all(const float* W, bf16_t* WT, int nb, int K, int N, LAS float* scr, int gw, int ngw, int lane) {
    const int per = (K / 64) * (N / 32); const long total = (long)nb * per;
    for (long it = gw; it < total; it += ngw) { const int mb = (int)(it / per), item = (int)(it % per);
        p0_transpose_item(W + (size_t)mb * K * N, K, N, WT + (size_t)mb * K * N, scr, item, lane); }
}

struct PPOrder {
    int G, c; const char* A; const char* Bt;
    __device__ bool next(int i, pg8::Unit& u) const { const int L = i * G + c; if (L >= 1024) return false; u.e = L >> 8; u.pm = (L & 255) >> 2; u.pn = L & 3; u.lrow0 = 0; u.nvalid = 256; return true; }
    __device__ __forceinline__ const char* a_base(const pg8::Unit& u) const { return A + ((size_t)u.e * T + (size_t)u.pm * 256) * DPLE * 2; }
    __device__ __forceinline__ const char* b_base(const pg8::Unit& u) const { return Bt + ((size_t)u.e * DM + (size_t)u.pn * 256) * DPLE * 2; }
    __device__ __forceinline__ unsigned a_row(const pg8::Unit&, int) const { return 0u; }
    LAS unsigned* roff;
};

constexpr int LDS_ROFF = LDSCTL_OFF + 2048;
constexpr int LDS_TP = LDSCTL_OFF + 1024;
struct MoeOrder {
    LAS unsigned* roff; int G, c, nN; const LAS int* tp; const LAS int* cn; const int* elist; const char* A; const char* Bt; size_t bstride_e; bool gather;
    static __device__ __forceinline__ void setup(LAS unsigned char* lds, const unsigned* cnt) {
        LAS int* tp = (LAS int*)(lds + LDS_TP); LAS int* cn = (LAS int*)(lds + LDS_TP + 256);
        __syncthreads();
        if (threadIdx.x == 0) { int a = 0; for (int e = 0; e < NE; ++e) { const int cc = (int)__hip_atomic_load(cnt + e, RLX_AGENT); cn[e] = cc; tp[e] = a; a += (cc + 255) >> 8; } tp[NE] = a; }
        __syncthreads();
    }
    __device__ bool next(int i, pg8::Unit& u) const {
        const int nwg = __builtin_amdgcn_readfirstlane(tp[NE]) * nN; const long L = (long)i * G + c; if (L >= nwg) return false;
        int wgid = (int)L; { const int q = nwg / 8, r = nwg % 8, xcd = wgid % 8, off = wgid / 8; wgid = (xcd < r ? xcd * (q + 1) : r * (q + 1) + (xcd - r) * q) + off; }
        int e = 0; while (wgid >= __builtin_amdgcn_readfirstlane(tp[e + 1]) * nN) ++e;
        const int t0 = __builtin_amdgcn_readfirstlane(tp[e]), t1 = __builtin_amdgcn_readfirstlane(tp[e + 1]), ce = __builtin_amdgcn_readfirstlane(cn[e]);
        const int w = wgid - t0 * nN, te = t1 - t0, m = w % te;
        u.pn = w / te; u.pm = t0 + m; u.e = e; u.lrow0 = m * 256; u.nvalid = ce - m * 256; return true;
    }
    __device__ __forceinline__ const char* a_base(const pg8::Unit& u) const { return gather ? A : A + (size_t)u.pm * 256 * DF * 2; }
    __device__ __forceinline__ const char* b_base(const pg8::Unit& u) const { return Bt + (size_t)u.e * bstride_e + (size_t)u.pn * 256 * DM * 2; }
    __device__ __forceinline__ unsigned a_row(const pg8::Unit& u, int r) const { return r < u.nvalid ? (unsigned)(elist[(size_t)u.e * T + u.lrow0 + r] >> 2) : 0u; }
};
namespace pg8 {
struct EpiMoe1 {
    static constexpr bool PERM = true;
    const float* bias; bf16_t* act;
    __device__ __forceinline__ void operator()(const f32x4 (&acc)[2][2][4][2], const Unit& u, int wr, int wc, int fr, int fq) const {
        const int colg = u.pn * BM + wc * 32 + 8 * fq; const float* bp = bias + (size_t)u.e * 2 * DF + colg;
        f32x4 bv[2][2];
#pragma unroll
        for (int bj = 0; bj < 2; ++bj)
#pragma unroll
            for (int n = 0; n < 2; ++n) bv[bj][n] = *(const f32x4*)(bp + bj * HALF + 4 * n);
#pragma unroll
        for (int ai = 0; ai < 2; ++ai)
#pragma unroll
            for (int m = 0; m < 4; ++m) { const int lr = ai * HALF + wr * 64 + m * 16 + fr; bf16_t* rowp = act + (size_t)(u.pm * BM + lr) * DF + (colg >> 1);
                if (lr < u.nvalid) {
#pragma unroll
                for (int bj = 0; bj < 2; ++bj) { const f32x4 v0 = acc[ai][bj][m][0] + bv[bj][0], v1 = acc[ai][bj][m][1] + bv[bj][1];
                    float a[4];
#pragma unroll
                    for (int q = 0; q < 4; ++q) { const float gt = fminf(q < 2 ? v0[2 * q] : v1[2 * q - 4], 7.0f), up = fminf(fmaxf(q < 2 ? v0[2 * q + 1] : v1[2 * q - 3], -7.0f), 7.0f);
                        a[q] = (up + 1.0f) * (gt / (1.0f + __expf(-1.702f * gt))); }
                    u32x2 w; w.x = cvt_pk_bf16(a[0], a[1]); w.y = cvt_pk_bf16(a[2], a[3]);
                    *(u32x2*)(rowp + bj * (HALF / 2)) = w; } } }
    }
};
struct EpiMoe2 {
    static constexpr bool PERM = true;
    const float* bias; bf16_t* yb; const int* elist;
    __device__ __forceinline__ void operator()(const f32x4 (&acc)[2][2][4][2], const Unit& u, int wr, int wc, int fr, int fq) const {
        const int col = u.pn * BM + wc * 32 + 8 * fq; const float* bp = bias + (size_t)u.e * DM + col;
        f32x4 bv[2][2];
#pragma unroll
        for (int bj = 0; bj < 2; ++bj)
#pragma unroll
            for (int n = 0; n < 2; ++n) bv[bj][n] = *(const f32x4*)(bp + bj * HALF + 4 * n);
#pragma unroll
        for (int ai = 0; ai < 2; ++ai)
#pragma unroll
            for (int m = 0; m < 4; ++m) { const int lr = ai * HALF + wr * 64 + m * 16 + fr;
                if (lr < u.nvalid) { const int slot = elist[(size_t)u.e * T + u.lrow0 + lr]; bf16_t* rowp = yb + (size_t)slot * DM + col;
#pragma unroll
                for (int bj = 0; bj < 2; ++bj) { const f32x4 v0 = acc[ai][bj][m][0] + bv[bj][0], v1 = acc[ai][bj][m][1] + bv[bj][1];
                    u32x4 w; w.x = cvt_pk_bf16(v0[0], v0[1]); w.y = cvt_pk_bf16(v0[2], v0[3]); w.z = cvt_pk_bf16(v1[0], v1[1]); w.w = cvt_pk_bf16(v1[2], v1[3]);
                    *(u32x4*)(rowp + bj * HALF) = w; } } }
    }
};
}

constexpr int RW_ST = 136;
__device__ __forceinline__ void ln1_router_pair(int t, int lane, LAS const unsigned char* wimg, const bf16_t* __restrict__ xb_in, const bf16_t* __restrict__ mix, const float* __restrict__ lg, const float* __restrict__ lb,
                                                const float* __restrict__ rb, bf16_t* __restrict__ x1b, unsigned* __restrict__ cnt, int* __restrict__ elist, float* __restrict__ gates) {
    f32x4 xa[4], xb[4];
#pragma unroll
    for (int r = 0; r < 2; ++r) {
        f32x4 y[4]; float s = 0.f; const size_t ro = (size_t)(t + r) * DM;
#pragma unroll
        for (int j = 0; j < 4; ++j) { const int c = 4 * lane + 256 * j; const u32x2 aw = *(const u32x2*)(xb_in + ro + c), mw = *(const u32x2*)(mix + ro + c);
            y[j] = (f32x4){bf2f(aw.x & 0xffffu), bf2f(aw.x >> 16), bf2f(aw.y & 0xffffu), bf2f(aw.y >> 16)} * DN_ALPHA + (f32x4){bf2f(mw.x & 0xffffu), bf2f(mw.x >> 16), bf2f(mw.y & 0xffffu), bf2f(mw.y >> 16)};
            s += (y[j].x + y[j].y) + (y[j].z + y[j].w); }
        const float mean = wave_sum(s) * (1.0f / DM); float s2 = 0.f;
#pragma unroll
        for (int j = 0; j < 4; ++j) { y[j] = y[j] - mean; s2 += (y[j].x * y[j].x + y[j].y * y[j].y) + (y[j].z * y[j].z + y[j].w * y[j].w); }
        const float rstd = 1.0f / sqrtf(wave_sum(s2) * (1.0f / DM) + LN_EPS);
#pragma unroll
        for (int j = 0; j < 4; ++j) { const int c = 4 * lane + 256 * j; const f32x4 gv = *(const f32x4*)(lg + c), bv = *(const f32x4*)(lb + c);
            const f32x4 o = y[j] * rstd * gv + bv;
            u32x2 pb; pb.x = pk2(o.x, o.y); pb.y = pk2(o.z, o.w); *(u32x2*)(x1b + ro + c) = pb;
            if (r == 0) xa[j] = o; else xb[j] = o; }
    }
    float a0[32], a1[32];
#pragma unroll
    for (int e = 0; e < 32; ++e) { a0[e] = 0.f; a1[e] = 0.f; }
#pragma unroll
    for (int j = 0; j < 4; ++j)
#pragma unroll
        for (int k = 0; k < 4; ++k) {
            const float x0 = xa[j][k], x1 = xb[j][k];
            LAS const unsigned char* wr = wimg + (k * 256 + lane + 64 * j) * RW_ST;
#pragma unroll
            for (int q = 0; q < 16; ++q) { const f32x2 w = *(LAS const f32x2*)(wr + 8 * q);
                a0[2 * q] += x0 * w.x; a0[2 * q + 1] += x0 * w.y; a1[2 * q] += x1 * w.x; a1[2 * q + 1] += x1 * w.y; }
            __builtin_amdgcn_sched_barrier(0);
        }
    float v[32];
    { const bool up = lane >= 32;
#pragma unroll
      for (int e = 0; e < 32; ++e) { const float mine = up ? a1[e] : a0[e], send = up ? a0[e] : a1[e]; v[e] = mine + __shfl_xor(send, 32); } }
#pragma unroll
    for (int n = 16; n >= 1; n >>= 1) { const bool up = (lane & n) != 0;
#pragma unroll
        for (int e = 0; e < n; ++e) { const float mine = up ? v[e + n] : v[e], send = up ? v[e] : v[e + n]; v[e] = mine + __shfl_xor(send, n); } }
    const int e = lane & 31, row = t + (lane >> 5);
    float vcur = v[0] + rb[e];
    float topv[4]; int topi[4];
#pragma unroll
    for (int kk = 0; kk < 4; ++kk) {
        float bv = vcur; int bi = e;
#pragma unroll
        for (int off = 1; off < 32; off <<= 1) { const float ov = __shfl_xor(bv, off); const int oi = __shfl_xor(bi, off); if (ov > bv || (ov == bv && oi < bi)) { bv = ov; bi = oi; } }
        topv[kk] = bv; topi[kk] = bi; if (e == bi) vcur = -INFINITY;
    }
    const float e1 = __expf(topv[1] - topv[0]), e2 = __expf(topv[2] - topv[0]), e3 = __expf(topv[3] - topv[0]);
    const float inv = 1.0f / (1.0f + e1 + e2 + e3);
    if (e < 4) {
        const int ee = e == 0 ? topi[0] : e == 1 ? topi[1] : e == 2 ? topi[2] : topi[3];
        const float gg = (e == 0 ? 1.0f : e == 1 ? e1 : e == 2 ? e2 : e3) * inv;
        const unsigned pos = __hip_atomic_fetch_add(cnt + ee, 1u, RLX_AGENT);
        elist[(size_t)ee * T + pos] = row * 4 + e; gates[row * 4 + e] = gg;
    }
}
__device__ __forceinline__ void ln2_row(int t, int lane, const bf16_t* __restrict__ x1b, const bf16_t* __restrict__ yb, const float* __restrict__ gates, const float* __restrict__ lg, const float* __restrict__ lb,
                                        bf16_t* __restrict__ x2b) {
    const float g0 = gates[t * 4], g1 = gates[t * 4 + 1], g2 = gates[t * 4 + 2], g3 = gates[t * 4 + 3];
    f32x4 y[4]; float s = 0.f;
#pragma unroll
    for (int j = 0; j < 4; ++j) { const int c = 4 * lane + 256 * j; const u32x2 aw = *(const u32x2*)(x1b + (size_t)t * DM + c); const f32x4 a = (f32x4){bf2f(aw.x & 0xffffu), bf2f(aw.x >> 16), bf2f(aw.y & 0xffffu), bf2f(aw.y >> 16)};
        f32x4 f = (f32x4){0.f, 0.f, 0.f, 0.f};
#pragma unroll
        for (int kk = 0; kk < 4; ++kk) { const u32x2 w = *(const u32x2*)(yb + (size_t)(t * 4 + kk) * DM + c); const float gk = kk == 0 ? g0 : kk == 1 ? g1 : kk == 2 ? g2 : g3;
            f.x += gk * bf2f(w.x & 0xffffu); f.y += gk * bf2f(w.x >> 16); f.z += gk * bf2f(w.y & 0xffffu); f.w += gk * bf2f(w.y >> 16); }
        y[j] = a * DN_ALPHA + f; s += (y[j].x + y[j].y) + (y[j].z + y[j].w); }
    const float mean = wave_sum(s) * (1.0f / DM); float s2 = 0.f;
#pragma unroll
    for (int j = 0; j < 4; ++j) { y[j] = y[j] - mean; s2 += (y[j].x * y[j].x + y[j].y * y[j].y) + (y[j].z * y[j].z + y[j].w * y[j].w); }
    const float rstd = 1.0f / sqrtf(wave_sum(s2) * (1.0f / DM) + LN_EPS);
#pragma unroll
    for (int j = 0; j < 4; ++j) { const int c = 4 * lane + 256 * j; const f32x4 gv = *(const f32x4*)(lg + c), bv = *(const f32x4*)(lb + c);
        const f32x4 o = y[j] * rstd * gv + bv;
        u32x2 pb; pb.x = pk2(o.x, o.y); pb.y = pk2(o.z, o.w); *(u32x2*)(x2b + (size_t)t * DM + c) = pb; }
}
typedef _Float16 f16x8 __attribute__((ext_vector_type(8)));
typedef float f32x16 __attribute__((ext_vector_type(16)));
typedef short s16x4 __attribute__((ext_vector_type(4)));
__device__ __forceinline__ s16x4 lds_tr16(LAS const unsigned char* p) { return __builtin_bit_cast(s16x4, __builtin_amdgcn_ds_read_tr16_b64_v4i16((LAS s16x4*)p)); }
__device__ __forceinline__ bf16x8 cat4(s16x4 a, s16x4 b) { return __builtin_shufflevector(a, b, 0, 1, 2, 3, 4, 5, 6, 7); }
__device__ __forceinline__ unsigned cvtpk_c(float lo, float hi) { return pg8::cvt_pk_bf16(lo, hi); }
__device__ __forceinline__ float fexp2(float x) { return __builtin_amdgcn_exp2f(x); }
__device__ __forceinline__ float flog2(float x) { return __builtin_amdgcn_logf(x); }

namespace sb {
constexpr int KST = 144, TILE_B = 64 * KST;
__device__ __forceinline__ void attn_phase(LAS unsigned char* lds, const bf16_t* __restrict__ Q, const bf16_t* __restrict__ K, const bf16_t* __restrict__ V, bf16_t* __restrict__ O, int G, int c) {
    int tid = threadIdx.x; asm volatile("" : "+v"(tid));
    const int wid = __builtin_amdgcn_readfirstlane(tid >> 6), lane = tid & 63, n = lane & 31, hi = lane >> 5;
    f16x8 U0, U1, ONE;
#pragma unroll
    for (int j = 0; j < 8; ++j) { const int jp = 8 * (j >> 2) + 4 * hi + (j & 3); U0[j] = (jp > n) ? (_Float16)1.0f : (_Float16)0.0f; U1[j] = (16 + jp > n) ? (_Float16)1.0f : (_Float16)0.0f; ONE[j] = (_Float16)1.0f; }
    const int srow = tid >> 3, sch = tid & 7;
    const int trq = (lane & 15) >> 2, trp = lane & 3, blk = (lane >> 4) & 1;
    for (int it = 0;; ++it) {
        const int L = it * G + c; if (L >= NB * SH * 8) break;
        const int bh = L >> 3, qp = L & 7, qt = ((L >> 8) & 1) ? 7 - qp : qp, b = bh >> 4, h = bh & 15;
        const size_t rowbase = (size_t)b * SEQ;
        const int q0 = qt * 256 + wid * 32;
        bf16x8 qf[4];
        { const bf16_t* qrow = Q + (rowbase + q0 + n) * DM + h * SD + 8 * hi;
#pragma unroll
          for (int ks = 0; ks < 4; ++ks) qf[ks] = *(const bf16x8*)(qrow + 16 * ks); }
        f32x16 o0, o1, carry;
#pragma unroll
        for (int r = 0; r < 16; ++r) { o0[r] = 0.f; o1[r] = 0.f; carry[r] = 0.f; }
        const int nkt = 4 * qt + 4;
        const bf16_t* kg = K + (rowbase + srow) * DM + h * SD + sch * 8; const bf16_t* vg = V + (rowbase + srow) * DM + h * SD + sch * 8;
        { const u32x4 kr = *(const u32x4*)(kg + (size_t)(nkt - 1) * 64 * DM), vr = *(const u32x4*)(vg + (size_t)(nkt - 1) * 64 * DM);
          *(LAS u32x4*)(lds + srow * KST + sch * 16) = kr; *(LAS u32x4*)(lds + 2 * TILE_B + srow * KST + sch * 16) = vr; }
        asm volatile("s_waitcnt lgkmcnt(0)" ::: "memory"); __builtin_amdgcn_s_barrier(); asm volatile("" ::: "memory");
        int cur = 0, par = 0, wdone = 0;
        LAS unsigned* flg = (LAS unsigned*)(lds + 4 * TILE_B);
        for (int kt = nkt - 1; kt >= 0; --kt) {
            if (kt != nkt - 1) { const unsigned f = lane < 8 ? flg[(par ^ 1) * 8 + lane] : 1u; if (__all(f != 0u)) break; }
            u32x4 kr, vr;
            if (kt > 0) { kr = *(const u32x4*)(kg + (size_t)(kt - 1) * 64 * DM); vr = *(const u32x4*)(vg + (size_t)(kt - 1) * 64 * DM); }
            LAS const unsigned char* kb = lds + cur * TILE_B; LAS const unsigned char* vb = lds + (2 + cur) * TILE_B;
#pragma unroll
            for (int sub = 1; sub >= 0; --sub) {
                const int key0 = kt * 64 + sub * 32;
                if (key0 <= q0 && !wdone) {
                    const bool diag = (key0 == q0);
                    f32x16 z;
#pragma unroll
                    for (int r = 0; r < 16; ++r) z[r] = 0.f;
                    { LAS const unsigned char* kp = kb + (sub * 32 + n) * KST + hi * 16;
#pragma unroll
                      for (int ks = 0; ks < 4; ++ks) { const bf16x8 kf = *(LAS const bf16x8*)(kp + ks * 32); z = __builtin_amdgcn_mfma_f32_32x32x16_bf16(kf, qf[ks], z, 0, 0, 0); } }
                    f16x8 lf0, lf1;
#pragma unroll
                    for (int r = 0; r < 16; ++r) {
                        const float zz = z[r];
                        float l = -(fmaxf(zz, 0.f) + flog2(1.0f + fexp2(-fabsf(zz))));
                        float zl = zz + l;
                        if (diag) { const bool valid = ((r & 3) + 8 * (r >> 2) + 4 * hi) < n; l = valid ? l : 0.f; zl = valid ? zl : -INFINITY; }
                        z[r] = zl;
                        if (r < 8) lf0[r] = (_Float16)l; else lf1[r - 8] = (_Float16)l;
                    }
                    f32x16 y = carry;
                    y = __builtin_amdgcn_mfma_f32_32x32x16_f16(U0, lf0, y, 0, 0, 0); y = __builtin_amdgcn_mfma_f32_32x32x16_f16(U1, lf1, y, 0, 0, 0);
                    carry = __builtin_amdgcn_mfma_f32_32x32x16_f16(ONE, lf0, carry, 0, 0, 0); carry = __builtin_amdgcn_mfma_f32_32x32x16_f16(ONE, lf1, carry, 0, 0, 0);
                    bf16x8 pf0, pf1;
                    { unsigned w[8];
#pragma unroll
                      for (int r2 = 0; r2 < 8; ++r2) w[r2] = cvtpk_c(fexp2(z[2 * r2] + y[2 * r2]), fexp2(z[2 * r2 + 1] + y[2 * r2 + 1]));
                      pf0 = __builtin_bit_cast(bf16x8, (u32x4){w[0], w[1], w[2], w[3]}); pf1 = __builtin_bit_cast(bf16x8, (u32x4){w[4], w[5], w[6], w[7]}); }
                    LAS const unsigned char* vp = vb + (sub * 32 + 4 * hi + trq) * KST + (16 * blk + 4 * trp) * 2;
#pragma unroll
                    for (int s = 0; s < 2; ++s) {
                        const bf16x8 va = cat4(lds_tr16(vp + (16 * s) * KST), lds_tr16(vp + (16 * s + 8) * KST));
                        const bf16x8 vc = cat4(lds_tr16(vp + (16 * s) * KST + 64), lds_tr16(vp + (16 * s + 8) * KST + 64));
                        o0 = __builtin_amdgcn_mfma_f32_32x32x16_bf16(va, s ? pf1 : pf0, o0, 0, 0, 0);
                        o1 = __builtin_amdgcn_mfma_f32_32x32x16_bf16(vc, s ? pf1 : pf0, o1, 0, 0, 0);
                    }
                    if (__all(carry[0] < -160.0f)) wdone = 1;
                }
            }
            if (lane == 0) flg[par * 8 + wid] = (unsigned)wdone;
            if (kt > 0) { *(LAS u32x4*)(lds + (cur ^ 1) * TILE_B + srow * KST + sch * 16) = kr; *(LAS u32x4*)(lds + (2 + (cur ^ 1)) * TILE_B + srow * KST + sch * 16) = vr; }
            asm volatile("s_waitcnt lgkmcnt(0)" ::: "memory"); __builtin_amdgcn_s_barrier(); asm volatile("" ::: "memory");
            cur ^= 1; par ^= 1;
        }
        bf16_t* orow = O + (rowbase + q0 + n) * DM + h * SD + 4 * hi;
#pragma unroll
        for (int g4 = 0; g4 < 4; ++g4) {
            u32x2 w0, w1; w0.x = pg8::cvt_pk_bf16(o0[4 * g4], o0[4 * g4 + 1]); w0.y = pg8::cvt_pk_bf16(o0[4 * g4 + 2], o0[4 * g4 + 3]);
            w1.x = pg8::cvt_pk_bf16(o1[4 * g4], o1[4 * g4 + 1]); w1.y = pg8::cvt_pk_bf16(o1[4 * g4 + 2], o1[4 * g4 + 3]);
            *(u32x2*)(orow + 8 * g4) = w0; *(u32x2*)(orow + 32 + 8 * g4) = w1; }
    }
}
}

namespace ret {
constexpr int QST = 528, VST = 144;
constexpr int O_Q = 0, O_K = 64 * QST, O_ST = 2 * 64 * QST, O_V = 3 * 64 * QST, O_VD = O_V + 64 * VST, O_P = O_VD + 64 * VST, LDS_END = O_P + 64 * VST;
static_assert(LDS_END <= 131072, "retention LDS");
__device__ __forceinline__ void scan_phase(LAS unsigned char* lds, const bf16_t* __restrict__ Q, const bf16_t* __restrict__ K, const bf16_t* __restrict__ V, bf16_t* __restrict__ RO, int G, int c) {
    int tid = threadIdx.x; asm volatile("" : "+v"(tid));
    const int wid = __builtin_amdgcn_readfirstlane(tid >> 6), lane = tid & 63, lr = lane & 15, g = lane >> 4;
    const int trq = (lane & 15) >> 2, trp = lane & 3;
    const int tqt = wid >> 1, e2 = 2 * (wid & 1);
    for (int it = 0;; ++it) {
        const int L = it * G + c; if (L >= NB * RH * 8) break;
        const int bh = (L & 7) * 4 + (L >> 6), es = (L >> 3) & 7, b = bh >> 2, h = bh & 3;
        const size_t rowbase = (size_t)b * SEQ;
        const float lg2 = flog2(1.0f - fexp2(-5.0f - (float)h));
        const float cdec = fexp2(lg2 * 64.0f);
        f32x4 S[2][4];
#pragma unroll
        for (int a = 0; a < 2; ++a)
#pragma unroll
            for (int e = 0; e < 4; ++e) S[a][e] = (f32x4){0.f, 0.f, 0.f, 0.f};
        const bf16_t* qg = Q + (rowbase + (tid >> 5)) * DM + h * RDK + (tid & 31) * 8; const bf16_t* kg = K + (rowbase + (tid >> 5)) * DM + h * RDK + (tid & 31) * 8;
        const bf16_t* vg = V + (rowbase + (tid >> 3)) * RHV + h * RDV + es * 64 + (tid & 7) * 8;
        const int sq = (tid >> 5) * QST + (tid & 31) * 16, sv = (tid >> 3) * VST + (tid & 7) * 16;
        const float kdv = fexp2(lg2 * (float)(63 - (tid >> 3)));
        u32x4 rq[4], rk[4], rv;
#pragma unroll
        for (int i = 0; i < 4; ++i) { rq[i] = *(const u32x4*)(qg + (size_t)(16 * i) * DM); rk[i] = *(const u32x4*)(kg + (size_t)(16 * i) * DM); }
        rv = *(const u32x4*)vg;
        __builtin_amdgcn_s_barrier();
        for (int ci = 0; ci < SEQ / 64; ++ci) {
#pragma unroll
            for (int i = 0; i < 4; ++i) { *(LAS u32x4*)(lds + O_Q + sq + 16 * i * QST) = rq[i]; *(LAS u32x4*)(lds + O_K + sq + 16 * i * QST) = rk[i]; }
            { *(LAS u32x4*)(lds + O_V + sv) = rv;
              u32x4 d; d.x = pk2(bf2f(rv.x & 0xffffu) * kdv, bf2f(rv.x >> 16) * kdv); d.y = pk2(bf2f(rv.y & 0xffffu) * kdv, bf2f(rv.y >> 16) * kdv);
              d.z = pk2(bf2f(rv.z & 0xffffu) * kdv, bf2f(rv.z >> 16) * kdv); d.w = pk2(bf2f(rv.w & 0xffffu) * kdv, bf2f(rv.w >> 16) * kdv);
              *(LAS u32x4*)(lds + O_VD + sv) = d; }
#pragma unroll
            for (int a = 0; a < 2; ++a)
#pragma unroll
                for (int e = 0; e < 4; ++e) { u32x2 w; w.x = pg8::cvt_pk_bf16(S[a][e][0], S[a][e][1]); w.y = pg8::cvt_pk_bf16(S[a][e][2], S[a][e][3]);
                    *(LAS u32x2*)(lds + O_ST + (16 * e + lr) * QST + (32 * wid + 16 * a + 4 * g) * 2) = w; }
            asm volatile("s_waitcnt lgkmcnt(0)" ::: "memory"); __builtin_amdgcn_s_barrier(); asm volatile("" ::: "memory");
            if (ci + 1 < SEQ / 64) {
#pragma unroll
                for (int i = 0; i < 4; ++i) { rq[i] = *(const u32x4*)(qg + (size_t)((ci + 1) * 64 + 16 * i) * DM); rk[i] = *(const u32x4*)(kg + (size_t)((ci + 1) * 64 + 16 * i) * DM); }
                rv = *(const u32x4*)(vg + (size_t)(ci + 1) * 64 * RHV);
            }
            f32x4 pacc[2], oacc[2];
#pragma unroll
            for (int x = 0; x < 2; ++x) { pacc[x] = (f32x4){0.f, 0.f, 0.f, 0.f}; oacc[x] = (f32x4){0.f, 0.f, 0.f, 0.f}; }
            { LAS const unsigned char* qp = lds + O_Q + (16 * tqt + lr) * QST + 16 * g;
              LAS const unsigned char* kp = lds + O_K + (16 * e2 + lr) * QST + 16 * g;
              LAS const unsigned char* sp = lds + O_ST + (16 * e2 + lr) * QST + 16 * g;
#pragma unroll
              for (int ks = 0; ks < 8; ++ks) {
                  const bf16x8 qa = *(LAS const bf16x8*)(qp + 64 * ks);
                  const bf16x8 k0 = *(LAS const bf16x8*)(kp + 64 * ks), k1 = *(LAS const bf16x8*)(kp + 16 * QST + 64 * ks);
                  const bf16x8 s0 = *(LAS const bf16x8*)(sp + 64 * ks), s1 = *(LAS const bf16x8*)(sp + 16 * QST + 64 * ks);
                  pacc[0] = __builtin_amdgcn_mfma_f32_16x16x32_bf16(k0, qa, pacc[0], 0, 0, 0); pacc[1] = __builtin_amdgcn_mfma_f32_16x16x32_bf16(k1, qa, pacc[1], 0, 0, 0);
                  oacc[0] = __builtin_amdgcn_mfma_f32_16x16x32_bf16(qa, s0, oacc[0], 0, 0, 0); oacc[1] = __builtin_amdgcn_mfma_f32_16x16x32_bf16(qa, s1, oacc[1], 0, 0, 0);
              } }
#pragma unroll
            for (int x = 0; x < 2; ++x) { float pv[4];
#pragma unroll
                for (int i = 0; i < 4; ++i) { const int dist = (16 * tqt + lr) - (16 * (e2 + x) + 4 * g + i); pv[i] = pacc[x][i] * fexp2(lg2 * fabsf((float)dist)); }
                u32x2 w; w.x = pg8::cvt_pk_bf16(pv[0], pv[1]); w.y = pg8::cvt_pk_bf16(pv[2], pv[3]);
                *(LAS u32x2*)(lds + O_P + (16 * tqt + lr) * VST + (16 * (e2 + x) + 4 * g) * 2) = w; }
#pragma unroll
            for (int i = 0; i < 4; ++i) { const float qd = fexp2(lg2 * (float)(16 * tqt + 4 * g + i + 1)); oacc[0][i] *= qd; oacc[1][i] *= qd; }
            asm volatile("s_waitcnt lgkmcnt(0)" ::: "memory"); __builtin_amdgcn_s_barrier(); asm volatile("" ::: "memory");
            { LAS const unsigned char* pp = lds + O_P + (16 * tqt + lr) * VST + 16 * g;
              LAS const unsigned char* vp = lds + O_V + (8 * g + trq) * VST + (16 * e2 + 4 * trp) * 2;
#pragma unroll
              for (int ks = 0; ks < 2; ++ks) {
                  const bf16x8 pa = *(LAS const bf16x8*)(pp + 64 * ks);
                  const bf16x8 v0 = cat4(lds_tr16(vp + (32 * ks) * VST), lds_tr16(vp + (32 * ks + 4) * VST));
                  const bf16x8 v1 = cat4(lds_tr16(vp + (32 * ks) * VST + 32), lds_tr16(vp + (32 * ks + 4) * VST + 32));
                  oacc[0] = __builtin_amdgcn_mfma_f32_16x16x32_bf16(pa, v0, oacc[0], 0, 0, 0); oacc[1] = __builtin_amdgcn_mfma_f32_16x16x32_bf16(pa, v1, oacc[1], 0, 0, 0);
              } }
            { bf16_t* op = RO + (rowbase + ci * 64 + 16 * tqt + 4 * g) * RHV + h * RDV + es * 64 + 16 * e2 + lr;
#pragma unroll
              for (int i = 0; i < 4; ++i) { op[(size_t)i * RHV] = (bf16_t)f2bf(oacc[0][i]); op[(size_t)i * RHV + 16] = (bf16_t)f2bf(oacc[1][i]); } }
#pragma unroll
            for (int a = 0; a < 2; ++a)
#pragma unroll
                for (int e = 0; e < 4; ++e) S[a][e] = S[a][e] * cdec;
            { LAS const unsigned char* ktp = lds + O_K + (8 * g + trq) * QST + (32 * wid + 4 * trp) * 2;
              LAS const unsigned char* vtp = lds + O_VD + (8 * g + trq) * VST + (4 * trp) * 2;
#pragma unroll
              for (int ks = 0; ks < 2; ++ks) {
                  bf16x8 ka[2], vb[4];
#pragma unroll
                  for (int a = 0; a < 2; ++a) ka[a] = cat4(lds_tr16(ktp + (32 * ks) * QST + 32 * a), lds_tr16(ktp + (32 * ks + 4) * QST + 32 * a));
#pragma unroll
                  for (int e = 0; e < 4; ++e) vb[e] = cat4(lds_tr16(vtp + (32 * ks) * VST + 32 * e), lds_tr16(vtp + (32 * ks + 4) * VST + 32 * e));
#pragma unroll
                  for (int a = 0; a < 2; ++a)
#pragma unroll
                      for (int e = 0; e < 4; ++e) S[a][e] = __builtin_amdgcn_mfma_f32_16x16x32_bf16(ka[a], vb[e], S[a][e], 0, 0, 0);
              } }
            asm volatile("s_waitcnt lgkmcnt(0)" ::: "memory"); __builtin_amdgcn_s_barrier(); asm volatile("" ::: "memory");
        }
    }
}
__device__ __forceinline__ void gate_row(int w, int lane, const bf16_t* __restrict__ ro, const bf16_t* __restrict__ g, bf16_t* __restrict__ gn) {
    const u32x4 rw = *(const u32x4*)(ro + (size_t)w * RDV + 8 * lane), gw = *(const u32x4*)(g + (size_t)w * RDV + 8 * lane);
    float xv[8] = {bf2f(rw.x & 0xffffu), bf2f(rw.x >> 16), bf2f(rw.y & 0xffffu), bf2f(rw.y >> 16), bf2f(rw.z & 0xffffu), bf2f(rw.z >> 16), bf2f(rw.w & 0xffffu), bf2f(rw.w >> 16)};
    float gv[8] = {bf2f(gw.x & 0xffffu), bf2f(gw.x >> 16), bf2f(gw.y & 0xffffu), bf2f(gw.y >> 16), bf2f(gw.z & 0xffffu), bf2f(gw.z >> 16), bf2f(gw.w & 0xffffu), bf2f(gw.w >> 16)};
    float s = 0.f;
#pragma unroll
    for (int j = 0; j < 8; ++j) s += xv[j];
    const float mean = wave_sum(s) * (1.0f / RDV); float s2 = 0.f;
#pragma unroll
    for (int j = 0; j < 8; ++j) { xv[j] -= mean; s2 += xv[j] * xv[j]; }
    const float rstd = 1.0f / sqrtf(wave_sum(s2) * (1.0f / RDV) + GN_EPS);
    unsigned wv[4];
#pragma unroll
    for (int j = 0; j < 4; ++j) { const float g0 = gv[2 * j], g1 = gv[2 * j + 1];
        wv[j] = pg8::cvt_pk_bf16(g0 / (1.0f + __expf(-g0)) * (xv[2 * j] * rstd), g1 / (1.0f + __expf(-g1)) * (xv[2 * j + 1] * rstd)); }
    *(u32x4*)(gn + (size_t)w * RDV + 8 * lane) = (u32x4){wv[0], wv[1], wv[2], wv[3]};
}
}
struct Args { const float* in[19]; float* out; unsigned char* ws; int ph_lo, ph_hi, bar_region, pad; };
#define CAS __attribute__((address_space(4)))
#define PHASE_ARGS() const CAS Args* ka = (const CAS Args*)__builtin_amdgcn_kernarg_segment_ptr(); asm volatile("" : "+s"(ka) :: "memory"); unsigned char* const ws = ka->ws; (void)ws; int ptid = threadIdx.x; asm volatile("" : "+v"(ptid)); const int lane = ptid & 63, wave = __builtin_amdgcn_readfirstlane(ptid >> 6); (void)lane; (void)wave
#define WSP(type, off) ((type*)(ws + (off)))
#ifndef PH_MASK
#define PH_MASK 0xffff
#endif
#define ON(b) ((PH_MASK >> (b)) & 1)
__global__ void __launch_bounds__(NWAVES * 64, 2) mega(Args args) {
    extern __shared__ __attribute__((aligned(16))) unsigned char lds_raw[];
    LAS unsigned char* lds = (LAS unsigned char*)lds_raw;
    const int tid = threadIdx.x;
    const int G = gridDim.x;
    for (int u = tid; u < (LDS_BYTES - LDSCTL_OFF) / 4; u += NWAVES * 64) ((LAS unsigned*)(lds + LDSCTL_OFF))[u] = 0u;
    __syncthreads();
    XcdBarrier bar = xcd_barrier_post((unsigned*)(args.ws + OFF_CTL) + CW_BAR + args.bar_region * XCD_BAR_WORDS, (volatile LAS unsigned*)(lds + MISC_OFF) + 8);
    const int lo = args.ph_lo, hi = args.ph_hi;
#define IN(k) (lo <= (k) && (k) < hi)
#define SEAM(k) do { if (IN(k) && IN((k) + 1)) xcd_barrier(bar); } while (0)

    if (ON(0) && IN(0)) {
        PHASE_ARGS();
        LAS float* scr = (LAS float*)(lds + RING_OFF + wave * 16384);
        const int gw = blockIdx.x * NWAVES + wave, ngw = G * NWAVES;
        p0_transpose_all(ka->in[2], WSP(bf16_t, OFF_WRI), 2, DM, RIN, scr, gw, ngw, lane);
        p0_transpose_all(ka->in[3], WSP(bf16_t, OFF_WRO), 2, RHV, DM, scr, gw, ngw, lane);
        p0_transpose_all(ka->in[4], WSP(bf16_t, OFF_WSI), 2, DM, 3 * DM, scr, gw, ngw, lane);
        p0_transpose_all(ka->in[5], WSP(bf16_t, OFF_WSO), 2, DM, DM, scr, gw, ngw, lane);
        p0_transpose_all(ka->in[17], WSP(bf16_t, OFF_WPG), 4, DM, DM, scr, gw, ngw, lane);
        p0_transpose_all(ka->in[16], WSP(bf16_t, OFF_WPW), 4, DPLE, DM, scr, gw, ngw, lane);
        p0_transpose_all(ka->in[10], WSP(bf16_t, OFF_WGU), 128, DM, 2 * DF, scr, gw, ngw, lane);
        p0_transpose_all(ka->in[12], WSP(bf16_t, OFF_WDN), 128, DF, DM, scr, gw, ngw, lane);
        const size_t gt = (size_t)blockIdx.x * (NWAVES * 64) + ptid, ngt = (size_t)G * NWAVES * 64;
        { const f32x4* x = (const f32x4*)ka->in[0]; u32x2* xb = WSP(u32x2, OFF_XB);
          for (size_t i = gt; i < (size_t)T * DM / 4; i += ngt) { const f32x4 v = x[i]; u32x2 o; o.x = pk2(v.x, v.y); o.y = pk2(v.z, v.w); xb[i] = o; } }
        { const f32x4* p = (const f32x4*)ka->in[1]; u32x2* pb = WSP(u32x2, OFF_PB);
          for (size_t i = gt; i < (size_t)4 * T * DPLE / 4; i += ngt) { const f32x4 v = p[i]; u32x2 o; o.x = pk2(v.x, v.y); o.y = pk2(v.z, v.w); pb[i] = o; } }
        { float* rope = WSP(float, OFF_ROPE);
          for (size_t i = gt; i < (size_t)SEQ * 128; i += ngt) { const int pos = (int)(i >> 7), d = (int)(i & 127);
            const float invf = 1.0f / powf(10000.0f, (float)d / 128.0f); const float ang = (float)pos * invf;
            rope[2 * i] = (float)cos((double)ang); rope[2 * i + 1] = (float)sin((double)ang); } }
    }
    SEAM(0);
    if (ON(1) && IN(1)) {
        PHASE_ARGS();
        PPOrder S; S.G = G; S.c = (int)blockIdx.x; S.A = (const char*)WSP(bf16_t, OFF_PB); S.Bt = (const char*)WSP(bf16_t, OFF_WPW);
        pg8::EpiBf16 E{WSP(bf16_t, OFF_PPB), DM, 0, 0, 1.0f, (size_t)T * DM};
        pg8::gemm_phase<pg8::EpiBf16, PPOrder, true, false>(lds + RING_OFF, DPLE, S, E);
    }
    SEAM(1);
#pragma unroll 1
    for (int i = 0; i < DEPTH; ++i) {
        const int pb = 2 + 10 * i, j = i >> 1;
        if (IN(pb)) {
            if (ON(2) && (i & 1) == 0) {
                PHASE_ARGS();
                pg8::DenseOrder S; S.init(T, RIN, DM, G, (int)blockIdx.x, WSP(bf16_t, OFF_XB), WSP(bf16_t, OFF_WRI) + (size_t)j * RIN * DM);
                pg8::EpiRetProj E{WSP(bf16_t, OFF_Q), WSP(bf16_t, OFF_K), WSP(bf16_t, OFF_V), WSP(bf16_t, OFF_G), WSP(float, OFF_ROPE)};
                pg8::gemm_phase<pg8::EpiRetProj, pg8::DenseOrder, true, false>(lds + RING_OFF, DM, S, E);
            } else if (ON(3) && (i & 1) == 1) {
                PHASE_ARGS();
                pg8::DenseOrder S; S.init(T, 3 * DM, DM, G, (int)blockIdx.x, WSP(bf16_t, OFF_XB), WSP(bf16_t, OFF_WSI) + (size_t)j * 3 * DM * DM);
                pg8::EpiBf16 E{WSP(bf16_t, OFF_Q), DM, DM, (size_t)(OFF_K - OFF_Q) / 2, 0.125f * 1.4426950408889634f, 0};
                pg8::gemm_phase<pg8::EpiBf16, pg8::DenseOrder, true, false>(lds + RING_OFF, DM, S, E);
            }
        }
        SEAM(pb);
        if (IN(pb + 1)) {
            if (ON(10) && (i & 1) == 0) { PHASE_ARGS(); ret::scan_phase(lds + RING_OFF, WSP(bf16_t, OFF_Q), WSP(bf16_t, OFF_K), WSP(bf16_t, OFF_V), WSP(bf16_t, OFF_RO), G, (int)blockIdx.x); }
            else if (ON(11) && (i & 1) == 1) { PHASE_ARGS(); sb::attn_phase(lds + RING_OFF, WSP(bf16_t, OFF_Q), WSP(bf16_t, OFF_K), WSP(bf16_t, OFF_V), WSP(bf16_t, OFF_GN), G, (int)blockIdx.x); }
        }
        SEAM(pb + 1);
        if (ON(12) && IN(pb + 2) && (i & 1) == 0) {
            PHASE_ARGS();
            for (int w = blockIdx.x * NWAVES + wave; w < T * RH; w += G * NWAVES) ret::gate_row(w, lane, WSP(bf16_t, OFF_RO), WSP(bf16_t, OFF_G), WSP(bf16_t, OFF_GN));
        }
        if ((i & 1) == 0) SEAM(pb + 2);
        if (ON(4) && IN(pb + 3)) {
            PHASE_ARGS();
            pg8::EpiBf16 E{WSP(bf16_t, OFF_MIX), DM, 0, 0, 1.0f, 0};
            const int Kx = (i & 1) ? DM : RHV;
            pg8::DenseOrder S; S.init(T, DM, Kx, G, (int)blockIdx.x, WSP(bf16_t, OFF_GN), (i & 1) ? (const void*)(WSP(bf16_t, OFF_WSO) + (size_t)j * DM * DM) : (const void*)(WSP(bf16_t, OFF_WRO) + (size_t)j * DM * RHV));
            pg8::gemm_phase<pg8::EpiBf16, pg8::DenseOrder, false, false>(lds + RING_OFF, Kx, S, E);
        }
        SEAM(pb + 3);
        if (ON(6) && IN(pb + 4)) {
            PHASE_ARGS();
            { const f32x4* rw4 = (const f32x4*)(ka->in[8] + (size_t)i * DM * NE);
              for (int q = ptid; q < DM * NE / 4; q += NWAVES * 64) { const int c = q >> 3, ch = q & 7; const f32x4 w = rw4[q];
                  LAS unsigned char* d = lds + RING_OFF + ((c & 3) * 256 + (c >> 2)) * RW_ST + ch * 16; *(LAS f32x2*)d = (f32x2){w.x, w.y}; *(LAS f32x2*)(d + 8) = (f32x2){w.z, w.w}; } }
            __syncthreads();
            unsigned* cnt = WSP(unsigned, OFF_CTL) + CW_CNT + i * 64;
            const float* lg = ka->in[6] + (size_t)i * DM; const float* lb = ka->in[7] + (size_t)i * DM; const float* rb = ka->in[9] + (size_t)i * NE;
            for (int t = 2 * (blockIdx.x * NWAVES + wave); t < T; t += 2 * G * NWAVES)
                ln1_router_pair(t, lane, lds + RING_OFF, WSP(bf16_t, OFF_XB), WSP(bf16_t, OFF_MIX), lg, lb, rb, WSP(bf16_t, OFF_X1B), cnt, WSP(int, OFF_EL), WSP(float, OFF_GT));
            __syncthreads();
        }
        SEAM(pb + 4);
        if (ON(7) && IN(pb + 5)) {
            PHASE_ARGS();
            MoeOrder::setup(lds, WSP(unsigned, OFF_CTL) + CW_CNT + i * 64);
            MoeOrder S; S.G = G; S.c = (int)blockIdx.x; S.nN = 2 * DF / 256; S.tp = (const LAS int*)(lds + LDS_TP); S.cn = (const LAS int*)(lds + LDS_TP + 256); S.elist = WSP(int, OFF_EL);
            S.A = (const char*)WSP(bf16_t, OFF_X1B); S.Bt = (const char*)(WSP(bf16_t, OFF_WGU) + (size_t)i * NE * 2 * DF * DM); S.bstride_e = (size_t)2 * DF * DM * 2; S.gather = true; S.roff = (LAS unsigned*)(lds + LDS_ROFF);
            pg8::EpiMoe1 E{ka->in[11] + (size_t)i * NE * 2 * DF, WSP(bf16_t, OFF_ACT)};
            pg8::gemm_phase<pg8::EpiMoe1, MoeOrder, true, true>(lds + RING_OFF, DM, S, E);
        }
        SEAM(pb + 5);
        if (ON(8) && IN(pb + 6)) {
            PHASE_ARGS();
            MoeOrder::setup(lds, WSP(unsigned, OFF_CTL) + CW_CNT + i * 64);
            MoeOrder S; S.G = G; S.c = (int)blockIdx.x; S.nN = DM / 256; S.tp = (const LAS int*)(lds + LDS_TP); S.cn = (const LAS int*)(lds + LDS_TP + 256); S.elist = WSP(int, OFF_EL);
            S.A = (const char*)WSP(bf16_t, OFF_ACT); S.Bt = (const char*)(WSP(bf16_t, OFF_WDN) + (size_t)i * NE * DM * DF); S.bstride_e = (size_t)DM * DF * 2; S.gather = false; S.roff = (LAS unsigned*)(lds + LDS_ROFF);
            pg8::EpiMoe2 E{ka->in[13] + (size_t)i * NE * DM, WSP(bf16_t, OFF_YB), WSP(int, OFF_EL)};
            pg8::gemm_phase<pg8::EpiMoe2, MoeOrder, true, false>(lds + RING_OFF, DF, S, E);
        }
        SEAM(pb + 6);
        if (ON(9) && IN(pb + 7)) {
            PHASE_ARGS();
            const float* lg = ka->in[14] + (size_t)i * DM; const float* lb = ka->in[15] + (size_t)i * DM;
            for (int t = blockIdx.x * NWAVES + wave; t < T; t += G * NWAVES)
                ln2_row(t, lane, WSP(bf16_t, OFF_X1B), WSP(bf16_t, OFF_YB), WSP(float, OFF_GT), lg, lb, WSP(bf16_t, OFF_X2B));
        }
        SEAM(pb + 7);
        if (ON(5) && IN(pb + 8)) {
            PHASE_ARGS();
            pg8::DenseOrder S; S.init(T, DM, DM, G, (int)blockIdx.x, WSP(bf16_t, OFF_X2B), WSP(bf16_t, OFF_WPG) + (size_t)i * DM * DM);
            pg8::EpiPle E{WSP(bf16_t, OFF_X2B), WSP(bf16_t, OFF_PPB) + (size_t)i * T * DM, ka->in[18] + (size_t)i * DM, WSP(bf16_t, OFF_XB), i == DEPTH - 1 ? ka->out : nullptr};
            pg8::gemm_phase<pg8::EpiPle, pg8::DenseOrder, false, false>(lds + RING_OFF, DM, S, E);
        }
        SEAM(pb + 8);
    }
#undef IN
#undef SEAM
}
static int g_grid = 0;
extern "C" void kernel_launch(void* const* d_in, const int* in_sizes, int n_in, void* d_out, int out_size, void* d_ws, size_t ws_size, hipStream_t stream) {
    if (n_in != 19 || ws_size < WS_END || out_size != T * DM) { fprintf(stderr, "kernel_launch: unexpected arguments (n_in %d, ws %zu need %zu, out %d)\n", n_in, ws_size, (size_t)WS_END, out_size); return; }
    if (g_grid == 0) {
        int dev = 0, cus = 0;
        if (hipGetDevice(&dev) != hipSuccess || hipDeviceGetAttribute(&cus, hipDeviceAttributeMultiprocessorCount, dev) != hipSuccess) { g_grid = -1; return; }
        if (hipFuncSetAttribute((const void*)mega, hipFuncAttributeMaxDynamicSharedMemorySize, LDS_BYTES) != hipSuccess) { g_grid = -1; return; }
        int per_cu = 0; (void)hipOccupancyMaxActiveBlocksPerMultiprocessor(&per_cu, (const void*)mega, NWAVES * 64, LDS_BYTES); (void)hipGetLastError();
        if (per_cu < 1) fprintf(stderr, "kernel_launch: occupancy query reports %d workgroups per CU\n", per_cu);
        g_grid = cus;
    }
    if (g_grid < 0) return;
    (void)hipMemsetAsync((unsigned char*)d_ws + OFF_CTL, 0, MiB, stream);
    Args a{};
    for (int i = 0; i < 19; ++i) a.in[i] = (const float*)d_in[i];
    a.out = (float*)d_out; a.ws = (unsigned char*)d_ws; a.ph_lo = 0; a.ph_hi = 2 + 10 * DEPTH; a.bar_region = 0; a.pad = 0;
    hipLaunchKernelGGL(mega, dim3(g_grid), dim3(NWAVES * 64), LDS_BYTES, stream, a);
}
```

```cpp
#include <hip/hip_runtime.h>
#include <stdint.h>
#include <cstdio>

typedef unsigned short bf16_t;
typedef short bf16x8 __attribute__((ext_vector_type(8)));
typedef float f32x4 __attribute__((ext_vector_type(4)));
typedef unsigned u32x4 __attribute__((ext_vector_type(4)));
typedef unsigned u32x2 __attribute__((ext_vector_type(2)));

constexpr int DM = 1024, NB = 8, SEQ = 2048, DEPTH = 4, T = NB * SEQ;
constexpr int RH = 4, RDK = 256, RDV = 512, RIN = 6144, RHV = RH * RDV;
constexpr int SH = 16, SD = 64;
constexpr int NE = 32, TOPK = 4, DF = 1024, DPLE = 256;
constexpr int NSLOT = T * TOPK;
constexpr int RPAD = NSLOT + NE * 256;
constexpr float DN_ALPHA = 1.6817928305074290f;
constexpr float LN_EPS = 1e-5f, GN_EPS = 1e-6f;

constexpr size_t MiB = (size_t)1 << 20;
constexpr size_t al(size_t x) { return (x + 255) & ~(size_t)255; }
constexpr size_t OFF_CTL = 0;
constexpr size_t OFF_WRI = OFF_CTL + MiB;
constexpr size_t OFF_WRO = OFF_WRI + al((size_t)2 * RIN * DM * 2);
constexpr size_t OFF_WSI = OFF_WRO + al((size_t)2 * DM * RHV * 2);
constexpr size_t OFF_WSO = OFF_WSI + al((size_t)2 * 3 * DM * DM * 2);
constexpr size_t OFF_WPG = OFF_WSO + al((size_t)2 * DM * DM * 2);
constexpr size_t OFF_WPW = OFF_WPG + al((size_t)4 * DM * DM * 2);
constexpr size_t OFF_WGU = OFF_WPW + al((size_t)4 * DM * DPLE * 2);
constexpr size_t OFF_WDN = OFF_WGU + al((size_t)128 * 2 * DF * DM * 2);
constexpr size_t OFF_PB  = OFF_WDN + al((size_t)128 * DM * DF * 2);
constexpr size_t OFF_XF  = OFF_PB  + al((size_t)4 * T * DPLE * 2);
constexpr size_t OFF_XB  = OFF_XF  + al((size_t)T * DM * 4);
constexpr size_t OFF_X1F = OFF_XB  + al((size_t)T * DM * 2);
constexpr size_t OFF_X1B = OFF_X1F + al((size_t)T * DM * 4);
constexpr size_t OFF_X2F = OFF_X1B + al((size_t)T * DM * 2);
constexpr size_t OFF_X2B = OFF_X2F + al((size_t)T * DM * 4);
constexpr size_t OFF_MIX = OFF_X2B + al((size_t)T * DM * 2);
constexpr size_t OFF_Q   = OFF_MIX + al((size_t)T * DM * 4);
constexpr size_t OFF_K   = OFF_Q   + al((size_t)T * DM * 2);
constexpr size_t OFF_V   = OFF_K   + al((size_t)T * DM * 2);
constexpr size_t OFF_G   = OFF_V   + al((size_t)T * RHV * 2);
constexpr size_t OFF_RO  = OFF_G   + al((size_t)T * RHV * 2);
constexpr size_t OFF_GN  = OFF_RO  + al((size_t)T * RHV * 4);
constexpr size_t OFF_ACT = OFF_GN  + al((size_t)T * RHV * 2);
constexpr size_t OFF_YB  = OFF_ACT + al((size_t)RPAD * DF * 2);
constexpr size_t OFF_PPB = OFF_YB  + al((size_t)(NSLOT + 1) * DM * 2);
constexpr size_t OFF_EL  = OFF_PPB + al((size_t)4 * T * DM * 2);
constexpr size_t OFF_GT  = OFF_EL  + al((size_t)NE * T * 4);
constexpr size_t OFF_ROPE= OFF_GT  + al((size_t)NSLOT * 4);
constexpr size_t OFF_PROJ= OFF_ROPE+ al((size_t)SEQ * 128 * 2 * 4);
constexpr size_t WS_END  = OFF_PROJ+ al((size_t)T * RIN * 4);
constexpr int CW_CNT = 16384;

__device__ __forceinline__ unsigned f2bf(float f) { unsigned u = __float_as_uint(f); return (u + 0x7fffu + ((u >> 16) & 1u)) >> 16; }
typedef float pk_f32x2 __attribute__((ext_vector_type(2))); typedef __bf16 pk_bf16x2 __attribute__((ext_vector_type(2)));
__device__ __forceinline__ unsigned pk2(float lo, float hi) { pk_f32x2 v = {lo, hi}; return __builtin_bit_cast(unsigned, __builtin_convertvector(v, pk_bf16x2)); }
__device__ __forceinline__ float bf2f(unsigned b) { return __uint_as_float(b << 16); }
template <int CTRL> __device__ __forceinline__ float dpp_f(float v) { return __builtin_bit_cast(float, __builtin_amdgcn_update_dpp(0, __builtin_bit_cast(int, v), CTRL, 0xf, 0xf, true)); }
__device__ __forceinline__ float lane_f(float v, int l) { return __builtin_bit_cast(float, __builtin_amdgcn_readlane(__builtin_bit_cast(int, v), l)); }
__device__ __forceinline__ float wave_sum(float v) {
    v += dpp_f<0xB1>(v); v += dpp_f<0x4E>(v); v += dpp_f<0x141>(v); v += dpp_f<0x140>(v);
    return (lane_f(v, 0) + lane_f(v, 16)) + (lane_f(v, 32) + lane_f(v, 48));
}
__device__ __forceinline__ float sigmoidf_(float x) { return 1.0f / (1.0f + __expf(-x)); }

#define LAS __attribute__((address_space(3)))
#define GAS __attribute__((address_space(1)))
namespace pg8 {
constexpr int BM = 256, BK = 64, HALF = 128, HTB = HALF * BK * 2  , STAGE_BYTES = 8 * HTB, NXCD = 8, WGM = 8;
__host__ __device__ __forceinline__ int lds_byte(int r, int c) { const int st = (r >> 4) * 2 + (c >> 5), rr = r & 15, cc = c & 31, ob = rr * 64 + cc * 2; return st * 1024 + (ob ^ (((ob >> 9) & 1) << 5)); }
__host__ __device__ __forceinline__ void stage_rc(int b, int& R, int& C) { const int st = b / 1024, sb = b % 1024, swz = sb ^ (((sb >> 9) & 1) << 5); R = (st >> 1) * 16 + swz / 64; C = (st & 1) * 32 + (swz % 64) / 2; }
__host__ __device__ __forceinline__ int perm32(int rho) { const int n = rho >> 4, i = rho & 15; return 8 * (i >> 2) + 4 * n + (i & 3); }
struct Unit { int pm, pn, e, lrow0, nvalid; };
template <class E> struct PermOf { static __host__ __device__ __forceinline__ int f(int rho) { return perm32(rho); } };
typedef float f32x2_t __attribute__((ext_vector_type(2))); typedef __bf16 bf16x2_t __attribute__((ext_vector_type(2)));
__device__ __forceinline__ unsigned cvt_pk_bf16(float lo, float hi) { f32x2_t v = {lo, hi}; bf16x2_t b = __builtin_convertvector(v, bf16x2_t); return __builtin_bit_cast(unsigned, b); }

struct DenseOrder {
    int nM, nN, nwg, G, c; const char* A; const char* Bt; size_t tstep;
    __device__ void init(int M, int N, int K, int G_, int c_, const void* A_, const void* Bt_) { nM = M / BM; nN = N / BM; nwg = nM * nN; G = G_; c = c_; A = (const char*)A_; Bt = (const char*)Bt_; tstep = (size_t)BM * K * 2; }
    __device__ bool next(int i, Unit& u) const {
        const long L = (long)i * G + c; if (L >= nwg) return false;
        int wgid = (int)L; { const int q = nwg / NXCD, r = nwg % NXCD, xcd = wgid % NXCD, off = wgid / NXCD; wgid = (xcd < r ? xcd * (q + 1) : r * (q + 1) + (xcd - r) * q) + off; }
        const int nig = WGM * nN, gid = wgid / nig, fm = gid * WGM, gsz = (nM - fm) < WGM ? (nM - fm) : WGM;
        u.pm = fm + ((wgid % nig) % gsz); u.pn = (wgid % nig) / gsz; u.e = 0; u.lrow0 = 0; u.nvalid = BM; return true;
    }
    __device__ __forceinline__ const char* a_base(const Unit& u) const { return A + (size_t)u.pm * tstep; }
    __device__ __forceinline__ const char* b_base(const Unit& u) const { return Bt + (size_t)u.pn * tstep; }
    __device__ __forceinline__ void prep(const Unit&, int, int, int) const {}
    __device__ __forceinline__ void prep_load(const Unit&, int, int&, f32x4&) const {}
    __device__ __forceinline__ void prep_store(int, int, int, int, const f32x4&) const {}
    static constexpr bool HAS_PREP = false;
    LAS unsigned* roff;
};
struct EpiF32 {
    static constexpr bool PERM = false; static constexpr int NSTORE = 16;
    float* C; int ldc;
    __device__ __forceinline__ void operator()(const f32x4 (&acc)[2][2][4][2], const Unit& u, int wr, int wc, int fr, int fq, int) const {
        const int row0 = u.pm * BM + wr * 64 + fr, col0 = u.pn * BM + wc * 32 + 4 * fq;
#pragma unroll
        for (int ai = 0; ai < 2; ++ai)
#pragma unroll
            for (int m = 0; m < 4; ++m) { float* rowp = C + (size_t)(row0 + ai * HALF + m * 16) * ldc + col0;
#pragma unroll
                for (int bj = 0; bj < 2; ++bj)
#pragma unroll
                    for (int n = 0; n < 2; ++n) *(f32x4*)(rowp + bj * HALF + n * 16) = acc[ai][bj][m][n]; }
    }
};
struct EpiBf16 {
    static constexpr bool PERM = true; static constexpr int NSTORE = 16;
    bf16_t* O; int ldc; int split_cols; size_t split_stride; float scale0; size_t estride;
    __device__ __forceinline__ void operator()(const f32x4 (&acc)[2][2][4][2], const Unit& u, int wr, int wc, int fr, int fq, int) const {
        const int row0 = u.pm * BM + wr * 64 + fr; int colt = u.pn * BM; bf16_t* base = O + (size_t)u.e * estride;
        float sc = 1.f; if (split_cols) { const int t = colt / split_cols; base += (size_t)t * split_stride; colt -= t * split_cols; if (t == 0) sc = scale0; }
        const int col0 = colt + wc * 32 + 8 * fq; const bool scaled = __builtin_amdgcn_readfirstlane(sc != 1.0f ? 1 : 0) != 0;
#pragma unroll
        for (int ai = 0; ai < 2; ++ai)
#pragma unroll
            for (int m = 0; m < 4; ++m) { bf16_t* rowp = base + (size_t)(row0 + ai * HALF + m * 16) * ldc + col0;
#pragma unroll
                for (int bj = 0; bj < 2; ++bj) { f32x4 v0 = acc[ai][bj][m][0], v1 = acc[ai][bj][m][1];
                    if (scaled) { v0 = v0 * sc; v1 = v1 * sc; }
                    u32x4 w; w.x = cvt_pk_bf16(v0[0], v0[1]); w.y = cvt_pk_bf16(v0[2], v0[3]); w.z = cvt_pk_bf16(v1[0], v1[1]); w.w = cvt_pk_bf16(v1[2], v1[3]);
                    *(u32x4*)(rowp + bj * HALF) = w; } }
    }
};
struct EpiRetProj {
    static constexpr bool PERM = true; static constexpr int NSTORE = 16;
    bf16_t *Q, *Kk, *V, *G; const LAS float* invf;
    __device__ __forceinline__ void operator()(const f32x4 (&acc)[2][2][4][2], const Unit& u, int wr, int wc, int fr, int fq, int) const {
        const int row0 = u.pm * BM + wr * 64 + fr, pn = u.pn;
        if (pn < 8) {
            const int h = pn & 3; bf16_t* dst = pn < 4 ? Q : Kk; const float sc = pn < 4 ? 1.0f : 0.0625f; const int d0 = wc * 32 + 8 * fq;
            const f32x4 f0 = *(const LAS f32x4*)(invf + d0), f1 = *(const LAS f32x4*)(invf + d0 + 4);
            const float fv[8] = {f0[0], f0[1], f0[2], f0[3], f1[0], f1[1], f1[2], f1[3]};
#pragma unroll
            for (int ai = 0; ai < 2; ++ai)
#pragma unroll
                for (int m = 0; m < 4; ++m) { const int r = row0 + ai * HALF + m * 16; const float pos = (float)(r & (SEQ - 1));
                    float cs[8], sn[8];
#pragma unroll
                    for (int q = 0; q < 8; ++q) { const float ang = pos * fv[q];
                        float rev = ang * 0.15915494309189535f; rev = rev - __builtin_floorf(rev); cs[q] = __builtin_amdgcn_cosf(rev); sn[q] = __builtin_amdgcn_sinf(rev); }
                    const f32x4 xa = acc[ai][0][m][0], xb = acc[ai][0][m][1], ya = acc[ai][1][m][0], yb = acc[ai][1][m][1];
                    const float x[8] = {xa[0], xa[1], xa[2], xa[3], xb[0], xb[1], xb[2], xb[3]}, y[8] = {ya[0], ya[1], ya[2], ya[3], yb[0], yb[1], yb[2], yb[3]};
                    u32x4 w1, w2;
                    w1.x = cvt_pk_bf16((x[0] * cs[0] - y[0] * sn[0]) * sc, (x[1] * cs[1] - y[1] * sn[1]) * sc); w1.y = cvt_pk_bf16((x[2] * cs[2] - y[2] * sn[2]) * sc, (x[3] * cs[3] - y[3] * sn[3]) * sc);
                    w1.z = cvt_pk_bf16((x[4] * cs[4] - y[4] * sn[4]) * sc, (x[5] * cs[5] - y[5] * sn[5]) * sc); w1.w = cvt_pk_bf16((x[6] * cs[6] - y[6] * sn[6]) * sc, (x[7] * cs[7] - y[7] * sn[7]) * sc);
                    w2.x = cvt_pk_bf16((x[0] * sn[0] + y[0] * cs[0]) * sc, (x[1] * sn[1] + y[1] * cs[1]) * sc); w2.y = cvt_pk_bf16((x[2] * sn[2] + y[2] * cs[2]) * sc, (x[3] * sn[3] + y[3] * cs[3]) * sc);
                    w2.z = cvt_pk_bf16((x[4] * sn[4] + y[4] * cs[4]) * sc, (x[5] * sn[5] + y[5] * cs[5]) * sc); w2.w = cvt_pk_bf16((x[6] * sn[6] + y[6] * cs[6]) * sc, (x[7] * sn[7] + y[7] * cs[7]) * sc);
                    bf16_t* o = dst + (size_t)r * DM + h * RDK + d0;
                    *(u32x4*)o = w1; *(u32x4*)(o + 128) = w2; }
        } else {
            bf16_t* dst = pn < 16 ? V : G; const int cb = (pn < 16 ? pn - 8 : pn - 16) * BM + wc * 32 + 8 * fq;
#pragma unroll
            for (int ai = 0; ai < 2; ++ai)
#pragma unroll
                for (int m = 0; m < 4; ++m) { bf16_t* rowp = dst + (size_t)(row0 + ai * HALF + m * 16) * RHV + cb;
#pragma unroll
                    for (int bj = 0; bj < 2; ++bj) { const f32x4 v0 = acc[ai][bj][m][0], v1 = acc[ai][bj][m][1];
                        u32x4 w; w.x = cvt_pk_bf16(v0[0], v0[1]); w.y = cvt_pk_bf16(v0[2], v0[3]); w.z = cvt_pk_bf16(v1[0], v1[1]); w.w = cvt_pk_bf16(v1[2], v1[3]);
                        *(u32x4*)(rowp + bj * HALF) = w; } }
        }
    }
};
template <bool OUT> struct EpiPle {
    static constexpr bool PERM = true; static constexpr int NSTORE = 16;
    const bf16_t* x2b; const bf16_t* pp; const float* bg; bf16_t* xb; float* out;
    __device__ __forceinline__ void operator()(const f32x4 (&acc)[2][2][4][2], const Unit& u, int wr, int wc, int fr, int fq, int) const {
        const int row0 = u.pm * BM + wr * 64 + fr, col0 = u.pn * BM + wc * 32 + 8 * fq;
        f32x4 bv[2][2];
#pragma unroll
        for (int bj = 0; bj < 2; ++bj)
#pragma unroll
            for (int n = 0; n < 2; ++n) bv[bj][n] = *(const f32x4*)(bg + col0 + bj * HALF + 4 * n);
        u32x4 xw = *(const u32x4*)(x2b + (size_t)row0 * DM + col0), pw = *(const u32x4*)(pp + (size_t)row0 * DM + col0);
#pragma unroll
        for (int s = 0; s < 16; ++s) { const int ai = s >> 3, m = (s >> 1) & 3, bj = s & 1;
            const size_t o = (size_t)(row0 + ai * HALF + m * 16) * DM + col0 + bj * HALF;
            const u32x4 xc = xw, pc = pw;
            if (s + 1 < 16) { const int s1 = s + 1, ai1 = s1 >> 3, m1 = (s1 >> 1) & 3, bj1 = s1 & 1; const size_t o1 = (size_t)(row0 + ai1 * HALF + m1 * 16) * DM + col0 + bj1 * HALF;
                xw = *(const u32x4*)(x2b + o1); pw = *(const u32x4*)(pp + o1); }
            __builtin_amdgcn_sched_barrier(0);
            const unsigned xs[4] = {xc.x, xc.y, xc.z, xc.w}, ps[4] = {pc.x, pc.y, pc.z, pc.w};
            float r[8];
#pragma unroll
            for (int q = 0; q < 4; ++q) { const f32x4 a = acc[ai][bj][m][q >> 1] + bv[bj][q >> 1]; const int e0 = 2 * (q & 1);
                r[2 * q] = bf2f(xs[q] & 0xffffu) + bf2f(ps[q] & 0xffffu) * __builtin_amdgcn_rcpf(1.0f + __expf(-a[e0])); r[2 * q + 1] = bf2f(xs[q] >> 16) + bf2f(ps[q] >> 16) * __builtin_amdgcn_rcpf(1.0f + __expf(-a[e0 + 1])); }
            u32x4 w; w.x = cvt_pk_bf16(r[0], r[1]); w.y = cvt_pk_bf16(r[2], r[3]); w.z = cvt_pk_bf16(r[4], r[5]); w.w = cvt_pk_bf16(r[6], r[7]);
            *(u32x4*)(xb + o) = w;
            if constexpr (OUT) { *(f32x4*)(out + o) = (f32x4){r[0], r[1], r[2], r[3]}; *(f32x4*)(out + o + 4) = (f32x4){r[4], r[5], r[6], r[7]}; }
            asm volatile("" ::: "memory"); }
    }
};

template <class Epi, class Sched, bool ALIGN_EPI, bool GATHER>
__device__ __forceinline__ void gemm_phase(LAS unsigned char* lds, const int Kin, const Sched& S, const Epi& E) {
    int tid = threadIdx.x; asm volatile("" : "+v"(tid));
    const int wid = __builtin_amdgcn_readfirstlane(tid >> 6), lane = tid & 63, wr = wid >> 2, wc = wid & 3, fr = lane & 15, fq = lane >> 4;
    int K = __builtin_amdgcn_readfirstlane(Kin); asm volatile("" : "+s"(K));
    const int nt = K / BK;
    unsigned voffB[2], voffA[2], vG[2][2];
#pragma unroll
    for (int i = 0; i < 2; ++i) { int R, C; stage_rc(tid * 16 + i * 8192, R, C); const int Rb = Epi::PERM ? ((R & ~31) + PermOf<Epi>::f(R & 31)) : R;
        voffB[i] = (unsigned)(Rb * K + C) * 2u; voffA[i] = (unsigned)(R * K + C) * 2u; }
    const size_t kstep = (size_t)(BK * 2);
    const size_t hstep = (size_t)HALF * K * 2;
    const unsigned ldsw = (unsigned)wid * 1024u;
    const int aoff = lds_byte(wr * 64 + fr, fq * 8), boff = lds_byte(wc * 32 + fr, fq * 8);
#define PG8_SA(b, h) (((b) * 2 + (h)) * HTB)
#define PG8_SB(b, h) ((4 + (b) * 2 + (h)) * HTB)
#define PG8_STAGE(bufoff, gbase, voff) do { _Pragma("unroll") for (int _i = 0; _i < 2; ++_i) { unsigned _o = (voff)[_i]; if constexpr (GATHER) asm volatile("" : "+v"(_o)); \
        __builtin_amdgcn_global_load_lds((const unsigned*)((const char*)(gbase) + _o), (LAS unsigned*)(lds + (bufoff) + ldsw + _i * 8192), 16, 0, 0); } } while (0)
#define PG8_STAGEA(bufoff, gbase, h, vg) do { if constexpr (GATHER) { PG8_STAGE(bufoff, gbase, vg[h]); } else { PG8_STAGE(bufoff, (gbase) + (h) * hstep, voffA); } } while (0)
#define PG8_LDA(dst, b, h) do { _Pragma("unroll") for (int m = 0; m < 4; ++m) _Pragma("unroll") for (int k = 0; k < 2; ++k) dst[m][k] = *(const LAS bf16x8*)(lds + PG8_SA(b, h) + aoff + m * 2048 + k * 1024); } while (0)
#define PG8_LDB(dst, b, h) do { _Pragma("unroll") for (int n = 0; n < 2; ++n) _Pragma("unroll") for (int k = 0; k < 2; ++k) dst[n][k] = *(const LAS bf16x8*)(lds + PG8_SB(b, h) + boff + n * 2048 + k * 1024); } while (0)
#define PG8_MMA(ai, bj, At, Bt) do { __builtin_amdgcn_s_setprio(1); _Pragma("unroll") for (int m = 0; m < 4; ++m) _Pragma("unroll") for (int n = 0; n < 2; ++n) _Pragma("unroll") for (int k = 0; k < 2; ++k) \
        acc[ai][bj][m][n] = __builtin_amdgcn_mfma_f32_16x16x32_bf16(Bt[n][k], At[m][k], acc[ai][bj][m][n], 0, 0, 0); __builtin_amdgcn_s_setprio(0); } while (0)
#define PG8_WAIT_V(n) asm volatile("s_waitcnt vmcnt(" #n ")" ::: "memory")
#define PG8_WAIT_L(n) asm volatile("s_waitcnt lgkmcnt(" #n ")" ::: "memory")
#define PG8_WAIT_VF(flag, n) asm volatile("v_cmp_ne_u32_e32 vcc, 0, %0\n\ts_cbranch_vccz .Lw8_%=\n\ts_waitcnt vmcnt(%1)\n\ts_branch .Lwd_%=\n.Lw8_%=:\n\ts_waitcnt vmcnt(8)\n.Lwd_%=:" :: "v"(flag), "n"(n) : "memory", "vcc")
#define PG8_BAR __builtin_amdgcn_s_barrier()
#define PG8_SCHED __builtin_amdgcn_sched_barrier(0)
#define PG8_TABLE(u, par) do { S.prep(u, par, tid, K); } while (0)
#define PG8_GREAD(dst) do { _Pragma("unroll") for (int _i = 0; _i < 2; ++_i) { int _R, _C; stage_rc(tid * 16 + _i * 8192, _R, _C); _Pragma("unroll") for (int _h = 0; _h < 2; ++_h) dst[_h][_i] = S.roff[_h * HALF + _R] + (unsigned)_C * 2u; } } while (0)
    Unit cur, nxt; int ui = 0; int pslot = 0; f32x4 pbias = (f32x4){0.f, 0.f, 0.f, 0.f};
    if (!S.next(0, cur)) return;
    f32x4 acc[2][2][4][2];
#pragma unroll
    for (int a = 0; a < 2; ++a)
#pragma unroll
        for (int b = 0; b < 2; ++b)
#pragma unroll
            for (int m = 0; m < 4; ++m)
#pragma unroll
                for (int n = 0; n < 2; ++n) { f32x2_t zl, zh; asm volatile("v_pk_mov_b32 %0, 0, 0" : "=v"(zl)); asm volatile("v_pk_mov_b32 %0, 0, 0" : "=v"(zh)); acc[a][b][m][n] = (f32x4){zl[0], zl[1], zh[0], zh[1]}; }
    bf16x8 At[4][2], B0[2][2], B1[2][2];
    const char* cA = S.a_base(cur); const char* cB = S.b_base(cur);
    if constexpr (Sched::HAS_PREP) { PG8_TABLE(cur, 0); asm volatile("s_waitcnt vmcnt(0) lgkmcnt(0)" ::: "memory"); __builtin_amdgcn_s_barrier(); asm volatile("" ::: "memory"); }
    if constexpr (GATHER) { PG8_GREAD(vG); }
    PG8_STAGE(PG8_SB(0, 0), cB, voffB); PG8_STAGE(PG8_SB(0, 1), cB + hstep, voffB); PG8_STAGEA(PG8_SA(0, 0), cA, 0, vG); PG8_STAGEA(PG8_SA(0, 1), cA, 1, vG);
    if (wr == 1) PG8_BAR;
    PG8_WAIT_V(2); PG8_BAR;
    PG8_STAGE(PG8_SB(1, 0), cB + kstep, voffB); PG8_STAGEA(PG8_SA(1, 0), cA + kstep, 0, vG); PG8_STAGE(PG8_SB(1, 1), cB + hstep + kstep, voffB);
    PG8_WAIT_V(6); PG8_BAR;
    for (;;) {
        const bool has_next = S.next(ui + 1, nxt);
        const char* nA = has_next ? S.a_base(nxt) : cA; const char* nB = has_next ? S.b_base(nxt) : cB;
        for (int t = 0; t < nt; t += 2) {
            const bool last = (t == nt - 2);
            const int fresh = (t == 0 && ui > 0) ? 1 : 0;
            const char* a1 = cA + (size_t)(t + 1) * kstep;
            const char* a2 = last ? nA : cA + (size_t)(t + 2) * kstep; const char* b2 = last ? nB : cB + (size_t)(t + 2) * kstep;
            const char* a3 = a2 + kstep; const char* b3 = b2 + kstep;
            if constexpr (Sched::HAS_PREP) {
                if (t == nt - 4 && has_next) S.prep_load(nxt, tid, pslot, pbias);
                if (last && has_next) S.prep_store((ui + 1) & 1, tid, K, pslot, pbias); }
            PG8_LDB(B0, 0, 0); PG8_LDB(B1, 0, 1); PG8_SCHED; PG8_LDA(At, 0, 0); PG8_STAGEA(PG8_SA(1, 1), a1, 1, vG);
            PG8_WAIT_VF(fresh, 8 + Epi::NSTORE); PG8_WAIT_L(0); PG8_BAR; PG8_MMA(0, 0, At, B0); PG8_MMA(0, 1, At, B1); PG8_BAR; PG8_SCHED;
            if constexpr (GATHER) { if (last && has_next) { PG8_GREAD(vG); } }
            PG8_LDA(At, 0, 1); PG8_STAGE(PG8_SB(0, 0), b2, voffB); PG8_STAGE(PG8_SB(0, 1), b2 + hstep, voffB); PG8_STAGEA(PG8_SA(0, 0), a2, 0, vG);
            PG8_WAIT_VF(fresh, 8 + Epi::NSTORE); PG8_WAIT_L(0); PG8_BAR; PG8_MMA(1, 0, At, B0); PG8_MMA(1, 1, At, B1); PG8_BAR; PG8_SCHED;
            PG8_LDB(B0, 1, 0); PG8_LDB(B1, 1, 1); PG8_SCHED; PG8_LDA(At, 1, 0); PG8_STAGEA(PG8_SA(0, 1), a2, 1, vG);
            PG8_WAIT_V(8); PG8_WAIT_L(0); PG8_BAR; PG8_MMA(0, 0, At, B0); PG8_MMA(0, 1, At, B1); PG8_BAR; PG8_SCHED;
            PG8_LDA(At, 1, 1); PG8_STAGE(PG8_SB(1, 0), b3, voffB); PG8_STAGE(PG8_SB(1, 1), b3 + hstep, voffB); PG8_STAGEA(PG8_SA(1, 0), a3, 0, vG);
            PG8_WAIT_V(8); PG8_WAIT_L(0); PG8_BAR; PG8_MMA(1, 0, At, B0); PG8_MMA(1, 1, At, B1); PG8_BAR; PG8_SCHED;
        }
        if constexpr (ALIGN_EPI) { if (wr == 0) PG8_BAR; }
        { int el = lane; asm volatile("" : "+v"(el));
          E(acc, cur, wr, wc, el & 15, el >> 4, ui & 1); }
        if (!has_next) break;
#pragma unroll
        for (int a = 0; a < 2; ++a)
#pragma unroll
            for (int b = 0; b < 2; ++b)
#pragma unroll
                for (int m = 0; m < 4; ++m)
#pragma unroll
                    for (int n = 0; n < 2; ++n) { f32x2_t zl, zh; asm volatile("v_pk_mov_b32 %0, 0, 0" : "=v"(zl)); asm volatile("v_pk_mov_b32 %0, 0, 0" : "=v"(zh)); acc[a][b][m][n] = (f32x4){zl[0], zl[1], zh[0], zh[1]}; }
        cur = nxt; cA = nA; cB = nB; ++ui;
        if constexpr (ALIGN_EPI) { if (wr == 1) PG8_BAR; }
    }
    PG8_WAIT_V(0);
    if constexpr (!ALIGN_EPI) { if (wr == 0) PG8_BAR; }
    PG8_BAR;
#undef PG8_SA
#undef PG8_SB
#undef PG8_STAGE
#undef PG8_STAGEA
#undef PG8_LDA
#undef PG8_LDB
#undef PG8_MMA
#undef PG8_WAIT_V
#undef PG8_WAIT_L
#undef PG8_WAIT_VF
#undef PG8_BAR
#undef PG8_SCHED
#undef PG8_TABLE
#undef PG8_GREAD
}
}
typedef float f32x2 __attribute__((ext_vector_type(2)));
constexpr int NWAVES = 8;
constexpr int RING_OFF = 0, RING_BYTES = 139264;
constexpr int LDSCTL_OFF = RING_BYTES, MISC_OFF = LDSCTL_OFF + 320;
constexpr int LDS_BYTES = 147456;
constexpr int CW_BAR = 4096;
typedef GAS unsigned gu32;
#define RLX_AGENT __ATOMIC_RELAXED, __HIP_MEMORY_SCOPE_AGENT

#define XB_TMO      128
#define XB_XCNT(j)  (256  + 64 * (j))
#define XB_XSUB(j)  (1280 + 64 * (j))
#define XB_XGEN(j)  (2304 + 64 * (j))
#define XB_TOP      3328
#define XB_TOPGEN   3392
#define XCD_BAR_WORDS 3456
#define XB_SPIN_CAP (1u << 18)
__device__ __forceinline__ unsigned xb_ld(unsigned* p)              { return __hip_atomic_load(p, __ATOMIC_RELAXED, __HIP_MEMORY_SCOPE_AGENT); }
__device__ __forceinline__ unsigned xb_add(unsigned* p, unsigned v) { return __hip_atomic_fetch_add(p, v, __ATOMIC_RELAXED, __HIP_MEMORY_SCOPE_AGENT); }
__device__ __forceinline__ unsigned xb_xcc_id() { return (unsigned)__builtin_amdgcn_s_getreg((3 << 11) | 20) & 0xFu; }
#define XB_SPIN(cond, bar) do { unsigned _sp = 0; while (cond) { __builtin_amdgcn_s_sleep(1); \
    if ((++_sp & 255u) == 0u) { if (xb_ld(&(bar)[XB_TMO])) break; if (_sp > XB_SPIN_CAP) { atomicAdd(&(bar)[XB_TMO], 1u); break; } } } } while (0)
struct XcdBarrier { unsigned* bar; unsigned x; volatile LAS unsigned* st; };
__device__ __forceinline__ XcdBarrier xcd_barrier_post(unsigned* bar, volatile LAS unsigned* st) {
    XcdBarrier b; b.bar = bar; b.x = xb_xcc_id(); b.st = st;
    if (threadIdx.x == 0) (void)xb_add(&bar[XB_XCNT(b.x)], 1u);
    return b;
}
__device__ __forceinline__ void xcd_barrier_complete(unsigned* bar, unsigned x, unsigned& nloc, unsigned& nx) {
    const unsigned G = gridDim.x * gridDim.y * gridDim.z;
    unsigned sum, cnt, mine, sp = 0u;
    for (;;) {
        sum = 0u; cnt = 0u; mine = 0u;
#pragma unroll
        for (unsigned j = 0; j < 16; ++j) { const unsigned c = xb_ld(&bar[XB_XCNT(j)]); sum += c; cnt += (c > 0u) ? 1u : 0u; mine = (j == x) ? c : mine; }
        if (sum == G) break;
        __builtin_amdgcn_s_sleep(1);
        if ((++sp & 255u) == 0u) { if (xb_ld(&bar[XB_TMO])) break; if (sp > XB_SPIN_CAP) { atomicAdd(&bar[XB_TMO], 1u); break; } }
    }
    nloc = mine > 0u ? mine : 1u; nx = cnt > 0u ? cnt : 1u;
}
__device__ __forceinline__ void xcd_barrier(const XcdBarrier& b) {
    asm volatile("s_waitcnt vmcnt(0)" ::: "memory");
    __syncthreads();
    if (threadIdx.x == 0) {
        unsigned* bar = b.bar;
        __builtin_amdgcn_s_waitcnt(0);
        unsigned nloc = b.st[0], nx = b.st[1];
        if (nloc == 0u) { xcd_barrier_complete(bar, b.x, nloc, nx); b.st[0] = nloc; b.st[1] = nx; }
        const unsigned old = xb_add(&bar[XB_XSUB(b.x)], 1u);
        const unsigned gen = old / nloc;
        if (old + 1u == (gen + 1u) * nloc) {
            __builtin_amdgcn_fence(__ATOMIC_RELEASE, "agent");
            asm volatile("s_waitcnt vmcnt(0)" ::: "memory");
            const unsigned og = xb_add(&bar[XB_TOP], 1u);
            const unsigned tg = og / nx;
            if (og + 1u == (tg + 1u) * nx) xb_add(&bar[XB_TOPGEN], 1u);
            else XB_SPIN(xb_ld(&bar[XB_TOPGEN]) == tg, bar);
            __builtin_amdgcn_fence(__ATOMIC_ACQUIRE, "agent");
            xb_add(&bar[XB_XGEN(b.x)], 1u);
            asm volatile("s_waitcnt vmcnt(0)" ::: "memory");
        } else {
            XB_SPIN(xb_ld(&bar[XB_XGEN(b.x)]) == gen, bar);
            __builtin_amdgcn_fence(__ATOMIC_ACQUIRE, "agent");
            asm volatile("s_waitcnt vmcnt(0)" ::: "memory");
        }
    }
    __syncthreads();
}

__device__ __forceinline__ void p0_transpose_item(const float* __restrict__ Wm, int K, int N, bf16_t* __restrict__ WTm, LAS float* scr, int item, int lane) {
    const int nblk = N / 32, kb = item / nblk, nbk = item % nblk, k0 = 64 * kb, n0 = 32 * nbk;
#pragma unroll 8
    for (int i = 0; i < 32; ++i) { const int kk = 2 * i + (lane >> 5); scr[kk * 33 + (lane & 31)] = Wm[(size_t)(k0 + kk) * N + n0 + (lane & 31)]; }
    asm volatile("s_waitcnt lgkmcnt(0)" ::: "memory");
    const int c = lane & 7;
#pragma unroll
    for (int j = 0; j < 4; ++j) { const int n = (lane >> 3) + 8 * j; const LAS float* s = scr + (8 * c) * 33 + n;
        u32x4 o; o.x = pk2(s[0 * 33], s[1 * 33]); o.y = pk2(s[2 * 33], s[3 * 33]); o.z = pk2(s[4 * 33], s[5 * 33]); o.w = pk2(s[6 * 33], s[7 * 33]);
        *(u32x4*)(WTm + (size_t)(n0 + n) * K + k0 + 8 * c) = o; }
    asm volatile("s_waitcnt lgkmcnt(0)" ::: "memory");
}
__device__ __forceinline__ void p0_transpose_range(const float* W, bf16_t* WT, int K, int N, LAS float* scr, long it0, long itend, int step, int lane) {
    const int nblk = N / 32, per = (K / 64) * nblk;
    if (it0 >= itend) return;
    float RA[32], RB[32];
#define P0_LOAD(R, itv) do { const int mb_ = (int)((itv) / per), item_ = (int)((itv) % per), k0_ = 64 * (item_ / nblk), n0_ = 32 * (item_ % nblk); \
        const float* src_ = W + (size_t)mb_ * K * N + (size_t)(k0_ + (lane >> 5)) * N + n0_ + (lane & 31); \
        _Pragma("unroll") for (int i_ = 0; i_ < 32; ++i_) R[i_] = __builtin_nontemporal_load(src_ + (size_t)(2 * i_) * N); } while (0)
#define P0_EMIT(R, itv) do { \
        _Pragma("unroll") for (int i_ = 0; i_ < 32; ++i_) scr[(2 * i_ + (lane >> 5)) * 33 + (lane & 31)] = R[i_]; \
        asm volatile("s_waitcnt lgkmcnt(0)" ::: "memory"); \
        { const int mb = (int)((itv) / per), item = (int)((itv) % per), k0 = 64 * (item / nblk), n0 = 32 * (item % nblk); bf16_t* WTm = WT + (size_t)mb * K * N; const int c = lane & 7; \
          _Pragma("unroll") for (int j = 0; j < 4; ++j) { const int n = (lane >> 3) + 8 * j; const LAS float* sp = scr + (8 * c) * 33 + n; \
              u32x4 o; o.x = pk2(sp[0 * 33], sp[1 * 33]); o.y = pk2(sp[2 * 33], sp[3 * 33]); o.z = pk2(sp[4 * 33], sp[5 * 33]); o.w = pk2(sp[6 * 33], sp[7 * 33]); \
              *(u32x4*)(WTm + (size_t)(n0 + n) * K + k0 + 8 * c) = o; } } \
        asm volatile("s_waitcnt lgkmcnt(0)" ::: "memory"); } while (0)
    long ia = it0, ib = it0 + step;
    P0_LOAD(RA, ia);
    if (ib < itend) P0_LOAD(RB, ib);
    for (;;) {
        const long ca = ia; P0_EMIT(RA, ca);
        ia = ib + step; if (ia < itend) P0_LOAD(RA, ia);
        if (ib >= itend) break;
        const long cb = ib; P0_EMIT(RB, cb);
        ib = ia + step; if (ib < itend) P0_LOAD(RB, ib);
        if (ia >= itend) break;
    }
#undef P0_LOAD
#undef P0_EMIT
}
__device__ __forceinline__ void p0_transpose_all(const float* W, bf16_t* WT, int nb, int K, int N, LAS float* scr, int gw, int ngw, int lane) {
    p0_transpose_range(W, WT, K, N, scr, gw, (long)nb * (K / 64) * (N / 32), ngw, lane);
}
#ifndef CVT_TAIL_CLAIMS
#define CVT_TAIL_CLAIMS 3
#endif
constexpr int CVT_GU = NE * (DM / 64) * (2 * DF / 32), CVT_DN = NE * (DF / 64) * (DM / 32), CVT_ITEMS = CVT_GU + CVT_DN;
constexpr int CW_CVT = 1024;
constexpr int LDS_CLAIM = LDSCTL_OFF + 960;
__device__ __forceinline__ void cvt_expert_weights(LAS unsigned char* lds, const float* wgu, const float* wdn, unsigned char* ws, int layer, int max_claims, int tid) {
    const int wave = __builtin_amdgcn_readfirstlane(tid >> 6), lane = tid & 63;
    LAS float* scr = (LAS float*)(lds + RING_OFF + wave * 16384);
    volatile LAS unsigned* cw = (volatile LAS unsigned*)(lds + LDS_CLAIM);
    unsigned* ctr = (unsigned*)(ws + OFF_CTL) + CW_CVT + 64 * layer;
    for (int r = 0; r < max_claims; ++r) {
        __syncthreads();
        if (tid == 0) *cw = __hip_atomic_fetch_add(ctr, 32u, RLX_AGENT);
        __syncthreads();
        const int base = __builtin_amdgcn_readfirstlane((int)*cw) + ((layer & 1) ? CVT_GU : 0);
        if (base >= CVT_ITEMS) break;
        const long it0 = base + 4 * wave;
        if (base < CVT_GU) p0_transpose_range(wgu + (size_t)layer * NE * DM * 2 * DF, (bf16_t*)(ws + OFF_WGU) + (size_t)layer * NE * 2 * DF * DM, DM, 2 * DF, scr, it0, it0 + 4, 1, lane);
        else p0_transpose_range(wdn + (size_t)layer * NE * DF * DM, (bf16_t*)(ws + OFF_WDN) + (size_t)layer * NE * DM * DF, DF, DM, scr, it0 - CVT_GU, it0 - CVT_GU + 4, 1, lane);
    }
    __syncthreads();
}

struct PPOrder {
    int G, c, lim; const char* A; const char* Bt;
    __device__ bool next(int i, pg8::Unit& u) const { const int L = i * G + c; if (L >= lim) return false; u.e = L >> 8; u.pm = (L & 255) >> 2; u.pn = L & 3; u.lrow0 = 0; u.nvalid = 256; return true; }
    __device__ __forceinline__ const char* a_base(const pg8::Unit& u) const { return A + ((size_t)u.e * T + (size_t)u.pm * 256) * DPLE * 2; }
    __device__ __forceinline__ const char* b_base(const pg8::Unit& u) const { return Bt + ((size_t)u.e * DM + (size_t)u.pn * 256) * DPLE * 2; }
    __device__ __forceinline__ void prep(const pg8::Unit&, int, int, int) const {}
    __device__ __forceinline__ void prep_load(const pg8::Unit&, int, int&, f32x4&) const {}
    __device__ __forceinline__ void prep_store(int, int, int, int, const f32x4&) const {}
    static constexpr bool HAS_PREP = false;
    LAS unsigned* roff;
};

constexpr int LDS_ROFF = LDSCTL_OFF + 2048;
constexpr int LDS_SLOT = LDSCTL_OFF + 3072;
constexpr int LDS_BIAS = LDSCTL_OFF + 5120;
constexpr int LDS_INVF = LDSCTL_OFF + 7168;
constexpr int LDS_TP = LDSCTL_OFF + 1024;
struct MoeOrder {
    LAS unsigned* roff; int G, c, nN; const LAS int* tp; const LAS int* cn; const int* elist; const char* A; const char* Bt; size_t bstride_e; bool gather;
    static __device__ __forceinline__ void setup(LAS unsigned char* lds, const unsigned* cnt) {
        LAS int* tp = (LAS int*)(lds + LDS_TP); LAS int* cn = (LAS int*)(lds + LDS_TP + 256);
        __syncthreads();
        if (threadIdx.x < NE) cn[threadIdx.x] = (int)__hip_atomic_load(cnt + threadIdx.x * 64, RLX_AGENT);
        __syncthreads();
        if (threadIdx.x == 0) { int a = 0; for (int e = 0; e < NE; ++e) { tp[e] = a; a += (cn[e] + 255) >> 8; } tp[NE] = a; }
        __syncthreads();
    }
    mutable int ehint = 0, nwg_c = -1;
    __device__ bool next(int i, pg8::Unit& u) const {
        if (nwg_c < 0) nwg_c = __builtin_amdgcn_readfirstlane(tp[NE]) * nN;
        const int nwg = nwg_c; const long L = (long)i * G + c; if (L >= nwg) return false;
        int wgid = (int)L; { const int q = nwg / 8, r = nwg % 8, xcd = wgid % 8, off = wgid / 8; wgid = (xcd < r ? xcd * (q + 1) : r * (q + 1) + (xcd - r) * q) + off; }
        int e = ehint; int t0 = __builtin_amdgcn_readfirstlane(tp[e]); if (wgid < t0 * nN) { e = 0; t0 = 0; }
        int t1 = __builtin_amdgcn_readfirstlane(tp[e + 1]);
        while (wgid >= t1 * nN) { ++e; t0 = t1; t1 = __builtin_amdgcn_readfirstlane(tp[e + 1]); }
        ehint = e;
        const int ce = __builtin_amdgcn_readfirstlane(cn[e]);
        const int w = wgid - t0 * nN, te = t1 - t0, m = w % te;
        u.pn = w / te; u.pm = t0 + m; u.e = e; u.lrow0 = m * 256; u.nvalid = ce - m * 256; return true;
    }
    __device__ __forceinline__ const char* a_base(const pg8::Unit& u) const { return gather ? A : A + (size_t)u.pm * 256 * DF * 2; }
    __device__ __forceinline__ const char* b_base(const pg8::Unit& u) const { return Bt + (size_t)u.e * bstride_e + (size_t)u.pn * 256 * DM * 2; }
    static constexpr bool HAS_PREP = true;
    const float* bias; int bias_e;
    LAS int* slotT; LAS float* biasT;
    __device__ __forceinline__ void prep(const pg8::Unit& u, int par, int tid, int K) const {
        if (tid < 256) { const int slot = tid < u.nvalid ? elist[(size_t)u.e * T + u.lrow0 + tid] : (gather ? 0 : NSLOT);
            if (gather) roff[tid] = (unsigned)(slot >> 2) * (unsigned)(K * 2); else slotT[par * 256 + tid] = slot; }
        else if (tid < 320) { const int q = tid - 256; const f32x4 b = *(const f32x4*)(bias + (size_t)u.e * bias_e + u.pn * 256 + 4 * q); *(LAS f32x4*)(biasT + par * 256 + 4 * q) = b; }
    }
    __device__ __forceinline__ void prep_load(const pg8::Unit& u, int tid, int& slot, f32x4& b) const {
        if (tid < 256) slot = tid < u.nvalid ? elist[(size_t)u.e * T + u.lrow0 + tid] : (gather ? 0 : NSLOT);
        else if (tid < 320) b = *(const f32x4*)(bias + (size_t)u.e * bias_e + u.pn * 256 + 4 * (tid - 256));
    }
    __device__ __forceinline__ void prep_store(int par, int tid, int K, int slot, const f32x4& b) const {
        if (tid < 256) { if (gather) roff[tid] = (unsigned)(slot >> 2) * (unsigned)(K * 2); else slotT[par * 256 + tid] = slot; }
        else if (tid < 320) *(LAS f32x4*)(biasT + par * 256 + 4 * (tid - 256)) = b;
    }
};
namespace pg8 {
struct EpiMoe1 {
    static constexpr bool PERM = true; static constexpr int NSTORE = 8;
    const LAS float* biasT; bf16_t* act;
    __device__ __forceinline__ void operator()(const f32x4 (&acc)[2][2][4][2], const Unit& u, int wr, int wc, int fr, int fq, int par) const {
        const int cl = wc * 32 + 8 * fq, colg = u.pn * BM + cl; const LAS float* bp = biasT + par * 256 + cl;
        f32x4 bg[2], bu[2];
#pragma unroll
        for (int bj = 0; bj < 2; ++bj) { const f32x4 b0 = *(const LAS f32x4*)(bp + bj * HALF), b1 = *(const LAS f32x4*)(bp + bj * HALF + 4);
            bg[bj] = (f32x4){b0[0], b0[2], b1[0], b1[2]}; bu[bj] = (f32x4){b0[1], b0[3], b1[1], b1[3]} + 1.0f; }
        const bool odd = (fq & 1) != 0;
#pragma unroll
        for (int ai = 0; ai < 2; ++ai)
#pragma unroll
            for (int mp = 0; mp < 2; ++mp) {
                const int lr = ai * HALF + wr * 64 + (2 * mp + (odd ? 1 : 0)) * 16 + fr;
                bf16_t* rowp = act + (size_t)(u.pm * BM + lr) * DF + (colg >> 1) - (odd ? 4 : 0);
#pragma unroll
                for (int bj = 0; bj < 2; ++bj) { u32x2 w[2];
#pragma unroll
                    for (int h = 0; h < 2; ++h) { const int m = 2 * mp + h; f32x4 G = acc[ai][bj][m][0] + bg[bj], U = acc[ai][bj][m][1] + bu[bj], R;
#pragma unroll
                        for (int q = 0; q < 4; ++q) { G[q] = fminf(G[q], 7.0f); U[q] = __builtin_amdgcn_fmed3f(U[q], -6.0f, 8.0f); }
                        const f32x4 X = G * (-1.702f * 1.4426950408889634f);
#pragma unroll
                        for (int q = 0; q < 4; ++q) R[q] = __builtin_amdgcn_exp2f(X[q]);
                        R = R + 1.0f;
#pragma unroll
                        for (int q = 0; q < 4; ++q) R[q] = __builtin_amdgcn_rcpf(R[q]);
                        const f32x4 A = U * (G * R);
                        w[h].x = cvt_pk_bf16(A[0], A[1]); w[h].y = cvt_pk_bf16(A[2], A[3]); }
                    const auto rx = __builtin_amdgcn_permlane16_swap(w[0].x, w[1].x, false, false), ry = __builtin_amdgcn_permlane16_swap(w[0].y, w[1].y, false, false);
                    *(u32x4*)(rowp + bj * (HALF / 2)) = (u32x4){rx[0], ry[0], rx[1], ry[1]}; }
                asm volatile("" ::: "memory"); }
    }
};
template <> struct PermOf<EpiMoe1> { static __host__ __device__ __forceinline__ int f(int rho) { const int n = rho >> 4, i = rho & 15; return 8 * (i >> 2) + 2 * (i & 3) + n; } };
struct EpiMoe2 {
    static constexpr bool PERM = true; static constexpr int NSTORE = 16;
    const LAS float* biasT; bf16_t* yb; const LAS int* slotT;
    __device__ __forceinline__ void operator()(const f32x4 (&acc)[2][2][4][2], const Unit& u, int wr, int wc, int fr, int fq, int par) const {
        const int cl = wc * 32 + 8 * fq, col = u.pn * BM + cl; const LAS float* bp = biasT + par * 256 + cl;
        f32x4 bv[2][2];
#pragma unroll
        for (int bj = 0; bj < 2; ++bj)
#pragma unroll
            for (int n = 0; n < 2; ++n) bv[bj][n] = *(const LAS f32x4*)(bp + bj * HALF + 4 * n);
#pragma unroll
        for (int ai = 0; ai < 2; ++ai)
#pragma unroll
            for (int m = 0; m < 4; ++m) { const int lr = ai * HALF + wr * 64 + m * 16 + fr;
                { const int slot = slotT[par * 256 + lr]; bf16_t* rowp = yb + (size_t)slot * DM + col;
#pragma unroll
                for (int bj = 0; bj < 2; ++bj) { const f32x4 v0 = acc[ai][bj][m][0] + bv[bj][0], v1 = acc[ai][bj][m][1] + bv[bj][1];
                    u32x4 w; w.x = cvt_pk_bf16(v0[0], v0[1]); w.y = cvt_pk_bf16(v0[2], v0[3]); w.z = cvt_pk_bf16(v1[0], v1[1]); w.w = cvt_pk_bf16(v1[2], v1[3]);
                    *(u32x4*)(rowp + bj * HALF) = w; } }
                asm volatile("" ::: "memory"); }
    }
};
}

constexpr int XT_ST = 2064;
constexpr int O_XH = 0, O_XL = 16 * XT_ST, O_PT = 2 * 16 * XT_ST, PT_ST = 36;
__device__ __forceinline__ void ln1_router_phase(LAS unsigned char* ring, int G, int c, int wave, int lane, const bf16_t* __restrict__ xb_in, const bf16_t* __restrict__ mix, const float* __restrict__ lg, const float* __restrict__ lb,
                                                 const float* __restrict__ rw, const float* __restrict__ rb, bf16_t* __restrict__ x1b, LAS int* rt_e, LAS float* rt_g, LAS int* rt_p, LAS int* rt_c) {
    const int fr = lane & 15, fq = lane >> 4;
    bf16x8 bh[4][2], bl[4][2];
#pragma unroll
    for (int ks = 0; ks < 4; ++ks)
#pragma unroll
        for (int nt = 0; nt < 2; ++nt) { const float* wp = rw + (size_t)(128 * wave + 32 * ks + 8 * fq) * NE + 16 * nt + fr; unsigned h[4], l[4];
#pragma unroll
            for (int q = 0; q < 4; ++q) { const float w0 = wp[(2 * q) * NE], w1 = wp[(2 * q + 1) * NE]; h[q] = pg8::cvt_pk_bf16(w0, w1);
                l[q] = pg8::cvt_pk_bf16(w0 - __uint_as_float(h[q] << 16), w1 - __uint_as_float(h[q] & 0xffff0000u)); }
            bh[ks][nt] = __builtin_bit_cast(bf16x8, (u32x4){h[0], h[1], h[2], h[3]}); bl[ks][nt] = __builtin_bit_cast(bf16x8, (u32x4){l[0], l[1], l[2], l[3]}); }
    const int nrow = 2 * G * NWAVES, t0 = 2 * (c * NWAVES + wave);
    const int nsw = (T - 2 * c * NWAVES + nrow - 1) / nrow;
    const float rbv = rb[lane & 31];
    u32x2 ra[2][4], rm[2][4];
#pragma unroll
    for (int r = 0; r < 2; ++r)
#pragma unroll
        for (int j = 0; j < 4; ++j) { const size_t o = (size_t)(t0 + r) * DM + 4 * lane + 256 * j; ra[r][j] = *(const u32x2*)(xb_in + o); rm[r][j] = *(const u32x2*)(mix + o); }
    for (int sweep = 0; sweep < nsw; ++sweep) {
        const int t = t0 + sweep * nrow;
#pragma unroll
        for (int r = 0; r < 2; ++r) {
            f32x4 y[4]; float s = 0.f; const size_t ro = (size_t)(t + r) * DM;
#pragma unroll
            for (int j = 0; j < 4; ++j) { const u32x2 aw = ra[r][j], mw = rm[r][j];
                y[j] = (f32x4){bf2f(aw.x & 0xffffu), bf2f(aw.x >> 16), bf2f(aw.y & 0xffffu), bf2f(aw.y >> 16)} * DN_ALPHA + (f32x4){bf2f(mw.x & 0xffffu), bf2f(mw.x >> 16), bf2f(mw.y & 0xffffu), bf2f(mw.y >> 16)};
                s += (y[j].x + y[j].y) + (y[j].z + y[j].w); }
            const float mean = wave_sum(s) * (1.0f / DM); float s2 = 0.f;
#pragma unroll
            for (int j = 0; j < 4; ++j) { y[j] = y[j] - mean; s2 += (y[j].x * y[j].x + y[j].y * y[j].y) + (y[j].z * y[j].z + y[j].w * y[j].w); }
            const float rstd = 1.0f / sqrtf(wave_sum(s2) * (1.0f / DM) + LN_EPS);
#pragma unroll
            for (int j = 0; j < 4; ++j) { const int cc = 4 * lane + 256 * j; const f32x4 gv = *(const f32x4*)(lg + cc), bv = *(const f32x4*)(lb + cc);
                const f32x4 o = y[j] * rstd * gv + bv;
                u32x2 hb; hb.x = pg8::cvt_pk_bf16(o.x, o.y); hb.y = pg8::cvt_pk_bf16(o.z, o.w); *(u32x2*)(x1b + ro + cc) = hb;
                u32x2 lw; lw.x = pg8::cvt_pk_bf16(o.x - __uint_as_float(hb.x << 16), o.y - __uint_as_float(hb.x & 0xffff0000u)); lw.y = pg8::cvt_pk_bf16(o.z - __uint_as_float(hb.y << 16), o.w - __uint_as_float(hb.y & 0xffff0000u));
                *(LAS u32x2*)(ring + O_XH + (2 * wave + r) * XT_ST + cc * 2) = hb; *(LAS u32x2*)(ring + O_XL + (2 * wave + r) * XT_ST + cc * 2) = lw; }
        }
        asm volatile("s_waitcnt lgkmcnt(0)" ::: "memory"); __builtin_amdgcn_s_barrier(); asm volatile("" ::: "memory");
        if (sweep + 1 < nsw) {
#pragma unroll
            for (int r = 0; r < 2; ++r)
#pragma unroll
                for (int j = 0; j < 4; ++j) { const size_t o = (size_t)(t + nrow + r) * DM + 4 * lane + 256 * j; ra[r][j] = *(const u32x2*)(xb_in + o); rm[r][j] = *(const u32x2*)(mix + o); }
        }
        f32x4 cacc[2] = {(f32x4){0.f, 0.f, 0.f, 0.f}, (f32x4){0.f, 0.f, 0.f, 0.f}};
        { LAS const unsigned char* ap = ring + fr * XT_ST + (128 * wave + 8 * fq) * 2;
#pragma unroll
          for (int ks = 0; ks < 4; ++ks) { const bf16x8 ah = *(LAS const bf16x8*)(ap + O_XH + 64 * ks), al = *(LAS const bf16x8*)(ap + O_XL + 64 * ks);
#pragma unroll
              for (int nt = 0; nt < 2; ++nt) { cacc[nt] = __builtin_amdgcn_mfma_f32_16x16x32_bf16(ah, bh[ks][nt], cacc[nt], 0, 0, 0); cacc[nt] = __builtin_amdgcn_mfma_f32_16x16x32_bf16(al, bh[ks][nt], cacc[nt], 0, 0, 0);
                  cacc[nt] = __builtin_amdgcn_mfma_f32_16x16x32_bf16(ah, bl[ks][nt], cacc[nt], 0, 0, 0); } } }
        { LAS float* pt = (LAS float*)(ring + O_PT) + (wave * 16 + 4 * fq) * PT_ST + fr;
#pragma unroll
          for (int nt = 0; nt < 2; ++nt)
#pragma unroll
              for (int i = 0; i < 4; ++i) pt[i * PT_ST + 16 * nt] = cacc[nt][i]; }
        asm volatile("s_waitcnt lgkmcnt(0)" ::: "memory"); __builtin_amdgcn_s_barrier(); asm volatile("" ::: "memory");
        const int e = lane & 31;
        float vcur;
        { LAS const float* pt = (LAS const float*)(ring + O_PT) + (2 * wave + (lane >> 5)) * PT_ST + e; float v = 0.f;
#pragma unroll
          for (int w = 0; w < 8; ++w) v += pt[w * 16 * PT_ST];
          vcur = v + rbv; }
        float topv[4]; int topi[4];
#pragma unroll
        for (int kk = 0; kk < 4; ++kk) {
            float m = vcur;
            m = fmaxf(m, dpp_f<0xB1>(m)); m = fmaxf(m, dpp_f<0x4E>(m)); m = fmaxf(m, dpp_f<0x141>(m)); m = fmaxf(m, dpp_f<0x140>(m));
            const float h0 = fmaxf(lane_f(m, 0), lane_f(m, 16)), h1 = fmaxf(lane_f(m, 32), lane_f(m, 48));
            const float mx = lane < 32 ? h0 : h1;
            const unsigned long long bal = __ballot(vcur == mx);
            const int i0 = __builtin_ctz((unsigned)bal), i1 = __builtin_ctz((unsigned)(bal >> 32));
            const int bi = lane < 32 ? i0 : i1;
            topv[kk] = mx; topi[kk] = bi; if (e == bi) vcur = -INFINITY;
        }
        const float e1 = __expf(topv[1] - topv[0]), e2 = __expf(topv[2] - topv[0]), e3 = __expf(topv[3] - topv[0]);
        const float inv = 1.0f / (1.0f + e1 + e2 + e3);
        if (e < 4) {
            const int ee = e == 0 ? topi[0] : e == 1 ? topi[1] : e == 2 ? topi[2] : topi[3];
            const float gg = (e == 0 ? 1.0f : e == 1 ? e1 : e == 2 ? e2 : e3) * inv;
            const int sl = (16 * sweep + 2 * wave + (lane >> 5)) * 4 + e;
            rt_e[sl] = ee; rt_g[sl] = gg; rt_p[sl] = (int)__hip_atomic_fetch_add((LAS unsigned*)(rt_c + ee), 1u, __ATOMIC_RELAXED, __HIP_MEMORY_SCOPE_WORKGROUP);
        }
    }
}
__device__ __forceinline__ void ln2_row(int t, int lane, const bf16_t* __restrict__ x1b, const bf16_t* __restrict__ yb, const float* __restrict__ gates, const float* __restrict__ lg, const float* __restrict__ lb,
                                        bf16_t* __restrict__ x2b) {
    const float g0 = gates[t * 4], g1 = gates[t * 4 + 1], g2 = gates[t * 4 + 2], g3 = gates[t * 4 + 3];
    f32x4 y[4]; float s = 0.f;
#pragma unroll
    for (int j = 0; j < 4; ++j) { const int c = 4 * lane + 256 * j; const u32x2 aw = __builtin_nontemporal_load((const u32x2*)(x1b + (size_t)t * DM + c)); const f32x4 a = (f32x4){bf2f(aw.x & 0xffffu), bf2f(aw.x >> 16), bf2f(aw.y & 0xffffu), bf2f(aw.y >> 16)};
        f32x4 f = (f32x4){0.f, 0.f, 0.f, 0.f};
#pragma unroll
        for (int kk = 0; kk < 4; ++kk) { const u32x2 w = __builtin_nontemporal_load((const u32x2*)(yb + (size_t)(t * 4 + kk) * DM + c)); const float gk = kk == 0 ? g0 : kk == 1 ? g1 : kk == 2 ? g2 : g3;
            f.x += gk * bf2f(w.x & 0xffffu); f.y += gk * bf2f(w.x >> 16); f.z += gk * bf2f(w.y & 0xffffu); f.w += gk * bf2f(w.y >> 16); }
        y[j] = a * DN_ALPHA + f; s += (y[j].x + y[j].y) + (y[j].z + y[j].w); }
    const float mean = wave_sum(s) * (1.0f / DM); float s2 = 0.f;
#pragma unroll
    for (int j = 0; j < 4; ++j) { y[j] = y[j] - mean; s2 += (y[j].x * y[j].x + y[j].y * y[j].y) + (y[j].z * y[j].z + y[j].w * y[j].w); }
    const float rstd = 1.0f / sqrtf(wave_sum(s2) * (1.0f / DM) + LN_EPS);
#pragma unroll
    for (int j = 0; j < 4; ++j) { const int c = 4 * lane + 256 * j; const f32x4 gv = *(const f32x4*)(lg + c), bv = *(const f32x4*)(lb + c);
        const f32x4 o = y[j] * rstd * gv + bv;
        u32x2 pb; pb.x = pk2(o.x, o.y); pb.y = pk2(o.z, o.w); *(u32x2*)(x2b + (size_t)t * DM + c) = pb; }
}
__device__ __forceinline__ void ln2_row2(int ta, int tb, int lane, const bf16_t* __restrict__ x1b, const bf16_t* __restrict__ yb, const float* __restrict__ gates, const float* __restrict__ lg, const float* __restrict__ lb,
                                         bf16_t* __restrict__ x2b) {
    u32x2 xa[2][4], ya[2][4][4]; float gk[2][4];
#pragma unroll
    for (int r = 0; r < 2; ++r) { const int t = r ? tb : ta;
#pragma unroll
        for (int kk = 0; kk < 4; ++kk) gk[r][kk] = gates[t * 4 + kk];
#pragma unroll
        for (int j = 0; j < 4; ++j) { const int c = 4 * lane + 256 * j; xa[r][j] = __builtin_nontemporal_load((const u32x2*)(x1b + (size_t)t * DM + c));
#pragma unroll
            for (int kk = 0; kk < 4; ++kk) ya[r][j][kk] = __builtin_nontemporal_load((const u32x2*)(yb + (size_t)(t * 4 + kk) * DM + c)); } }
    __builtin_amdgcn_sched_barrier(0);
#pragma unroll
    for (int r = 0; r < 2; ++r) { const int t = r ? tb : ta;
        f32x4 y[4]; float s = 0.f;
#pragma unroll
        for (int j = 0; j < 4; ++j) { const u32x2 aw = xa[r][j]; const f32x4 a = (f32x4){bf2f(aw.x & 0xffffu), bf2f(aw.x >> 16), bf2f(aw.y & 0xffffu), bf2f(aw.y >> 16)};
            f32x4 f = (f32x4){0.f, 0.f, 0.f, 0.f};
#pragma unroll
            for (int kk = 0; kk < 4; ++kk) { const u32x2 w = ya[r][j][kk]; const float g = gk[r][kk];
                f.x += g * bf2f(w.x & 0xffffu); f.y += g * bf2f(w.x >> 16); f.z += g * bf2f(w.y & 0xffffu); f.w += g * bf2f(w.y >> 16); }
            y[j] = a * DN_ALPHA + f; s += (y[j].x + y[j].y) + (y[j].z + y[j].w); }
        const float mean = wave_sum(s) * (1.0f / DM); float s2 = 0.f;
#pragma unroll
        for (int j = 0; j < 4; ++j) { y[j] = y[j] - mean; s2 += (y[j].x * y[j].x + y[j].y * y[j].y) + (y[j].z * y[j].z + y[j].w * y[j].w); }
        const float rstd = 1.0f / sqrtf(wave_sum(s2) * (1.0f / DM) + LN_EPS);
#pragma unroll
        for (int j = 0; j < 4; ++j) { const int c = 4 * lane + 256 * j; const f32x4 gv = *(const f32x4*)(lg + c), bv = *(const f32x4*)(lb + c);
            const f32x4 o = y[j] * rstd * gv + bv;
            u32x2 pb; pb.x = pk2(o.x, o.y); pb.y = pk2(o.z, o.w); *(u32x2*)(x2b + (size_t)t * DM + c) = pb; }
    }
}
typedef _Float16 f16x8 __attribute__((ext_vector_type(8)));
typedef _Float16 f16x2 __attribute__((ext_vector_type(2)));
typedef float f32x16 __attribute__((ext_vector_type(16)));
typedef short s16x4 __attribute__((ext_vector_type(4)));
__device__ __forceinline__ s16x4 lds_tr16(LAS const unsigned char* p) { return __builtin_bit_cast(s16x4, __builtin_amdgcn_ds_read_tr16_b64_v4i16((LAS s16x4*)p)); }
__device__ __forceinline__ bf16x8 cat4(s16x4 a, s16x4 b) { return __builtin_shufflevector(a, b, 0, 1, 2, 3, 4, 5, 6, 7); }
__device__ __forceinline__ unsigned cvtpk_c(float lo, float hi) { return pg8::cvt_pk_bf16(lo, hi); }
__device__ __forceinline__ float fexp2(float x) { return __builtin_amdgcn_exp2f(x); }
__device__ __forceinline__ float flog2(float x) { return __builtin_amdgcn_logf(x); }

namespace sb {
constexpr int KST = 144, SUB_B = 32 * KST, SLOT_B = 2 * SUB_B, NSLOT_R = 10;
__device__ __forceinline__ void attn_phase(LAS unsigned char* lds, const bf16_t* __restrict__ Q, const bf16_t* __restrict__ K, const bf16_t* __restrict__ V, bf16_t* __restrict__ O, int G, int c) {
    int tid = threadIdx.x; asm volatile("" : "+v"(tid));
    const int wid = __builtin_amdgcn_readfirstlane(tid >> 6), lane = tid & 63, n = lane & 31, hi = lane >> 5;
    f16x8 U0, U1, ONE;
#pragma unroll
    for (int j = 0; j < 8; ++j) { const int jp = 8 * (j >> 2) + 4 * hi + (j & 3); U0[j] = (jp > n) ? (_Float16)1.0f : (_Float16)0.0f; U1[j] = (16 + jp > n) ? (_Float16)1.0f : (_Float16)0.0f; ONE[j] = (_Float16)1.0f; }
    const int half = tid >> 8, srow = (tid & 255) >> 3, sch = tid & 7;
    const int trq = (lane & 15) >> 2, trp = lane & 3, blk = (lane >> 4) & 1;
    LAS unsigned* flg = (LAS unsigned*)(lds + NSLOT_R * SLOT_B);
    for (int it = 0;; ++it) {
        const int L = it * G + c; if (L >= NB * SH * 8) break;
        const int bh = L >> 3, qp = L & 7, qb = ((L >> 8) & 1) ? 7 - qp : qp, b = bh >> 4, h = bh & 15;
        const size_t rowbase = (size_t)b * SEQ;
        const int q0 = qb * 256 + wid * 32;
        bf16x8 qf[4];
        { const bf16_t* qrow = Q + (rowbase + q0 + n) * DM + h * SD + 8 * hi;
#pragma unroll
          for (int ks = 0; ks < 4; ++ks) qf[ks] = *(const bf16x8*)(qrow + 16 * ks); }
        f32x16 o0, o1, carry;
#pragma unroll
        for (int r = 0; r < 16; ++r) { o0[r] = 0.f; o1[r] = 0.f; carry[r] = 0.f; }
        const bf16_t* sg = (half ? V : K) + (rowbase + srow) * DM + h * SD + sch * 8;
        const int soff = half * SUB_B + srow * KST + sch * 16;
        { u32x4 r[9];
#pragma unroll
          for (int x = 0; x < 9; ++x) { const int g = 8 * qb + 7 - x; if (g >= 0) r[x] = *(const u32x4*)(sg + (size_t)g * 32 * DM); }
#pragma unroll
          for (int x = 0; x < 9; ++x) { const int g = 8 * qb + 7 - x; if (g >= 0) *(LAS u32x4*)(lds + (g % NSLOT_R) * SLOT_B + soff) = r[x]; } }
        asm volatile("s_waitcnt lgkmcnt(0)" ::: "memory"); __builtin_amdgcn_s_barrier(); asm volatile("" ::: "memory");
        int par = 0, j = 0;
        for (;; ++j) {
            const int gpre = 8 * qb - j - 2;
            u32x4 pr; if (gpre >= 0) pr = *(const u32x4*)(sg + (size_t)gpre * 32 * DM);
            const int g = 8 * qb + wid - j;
            int fin;
            {
                const bool diag = (j == 0);
                LAS const unsigned char* kb = lds + (g % NSLOT_R) * SLOT_B; LAS const unsigned char* vb = kb + SUB_B;
                f32x16 z;
#pragma unroll
                for (int r = 0; r < 16; ++r) z[r] = 0.f;
                { LAS const unsigned char* kp = kb + n * KST + hi * 16;
#pragma unroll
                  for (int ks = 0; ks < 4; ++ks) { const bf16x8 kf = *(LAS const bf16x8*)(kp + ks * 32); z = __builtin_amdgcn_mfma_f32_32x32x16_bf16(kf, qf[ks], z, 0, 0, 0); } }
                f16x8 lf0, lf1;
                { f32x16 t, mx;
#pragma unroll
                  for (int r = 0; r < 16; ++r) t[r] = fexp2(-fabsf(z[r]));
                  t = t + 1.0f;
#pragma unroll
                  for (int r = 0; r < 16; ++r) { t[r] = flog2(t[r]); mx[r] = __builtin_amdgcn_fmed3f(z[r], 0.f, 3.0e38f); }
                  f32x16 l = (-mx) - t;
                  z = z + l;
                  if (diag) {
#pragma unroll
                      for (int r = 0; r < 16; ++r) { const bool valid = ((r & 3) + 8 * (r >> 2) + 4 * hi) < n; l[r] = valid ? l[r] : 0.f; z[r] = valid ? z[r] : -INFINITY; } }
                  unsigned hw[8];
#pragma unroll
                  for (int r2 = 0; r2 < 8; ++r2) { const pg8::f32x2_t pr2 = {l[2 * r2], l[2 * r2 + 1]}; hw[r2] = __builtin_bit_cast(unsigned, __builtin_convertvector(pr2, f16x2)); }
                  lf0 = __builtin_bit_cast(f16x8, (u32x4){hw[0], hw[1], hw[2], hw[3]}); lf1 = __builtin_bit_cast(f16x8, (u32x4){hw[4], hw[5], hw[6], hw[7]}); }
                f32x16 y = carry;
                y = __builtin_amdgcn_mfma_f32_32x32x16_f16(U0, lf0, y, 0, 0, 0); y = __builtin_amdgcn_mfma_f32_32x32x16_f16(U1, lf1, y, 0, 0, 0);
                carry = __builtin_amdgcn_mfma_f32_32x32x16_f16(ONE, lf0, carry, 0, 0, 0); carry = __builtin_amdgcn_mfma_f32_32x32x16_f16(ONE, lf1, carry, 0, 0, 0);
                bf16x8 pf0, pf1;
                { unsigned w[8]; const f32x16 zy = z + y;
#pragma unroll
                  for (int r2 = 0; r2 < 8; ++r2) w[r2] = cvtpk_c(fexp2(zy[2 * r2]), fexp2(zy[2 * r2 + 1]));
                  pf0 = __builtin_bit_cast(bf16x8, (u32x4){w[0], w[1], w[2], w[3]}); pf1 = __builtin_bit_cast(bf16x8, (u32x4){w[4], w[5], w[6], w[7]}); }
                LAS const unsigned char* vp = vb + (4 * hi + trq) * KST + (16 * blk + 4 * trp) * 2;
#pragma unroll
                for (int s = 0; s < 2; ++s) {
                    const bf16x8 va = cat4(lds_tr16(vp + (16 * s) * KST), lds_tr16(vp + (16 * s + 8) * KST));
                    const bf16x8 vc = cat4(lds_tr16(vp + (16 * s) * KST + 64), lds_tr16(vp + (16 * s + 8) * KST + 64));
                    o0 = __builtin_amdgcn_mfma_f32_32x32x16_bf16(va, s ? pf1 : pf0, o0, 0, 0, 0);
                    o1 = __builtin_amdgcn_mfma_f32_32x32x16_bf16(vc, s ? pf1 : pf0, o1, 0, 0, 0);
                }
                fin = (__all(carry[0] < -160.0f) || g == 0) ? 1 : 0;
            }
            if (lane == 0) flg[par * 8 + wid] = (unsigned)fin;
            if (gpre >= 0) *(LAS u32x4*)(lds + (gpre % NSLOT_R) * SLOT_B + soff) = pr;
            asm volatile("s_waitcnt lgkmcnt(0)" ::: "memory"); __builtin_amdgcn_s_barrier(); asm volatile("" ::: "memory");
            par ^= 1;
            if (fin) { ++j; break; }
        }
        bf16_t* orow = O + (rowbase + q0 + n) * DM + h * SD + 4 * hi;
#pragma unroll
        for (int g4 = 0; g4 < 4; ++g4) {
            u32x2 w0, w1; w0.x = pg8::cvt_pk_bf16(o0[4 * g4], o0[4 * g4 + 1]); w0.y = pg8::cvt_pk_bf16(o0[4 * g4 + 2], o0[4 * g4 + 3]);
            w1.x = pg8::cvt_pk_bf16(o1[4 * g4], o1[4 * g4 + 1]); w1.y = pg8::cvt_pk_bf16(o1[4 * g4 + 2], o1[4 * g4 + 3]);
            *(u32x2*)(orow + 8 * g4) = w0; *(u32x2*)(orow + 32 + 8 * g4) = w1; }
        for (;; ++j) {
            { const unsigned f = lane < 8 ? flg[(par ^ 1) * 8 + lane] : 1u; if (__all(f != 0u)) break; }
            const int gpre = 8 * qb - j - 2;
            u32x4 pr; if (gpre >= 0) pr = *(const u32x4*)(sg + (size_t)gpre * 32 * DM);
            if (lane == 0) flg[par * 8 + wid] = 1u;
            if (gpre >= 0) *(LAS u32x4*)(lds + (gpre % NSLOT_R) * SLOT_B + soff) = pr;
            asm volatile("s_waitcnt lgkmcnt(0)" ::: "memory"); __builtin_amdgcn_s_barrier(); asm volatile("" ::: "memory");
            par ^= 1;
        }
        asm volatile("s_waitcnt lgkmcnt(0)" ::: "memory"); __builtin_amdgcn_s_barrier(); asm volatile("" ::: "memory");
    }
}
}

namespace ret {
constexpr int QST = 528, VST = 144;
constexpr int O_Q = 0, O_K = 64 * QST, O_ST = 2 * 64 * QST, O_V = 3 * 64 * QST, O_VD = O_V + 64 * VST, O_P = O_VD + 64 * VST, LDS_END = O_P + 64 * VST;
static_assert(LDS_END <= 131072, "retention LDS");
__device__ __forceinline__ void scan_phase(LAS unsigned char* lds, const bf16_t* __restrict__ Q, const bf16_t* __restrict__ K, const bf16_t* __restrict__ V, bf16_t* __restrict__ RO, int G, int c, const float* __restrict__ cw, bf16_t* __restrict__ cwt) {
    int tid = threadIdx.x; asm volatile("" : "+v"(tid));
    const int wid = __builtin_amdgcn_readfirstlane(tid >> 6), lane = tid & 63, lr = lane & 15, g = lane >> 4;
    const int trq = (lane & 15) >> 2, trp = lane & 3;
    const int tqt = wid >> 1, e2 = 2 * (wid & 1);
    for (int it = 0;; ++it) {
        const int L = it * G + c; if (L >= NB * RH * 8) break;
        const int bh = (L & 7) * 4 + (L >> 6), es = (L >> 3) & 7, b = bh >> 2, h = bh & 3;
        const size_t rowbase = (size_t)b * SEQ;
        const float lg2 = flog2(1.0f - fexp2(-5.0f - (float)h));
        const float cdec = fexp2(lg2 * 64.0f);
        f32x4 S[2][4];
#pragma unroll
        for (int a = 0; a < 2; ++a)
#pragma unroll
            for (int e = 0; e < 4; ++e) S[a][e] = (f32x4){0.f, 0.f, 0.f, 0.f};
        const bf16_t* qg = Q + (rowbase + (tid >> 5)) * DM + h * RDK + (tid & 31) * 8; const bf16_t* kg = K + (rowbase + (tid >> 5)) * DM + h * RDK + (tid & 31) * 8;
        const bf16_t* vg = V + (rowbase + (tid >> 3)) * RHV + h * RDV + es * 64 + (tid & 7) * 8;
        const int sq = (tid >> 5) * QST + (tid & 31) * 16, sv = (tid >> 3) * VST + (tid & 7) * 16;
        const float kdv = fexp2(lg2 * (float)(63 - (tid >> 3)));
        u32x4 rq[4], rk[4], rv;
#pragma unroll
        for (int i = 0; i < 4; ++i) { rq[i] = *(const u32x4*)(qg + (size_t)(16 * i) * DM); rk[i] = *(const u32x4*)(kg + (size_t)(16 * i) * DM); }
        rv = *(const u32x4*)vg;
        __builtin_amdgcn_s_barrier();
        for (int ci = 0; ci < SEQ / 64; ++ci) {
#pragma unroll
            for (int i = 0; i < 4; ++i) { *(LAS u32x4*)(lds + O_Q + sq + 16 * i * QST) = rq[i]; *(LAS u32x4*)(lds + O_K + sq + 16 * i * QST) = rk[i]; }
            { *(LAS u32x4*)(lds + O_V + sv) = rv;
              u32x4 d; d.x = pk2(bf2f(rv.x & 0xffffu) * kdv, bf2f(rv.x >> 16) * kdv); d.y = pk2(bf2f(rv.y & 0xffffu) * kdv, bf2f(rv.y >> 16) * kdv);
              d.z = pk2(bf2f(rv.z & 0xffffu) * kdv, bf2f(rv.z >> 16) * kdv); d.w = pk2(bf2f(rv.w & 0xffffu) * kdv, bf2f(rv.w >> 16) * kdv);
              *(LAS u32x4*)(lds + O_VD + sv) = d; }
#pragma unroll
            for (int a = 0; a < 2; ++a)
#pragma unroll
                for (int e = 0; e < 4; ++e) { u32x2 w; w.x = pg8::cvt_pk_bf16(S[a][e][0], S[a][e][1]); w.y = pg8::cvt_pk_bf16(S[a][e][2], S[a][e][3]);
                    *(LAS u32x2*)(lds + O_ST + (16 * e + lr) * QST + (32 * wid + 16 * a + 4 * g) * 2) = w; }
            asm volatile("s_waitcnt lgkmcnt(0)" ::: "memory"); __builtin_amdgcn_s_barrier(); asm volatile("" ::: "memory");
            if (ci + 1 < SEQ / 64) {
#pragma unroll
                for (int i = 0; i < 4; ++i) { rq[i] = *(const u32x4*)(qg + (size_t)((ci + 1) * 64 + 16 * i) * DM); rk[i] = *(const u32x4*)(kg + (size_t)((ci + 1) * 64 + 16 * i) * DM); }
                rv = *(const u32x4*)(vg + (size_t)(ci + 1) * 64 * RHV);
            }
            float cv[16]; size_t cdst = 0;
            if (cw) { const int item = (L * 8 + wid) * 8 + (ci >> 2), sub = ci & 3, m = item >> 9, kb = (item >> 5) & 15, nb = item & 31;
                const float* su = cw + ((size_t)m * DM + kb * 64) * (2 * DF) + nb * 64 + sub * 16;
                const int lo = (lane >> 4) * 16 * (2 * DF) + (lane & 15);
#pragma unroll
                for (int j = 0; j < 16; ++j) { const float* sj = su + (size_t)j * (2 * DF); asm volatile("" : "+s"(sj)); cv[j] = ((const GAS float*)sj)[lo]; }
                cdst = ((size_t)m * 2 * DF + nb * 64 + sub * 16 + (lane & 15)) * DM + kb * 64 + (lane >> 4) * 16; }
            f32x4 pacc[2], oacc[2];
#pragma unroll
            for (int x = 0; x < 2; ++x) { pacc[x] = (f32x4){0.f, 0.f, 0.f, 0.f}; oacc[x] = (f32x4){0.f, 0.f, 0.f, 0.f}; }
            { LAS const unsigned char* qp = lds + O_Q + (16 * tqt + lr) * QST + 16 * g;
              LAS const unsigned char* kp = lds + O_K + (16 * e2 + lr) * QST + 16 * g;
              LAS const unsigned char* sp = lds + O_ST + (16 * e2 + lr) * QST + 16 * g;
#pragma unroll
              for (int ks = 0; ks < 8; ++ks) {
                  const bf16x8 qa = *(LAS const bf16x8*)(qp + 64 * ks);
                  const bf16x8 k0 = *(LAS const bf16x8*)(kp + 64 * ks), k1 = *(LAS const bf16x8*)(kp + 16 * QST + 64 * ks);
                  const bf16x8 s0 = *(LAS const bf16x8*)(sp + 64 * ks), s1 = *(LAS const bf16x8*)(sp + 16 * QST + 64 * ks);
                  pacc[0] = __builtin_amdgcn_mfma_f32_16x16x32_bf16(k0, qa, pacc[0], 0, 0, 0); pacc[1] = __builtin_amdgcn_mfma_f32_16x16x32_bf16(k1, qa, pacc[1], 0, 0, 0);
                  oacc[0] = __builtin_amdgcn_mfma_f32_16x16x32_bf16(s0, qa, oacc[0], 0, 0, 0); oacc[1] = __builtin_amdgcn_mfma_f32_16x16x32_bf16(s1, qa, oacc[1], 0, 0, 0);
              } }
#pragma unroll
            for (int x = 0; x < 2; ++x) { float pv[4];
#pragma unroll
                for (int i = 0; i < 4; ++i) { const int dist = (16 * tqt + lr) - (16 * (e2 + x) + 4 * g + i); pv[i] = pacc[x][i] * fexp2(lg2 * fabsf((float)dist)); }
                u32x2 w; w.x = pg8::cvt_pk_bf16(pv[0], pv[1]); w.y = pg8::cvt_pk_bf16(pv[2], pv[3]);
                *(LAS u32x2*)(lds + O_P + (16 * tqt + lr) * VST + (16 * (e2 + x) + 4 * g) * 2) = w; }
            { const float qd = fexp2(lg2 * (float)(16 * tqt + lr + 1)); oacc[0] = oacc[0] * qd; oacc[1] = oacc[1] * qd; }
            asm volatile("s_waitcnt lgkmcnt(0)" ::: "memory"); __builtin_amdgcn_s_barrier(); asm volatile("" ::: "memory");
            { LAS const unsigned char* pp = lds + O_P + (16 * tqt + lr) * VST + 16 * g;
              LAS const unsigned char* vp = lds + O_V + (8 * g + trq) * VST + (16 * e2 + 4 * trp) * 2;
#pragma unroll
              for (int ks = 0; ks < 2; ++ks) {
                  const bf16x8 pa = *(LAS const bf16x8*)(pp + 64 * ks);
                  const bf16x8 v0 = cat4(lds_tr16(vp + (32 * ks) * VST), lds_tr16(vp + (32 * ks + 4) * VST));
                  const bf16x8 v1 = cat4(lds_tr16(vp + (32 * ks) * VST + 32), lds_tr16(vp + (32 * ks + 4) * VST + 32));
                  oacc[0] = __builtin_amdgcn_mfma_f32_16x16x32_bf16(v0, pa, oacc[0], 0, 0, 0); oacc[1] = __builtin_amdgcn_mfma_f32_16x16x32_bf16(v1, pa, oacc[1], 0, 0, 0);
              } }
            { bf16_t* op = RO + (rowbase + ci * 64 + 16 * tqt + lr) * RHV + h * RDV + es * 64 + 16 * e2 + 4 * g;
#pragma unroll
              for (int x = 0; x < 2; ++x) { u32x2 w; w.x = pk2(oacc[x][0], oacc[x][1]); w.y = pk2(oacc[x][2], oacc[x][3]); *(u32x2*)(op + 16 * x) = w; } }
#pragma unroll
            for (int a = 0; a < 2; ++a)
#pragma unroll
                for (int e = 0; e < 4; ++e) S[a][e] = S[a][e] * cdec;
            { LAS const unsigned char* ktp = lds + O_K + (8 * g + trq) * QST + (32 * wid + 4 * trp) * 2;
              LAS const unsigned char* vtp = lds + O_VD + (8 * g + trq) * VST + (4 * trp) * 2;
#pragma unroll
              for (int ks = 0; ks < 2; ++ks) {
                  bf16x8 ka[2], vb[4];
#pragma unroll
                  for (int a = 0; a < 2; ++a) ka[a] = cat4(lds_tr16(ktp + (32 * ks) * QST + 32 * a), lds_tr16(ktp + (32 * ks + 4) * QST + 32 * a));
#pragma unroll
                  for (int e = 0; e < 4; ++e) vb[e] = cat4(lds_tr16(vtp + (32 * ks) * VST + 32 * e), lds_tr16(vtp + (32 * ks + 4) * VST + 32 * e));
#pragma unroll
                  for (int a = 0; a < 2; ++a)
#pragma unroll
                      for (int e = 0; e < 4; ++e) S[a][e] = __builtin_amdgcn_mfma_f32_16x16x32_bf16(ka[a], vb[e], S[a][e], 0, 0, 0);
              } }
            if (cw) { u32x4 w0, w1; w0.x = pk2(cv[0], cv[1]); w0.y = pk2(cv[2], cv[3]); w0.z = pk2(cv[4], cv[5]); w0.w = pk2(cv[6], cv[7]);
                w1.x = pk2(cv[8], cv[9]); w1.y = pk2(cv[10], cv[11]); w1.z = pk2(cv[12], cv[13]); w1.w = pk2(cv[14], cv[15]);
                *(u32x4*)(cwt + cdst) = w0; *(u32x4*)(cwt + cdst + 8) = w1; }
            asm volatile("s_waitcnt lgkmcnt(0)" ::: "memory"); __builtin_amdgcn_s_barrier(); asm volatile("" ::: "memory");
        }
    }
}
__device__ __forceinline__ void gate_row(int w, int lane, const bf16_t* __restrict__ ro, const bf16_t* __restrict__ g, bf16_t* __restrict__ gn) {
    const u32x4 rw = __builtin_nontemporal_load((const u32x4*)(ro + (size_t)w * RDV + 8 * lane)), gw = __builtin_nontemporal_load((const u32x4*)(g + (size_t)w * RDV + 8 * lane));
    float xv[8] = {bf2f(rw.x & 0xffffu), bf2f(rw.x >> 16), bf2f(rw.y & 0xffffu), bf2f(rw.y >> 16), bf2f(rw.z & 0xffffu), bf2f(rw.z >> 16), bf2f(rw.w & 0xffffu), bf2f(rw.w >> 16)};
    float gv[8] = {bf2f(gw.x & 0xffffu), bf2f(gw.x >> 16), bf2f(gw.y & 0xffffu), bf2f(gw.y >> 16), bf2f(gw.z & 0xffffu), bf2f(gw.z >> 16), bf2f(gw.w & 0xffffu), bf2f(gw.w >> 16)};
    float s = 0.f;
#pragma unroll
    for (int j = 0; j < 8; ++j) s += xv[j];
    const float mean = wave_sum(s) * (1.0f / RDV); float s2 = 0.f;
#pragma unroll
    for (int j = 0; j < 8; ++j) { xv[j] -= mean; s2 += xv[j] * xv[j]; }
    const float rstd = 1.0f / sqrtf(wave_sum(s2) * (1.0f / RDV) + GN_EPS);
    unsigned wv[4];
#pragma unroll
    for (int j = 0; j < 4; ++j) { const float g0 = gv[2 * j], g1 = gv[2 * j + 1];
        wv[j] = pg8::cvt_pk_bf16(g0 * __builtin_amdgcn_rcpf(1.0f + __expf(-g0)) * (xv[2 * j] * rstd), g1 * __builtin_amdgcn_rcpf(1.0f + __expf(-g1)) * (xv[2 * j + 1] * rstd)); }
    *(u32x4*)(gn + (size_t)w * RDV + 8 * lane) = (u32x4){wv[0], wv[1], wv[2], wv[3]};
}
}
struct Args { const float* in[19]; float* out; unsigned char* ws; int ph_lo, ph_hi, bar_region, pad; };
#define CAS __attribute__((address_space(4)))
#define PHASE_ARGS() const CAS Args* ka = (const CAS Args*)__builtin_amdgcn_kernarg_segment_ptr(); asm volatile("" : "+s"(ka) :: "memory"); unsigned char* const ws = ka->ws; (void)ws; int ptid = threadIdx.x; asm volatile("" : "+v"(ptid)); const int lane = ptid & 63, wave = __builtin_amdgcn_readfirstlane(ptid >> 6); (void)lane; (void)wave
#define WSP(type, off) ((type*)(ws + (off)))
#ifndef PH_MASK
#define PH_MASK 0xffff
#endif
#define ON(b) ((PH_MASK >> (b)) & 1)
#ifndef REP_MASK
#define REP_MASK 0
#endif
#define REP(b) _Pragma("unroll 1") for (int rep_ = 0; rep_ < 1 + ((REP_MASK >> (b)) & 1); ++rep_)
__global__ void __launch_bounds__(NWAVES * 64, 2) mega(Args args) {
    extern __shared__ __attribute__((aligned(16))) unsigned char lds_raw[];
    LAS unsigned char* lds = (LAS unsigned char*)lds_raw;
    const int tid = threadIdx.x;
    const int G = gridDim.x;
    for (int u = tid; u < (LDS_BYTES - LDSCTL_OFF) / 4; u += NWAVES * 64) ((LAS unsigned*)(lds + LDSCTL_OFF))[u] = 0u;
    __syncthreads();
    XcdBarrier bar = xcd_barrier_post((unsigned*)(args.ws + OFF_CTL) + CW_BAR + args.bar_region * XCD_BAR_WORDS, (volatile LAS unsigned*)(lds + MISC_OFF) + 8);
    const int lo = args.ph_lo, hi = args.ph_hi;
#define IN(k) (lo <= (k) && (k) < hi)
#define SEAM(k) do { if (IN(k) && IN((k) + 1)) xcd_barrier(bar); } while (0)

    REP(0) if (ON(0) && IN(0)) {
        PHASE_ARGS();
        LAS float* scr = (LAS float*)(lds + RING_OFF + wave * 16384);
        const int gw = blockIdx.x * NWAVES + wave, ngw = G * NWAVES;
        p0_transpose_all(ka->in[2], WSP(bf16_t, OFF_WRI), 2, DM, RIN, scr, gw, ngw, lane);
        p0_transpose_all(ka->in[3], WSP(bf16_t, OFF_WRO), 2, RHV, DM, scr, gw, ngw, lane);
        p0_transpose_all(ka->in[4], WSP(bf16_t, OFF_WSI), 2, DM, 3 * DM, scr, gw, ngw, lane);
        p0_transpose_all(ka->in[5], WSP(bf16_t, OFF_WSO), 2, DM, DM, scr, gw, ngw, lane);
        p0_transpose_all(ka->in[17], WSP(bf16_t, OFF_WPG), 4, DM, DM, scr, gw, ngw, lane);
        p0_transpose_all(ka->in[16], WSP(bf16_t, OFF_WPW), 4, DPLE, DM, scr, gw, ngw, lane);
        p0_transpose_all(ka->in[10], WSP(bf16_t, OFF_WGU), NE, DM, 2 * DF, scr, gw, ngw, lane);
        p0_transpose_all(ka->in[12], WSP(bf16_t, OFF_WDN), NE, DF, DM, scr, gw, ngw, lane);
        const size_t gt = (size_t)blockIdx.x * (NWAVES * 64) + ptid, ngt = (size_t)G * NWAVES * 64;
        { const f32x4* x = (const f32x4*)ka->in[0]; u32x2* xb = WSP(u32x2, OFF_XB);
          for (size_t i = gt; i < (size_t)T * DM / 4; i += ngt) { const f32x4 v = x[i]; u32x2 o; o.x = pk2(v.x, v.y); o.y = pk2(v.z, v.w); xb[i] = o; } }
        { const f32x4* p = (const f32x4*)ka->in[1]; u32x2* pb = WSP(u32x2, OFF_PB);
          for (size_t i = gt; i < (size_t)4 * T * DPLE / 4; i += ngt) { const f32x4 v = p[i]; u32x2 o; o.x = pk2(v.x, v.y); o.y = pk2(v.z, v.w); pb[i] = o; } }
    }
    SEAM(0);
#pragma unroll 1
    for (int i = 0; i < DEPTH; ++i) {
        const int pb = 2 + 10 * i, j = i >> 1;
        if (IN(pb)) {
            REP(2) if (ON(2) && (i & 1) == 0) {
                PHASE_ARGS();
                pg8::DenseOrder S; S.init(T, RIN, DM, G, (int)blockIdx.x, WSP(bf16_t, OFF_XB), WSP(bf16_t, OFF_WRI) + (size_t)j * RIN * DM);
                if (ptid < 128) ((LAS float*)(lds + LDS_INVF))[ptid] = 1.0f / powf(10000.0f, (float)ptid / 128.0f);
                __syncthreads();
                pg8::EpiRetProj E{WSP(bf16_t, OFF_Q), WSP(bf16_t, OFF_K), WSP(bf16_t, OFF_V), WSP(bf16_t, OFF_G), (const LAS float*)(lds + LDS_INVF)};
                pg8::gemm_phase<pg8::EpiRetProj, pg8::DenseOrder, true, false>(lds + RING_OFF, DM, S, E);
            } REP(3) if (ON(3) && (i & 1) == 1) {
                PHASE_ARGS();
                pg8::DenseOrder S; S.init(T, 3 * DM, DM, G, (int)blockIdx.x, WSP(bf16_t, OFF_XB), WSP(bf16_t, OFF_WSI) + (size_t)j * 3 * DM * DM);
                pg8::EpiBf16 E{WSP(bf16_t, OFF_Q), DM, DM, (size_t)(OFF_K - OFF_Q) / 2, 0.125f * 1.4426950408889634f, 0};
                pg8::gemm_phase<pg8::EpiBf16, pg8::DenseOrder, true, false>(lds + RING_OFF, DM, S, E);
            }
        }
        SEAM(pb);
        if (IN(pb + 1)) {
            REP(10) if (ON(10) && (i & 1) == 0) { PHASE_ARGS(); ret::scan_phase(lds + RING_OFF, WSP(bf16_t, OFF_Q), WSP(bf16_t, OFF_K), WSP(bf16_t, OFF_V), WSP(bf16_t, OFF_RO), G, (int)blockIdx.x,
                ka->in[10] + (size_t)(i + 1) * NE * DM * 2 * DF, WSP(bf16_t, OFF_WGU) + (size_t)(i + 1) * NE * 2 * DF * DM); }
            REP(11) if (ON(11) && (i & 1) == 1) { PHASE_ARGS(); sb::attn_phase(lds + RING_OFF, WSP(bf16_t, OFF_Q), WSP(bf16_t, OFF_K), WSP(bf16_t, OFF_V), WSP(bf16_t, OFF_GN), G, (int)blockIdx.x); }
        }
        SEAM(pb + 1);
        REP(12) if (ON(12) && IN(pb + 2) && (i & 1) == 0) {
            PHASE_ARGS();
            for (int w = blockIdx.x * NWAVES + wave; w < T * RH; w += G * NWAVES) ret::gate_row(w, lane, WSP(bf16_t, OFF_RO), WSP(bf16_t, OFF_G), WSP(bf16_t, OFF_GN));
        }
        if ((i & 1) == 0) SEAM(pb + 2);
        REP(4) if (ON(4) && IN(pb + 3)) {
            PHASE_ARGS();
            pg8::EpiBf16 E{WSP(bf16_t, OFF_MIX), DM, 0, 0, 1.0f, 0};
            const int Kx = (i & 1) ? DM : RHV;
            pg8::DenseOrder S; S.init(T, DM, Kx, G, (int)blockIdx.x, WSP(bf16_t, OFF_GN), (i & 1) ? (const void*)(WSP(bf16_t, OFF_WSO) + (size_t)j * DM * DM) : (const void*)(WSP(bf16_t, OFF_WRO) + (size_t)j * DM * RHV));
            pg8::gemm_phase<pg8::EpiBf16, pg8::DenseOrder, false, false>(lds + RING_OFF, Kx, S, E);
        }
        SEAM(pb + 3);
        REP(6) if (ON(6) && IN(pb + 4)) {
            PHASE_ARGS();
            if (i > 0) cvt_expert_weights(lds, ka->in[10], ka->in[12], ws, i, 1 << 20, ptid);
            __syncthreads();
            unsigned* cnt = WSP(unsigned, OFF_CTL) + CW_CNT + i * 2048;
            const float* lg = ka->in[6] + (size_t)i * DM; const float* lb = ka->in[7] + (size_t)i * DM; const float* rb = ka->in[9] + (size_t)i * NE;
            LAS int* rt_e = (LAS int*)(lds + LDS_ROFF); LAS float* rt_g = (LAS float*)(lds + LDS_SLOT); LAS int* rt_p = (LAS int*)(lds + LDS_SLOT + 1024); LAS int* rt_c = (LAS int*)(lds + LDS_BIAS); LAS int* rt_b = (LAS int*)(lds + LDS_BIAS + 128);
            if (ptid < NE) rt_c[ptid] = 0;
            __syncthreads();
            const int nrow = 2 * G * NWAVES;
            ln1_router_phase(lds + RING_OFF, G, (int)blockIdx.x, wave, lane, WSP(bf16_t, OFF_XB), WSP(bf16_t, OFF_MIX), lg, lb, ka->in[8] + (size_t)i * DM * NE, rb, WSP(bf16_t, OFF_X1B), rt_e, rt_g, rt_p, rt_c);
            __syncthreads();
            if (ptid < NE) rt_b[ptid] = (int)__hip_atomic_fetch_add(cnt + ptid * 64, (unsigned)rt_c[ptid], RLX_AGENT);
            __syncthreads();
            { const int nsw = (T - 2 * (int)blockIdx.x * NWAVES + nrow - 1) / nrow;
              int* elist = WSP(int, OFF_EL); float* gates = WSP(float, OFF_GT);
              for (int s = ptid; s < nsw * 64; s += NWAVES * 64) { const int li = s >> 2, kk = s & 3, sweep = li >> 4, wv = (li >> 1) & 7, r = li & 1;
                  const int t = 2 * ((int)blockIdx.x * NWAVES + wv) + sweep * nrow + r; const int ee = rt_e[s];
                  elist[(size_t)ee * T + rt_b[ee] + rt_p[s]] = t * 4 + kk; gates[t * 4 + kk] = rt_g[s]; } }
            __syncthreads();
        }
        SEAM(pb + 4);
        REP(7) if (ON(7) && IN(pb + 5)) {
            PHASE_ARGS();
            MoeOrder::setup(lds, WSP(unsigned, OFF_CTL) + CW_CNT + i * 2048);
            MoeOrder S; S.G = G; S.c = (int)blockIdx.x; S.nN = 2 * DF / 256; S.tp = (const LAS int*)(lds + LDS_TP); S.cn = (const LAS int*)(lds + LDS_TP + 256); S.elist = WSP(int, OFF_EL);
            S.A = (const char*)WSP(bf16_t, OFF_X1B); S.Bt = (const char*)(WSP(bf16_t, OFF_WGU) + (size_t)i * NE * 2 * DF * DM); S.bstride_e = (size_t)2 * DF * DM * 2; S.gather = true; S.roff = (LAS unsigned*)(lds + LDS_ROFF);
            S.bias = ka->in[11] + (size_t)i * NE * 2 * DF; S.bias_e = 2 * DF; S.slotT = (LAS int*)(lds + LDS_SLOT); S.biasT = (LAS float*)(lds + LDS_BIAS);
            pg8::EpiMoe1 E{(const LAS float*)(lds + LDS_BIAS), WSP(bf16_t, OFF_ACT)};
            pg8::gemm_phase<pg8::EpiMoe1, MoeOrder, true, true>(lds + RING_OFF, DM, S, E);
            if (i + 1 < DEPTH) { const int nwg = S.tp[NE] * S.nN, mine = (nwg - (int)blockIdx.x + G - 1) / G, most = (nwg + G - 1) / G;
                if (mine < most) cvt_expert_weights(lds, ka->in[10], ka->in[12], ws, i + 1, (most - mine) * CVT_TAIL_CLAIMS, ptid); }
        }
        SEAM(pb + 5);
        REP(8) if (ON(8) && IN(pb + 6)) {
            PHASE_ARGS();
            MoeOrder::setup(lds, WSP(unsigned, OFF_CTL) + CW_CNT + i * 2048);
            MoeOrder S; S.G = G; S.c = (int)blockIdx.x; S.nN = DM / 256; S.tp = (const LAS int*)(lds + LDS_TP); S.cn = (const LAS int*)(lds + LDS_TP + 256); S.elist = WSP(int, OFF_EL);
            S.A = (const char*)WSP(bf16_t, OFF_ACT); S.Bt = (const char*)(WSP(bf16_t, OFF_WDN) + (size_t)i * NE * DM * DF); S.bstride_e = (size_t)DM * DF * 2; S.gather = false; S.roff = (LAS unsigned*)(lds + LDS_ROFF);
            S.bias = ka->in[13] + (size_t)i * NE * DM; S.bias_e = DM; S.slotT = (LAS int*)(lds + LDS_SLOT); S.biasT = (LAS float*)(lds + LDS_BIAS);
            pg8::EpiMoe2 E{(const LAS float*)(lds + LDS_BIAS), WSP(bf16_t, OFF_YB), (const LAS int*)(lds + LDS_SLOT)};
            pg8::gemm_phase<pg8::EpiMoe2, MoeOrder, true, false>(lds + RING_OFF, DF, S, E);
            { const int nwg = S.tp[NE] * S.nN, rem = nwg % G, mine = (nwg - (int)blockIdx.x + G - 1) / G, most = (nwg + G - 1) / G;
              int nidle = rem ? G - rem : 0, q = (int)blockIdx.x - rem;
              if (nidle < 64) { nidle = G; q = (int)blockIdx.x; }
              int ppu = 0;
              if (q >= 0) { PPOrder P; P.G = nidle; P.c = 256 * i + q; P.lim = 256 * (i + 1); P.A = (const char*)WSP(bf16_t, OFF_PB); P.Bt = (const char*)WSP(bf16_t, OFF_WPW);
                  pg8::EpiBf16 E2{WSP(bf16_t, OFF_PPB), DM, 0, 0, 1.0f, (size_t)T * DM};
                  pg8::gemm_phase<pg8::EpiBf16, PPOrder, true, false>(lds + RING_OFF, DPLE, P, E2);
                  ppu = (256 - q + nidle - 1) / nidle; }
              if (i + 1 < DEPTH && mine < most) { const int claims = (most - mine) * CVT_TAIL_CLAIMS - ppu;
                  if (claims > 0) cvt_expert_weights(lds, ka->in[10], ka->in[12], ws, i + 1, claims, ptid); } }
        }
        SEAM(pb + 6);
        REP(9) if (ON(9) && IN(pb + 7)) {
            PHASE_ARGS();
            const float* lg = ka->in[14] + (size_t)i * DM; const float* lb = ka->in[15] + (size_t)i * DM;
            { const int st = G * NWAVES; int t = blockIdx.x * NWAVES + wave;
              for (; t + st < T; t += 2 * st) ln2_row2(t, t + st, lane, WSP(bf16_t, OFF_X1B), WSP(bf16_t, OFF_YB), WSP(float, OFF_GT), lg, lb, WSP(bf16_t, OFF_X2B));
              if (t < T) ln2_row(t, lane, WSP(bf16_t, OFF_X1B), WSP(bf16_t, OFF_YB), WSP(float, OFF_GT), lg, lb, WSP(bf16_t, OFF_X2B)); }
        }
        SEAM(pb + 7);
        REP(5) if (ON(5) && IN(pb + 8)) {
            PHASE_ARGS();
            pg8::DenseOrder S; S.init(T, DM, DM, G, (int)blockIdx.x, WSP(bf16_t, OFF_X2B), WSP(bf16_t, OFF_WPG) + (size_t)i * DM * DM);
            if (i == DEPTH - 1) { pg8::EpiPle<true> E{WSP(bf16_t, OFF_X2B), WSP(bf16_t, OFF_PPB) + (size_t)i * T * DM, ka->in[18] + (size_t)i * DM, WSP(bf16_t, OFF_XB), ka->out};
                pg8::gemm_phase<pg8::EpiPle<true>, pg8::DenseOrder, false, false>(lds + RING_OFF, DM, S, E); }
            else { pg8::EpiPle<false> E{WSP(bf16_t, OFF_X2B), WSP(bf16_t, OFF_PPB) + (size_t)i * T * DM, ka->in[18] + (size_t)i * DM, WSP(bf16_t, OFF_XB), nullptr};
                pg8::gemm_phase<pg8::EpiPle<false>, pg8::DenseOrder, false, false>(lds + RING_OFF, DM, S, E); }
        }
        SEAM(pb + 8);
    }
#undef IN
#undef SEAM
}
static int g_grid = 0;
extern "C" void kernel_launch(void* const* d_in, const int* in_sizes, int n_in, void* d_out, int out_size, void* d_ws, size_t ws_size, hipStream_t stream) {
    if (n_in != 19 || ws_size < WS_END || out_size != T * DM) { fprintf(stderr, "kernel_launch: unexpected arguments (n_in %d, ws %zu need %zu, out %d)\n", n_in, ws_size, (size_t)WS_END, out_size); return; }
    if (g_grid == 0) {
        int dev = 0, cus = 0;
        if (hipGetDevice(&dev) != hipSuccess || hipDeviceGetAttribute(&cus, hipDeviceAttributeMultiprocessorCount, dev) != hipSuccess) { g_grid = -1; return; }
        if (hipFuncSetAttribute((const void*)mega, hipFuncAttributeMaxDynamicSharedMemorySize, LDS_BYTES) != hipSuccess) { g_grid = -1; return; }
        int per_cu = 0; (void)hipOccupancyMaxActiveBlocksPerMultiprocessor(&per_cu, (const void*)mega, NWAVES * 64, LDS_BYTES); (void)hipGetLastError();
        if (per_cu < 1) fprintf(stderr, "kernel_launch: occupancy query reports %d workgroups per CU\n", per_cu);
        if (cus < 256) { fprintf(stderr, "kernel_launch: built for a 256-CU device (per-block routing tables hold 64 token rows); found %d CUs, nothing launched\n", cus); g_grid = -1; return; }
        g_grid = cus;
    }
    if (g_grid < 0) return;
    (void)hipMemsetAsync((unsigned char*)d_ws + OFF_CTL, 0, MiB, stream);
    Args a{};
    for (int i = 0; i < 19; ++i) a.in[i] = (const float*)d_in[i];
    a.out = (float*)d_out; a.ws = (unsigned char*)d_ws; a.ph_lo = 0; a.ph_hi = 2 + 10 * DEPTH; a.bar_region = 0; a.pad = 0;
    hipLaunchKernelGGL(mega, dim3(g_grid), dim3(NWAVES * 64), LDS_BYTES, stream, a);
}
```

```cpp
#include <hip/hip_runtime.h>
#include <stdint.h>
#include <cstdio>

typedef unsigned short bf16_t;
typedef short bf16x8 __attribute__((ext_vector_type(8)));
typedef float f32x4 __attribute__((ext_vector_type(4)));
typedef unsigned u32x4 __attribute__((ext_vector_type(4)));
typedef unsigned u32x2 __attribute__((ext_vector_type(2)));

constexpr int DM = 1024, NB = 8, SEQ = 2048, DEPTH = 4, T = NB * SEQ;
constexpr int RH = 4, RDK = 256, RDV = 512, RIN = 6144, RHV = RH * RDV;
constexpr int SH = 16, SD = 64;
constexpr int NE = 32, TOPK = 4, DF = 1024, DPLE = 256;
constexpr int NSLOT = T * TOPK;
constexpr int RPAD = NSLOT + NE * 256;
constexpr float DN_ALPHA = 1.6817928305074290f;
constexpr float LN_EPS = 1e-5f, GN_EPS = 1e-6f;

constexpr size_t MiB = (size_t)1 << 20;
constexpr size_t al(size_t x) { return (x + 255) & ~(size_t)255; }
constexpr size_t OFF_CTL = 0;
constexpr size_t OFF_WRI = OFF_CTL + MiB;
constexpr size_t OFF_WRO = OFF_WRI + al((size_t)2 * RIN * DM * 2);
constexpr size_t OFF_WSI = OFF_WRO + al((size_t)2 * DM * RHV * 2);
constexpr size_t OFF_WSO = OFF_WSI + al((size_t)2 * 3 * DM * DM * 2);
constexpr size_t OFF_WPG = OFF_WSO + al((size_t)2 * DM * DM * 2);
constexpr size_t OFF_WPW = OFF_WPG + al((size_t)4 * DM * DM * 2);
constexpr size_t OFF_WGU = OFF_WPW + al((size_t)4 * DM * DPLE * 2);
constexpr size_t OFF_WDN = OFF_WGU + al((size_t)128 * 2 * DF * DM * 2);
constexpr size_t OFF_PB  = OFF_WDN + al((size_t)128 * DM * DF * 2);
constexpr size_t OFF_XF  = OFF_PB  + al((size_t)4 * T * DPLE * 2);
constexpr size_t OFF_XB  = OFF_XF  + al((size_t)T * DM * 4);
constexpr size_t OFF_X1F = OFF_XB  + al((size_t)T * DM * 2);
constexpr size_t OFF_X1B = OFF_X1F + al((size_t)T * DM * 4);
constexpr size_t OFF_X2F = OFF_X1B + al((size_t)T * DM * 2);
constexpr size_t OFF_X2B = OFF_X2F + al((size_t)T * DM * 4);
constexpr size_t OFF_MIX = OFF_X2B + al((size_t)T * DM * 2);
constexpr size_t OFF_Q   = OFF_MIX + al((size_t)T * DM * 4);
constexpr size_t OFF_K   = OFF_Q   + al((size_t)T * DM * 2);
constexpr size_t OFF_V   = OFF_K   + al((size_t)T * DM * 2);
constexpr size_t OFF_G   = OFF_V   + al((size_t)T * RHV * 2);
constexpr size_t OFF_RO  = OFF_G   + al((size_t)T * RHV * 2);
constexpr size_t OFF_GN  = OFF_RO  + al((size_t)T * RHV * 4);
constexpr size_t OFF_ACT = OFF_GN  + al((size_t)T * RHV * 2);
constexpr size_t OFF_YB  = OFF_ACT + al((size_t)RPAD * DF * 2);
constexpr size_t OFF_PPB = OFF_YB  + al((size_t)(NSLOT + 1) * DM * 2);
constexpr size_t OFF_EL  = OFF_PPB + al((size_t)4 * T * DM * 2);
constexpr size_t OFF_GT  = OFF_EL  + al((size_t)NE * T * 4);
constexpr size_t OFF_ROPE= OFF_GT  + al((size_t)NSLOT * 4);
constexpr size_t OFF_PROJ= OFF_ROPE+ al((size_t)SEQ * 128 * 2 * 4);
constexpr size_t WS_END  = OFF_PROJ+ al((size_t)T * RIN * 4);
constexpr int CW_CNT = 16384;

__device__ __forceinline__ unsigned f2bf(float f) { unsigned u = __float_as_uint(f); return (u + 0x7fffu + ((u >> 16) & 1u)) >> 16; }
typedef float pk_f32x2 __attribute__((ext_vector_type(2))); typedef __bf16 pk_bf16x2 __attribute__((ext_vector_type(2)));
__device__ __forceinline__ unsigned pk2(float lo, float hi) { pk_f32x2 v = {lo, hi}; return __builtin_bit_cast(unsigned, __builtin_convertvector(v, pk_bf16x2)); }
__device__ __forceinline__ float bf2f(unsigned b) { return __uint_as_float(b << 16); }
template <int CTRL> __device__ __forceinline__ float dpp_f(float v) { return __builtin_bit_cast(float, __builtin_amdgcn_update_dpp(0, __builtin_bit_cast(int, v), CTRL, 0xf, 0xf, true)); }
__device__ __forceinline__ float lane_f(float v, int l) { return __builtin_bit_cast(float, __builtin_amdgcn_readlane(__builtin_bit_cast(int, v), l)); }
__device__ __forceinline__ float wave_sum(float v) {
    v += dpp_f<0xB1>(v); v += dpp_f<0x4E>(v); v += dpp_f<0x141>(v); v += dpp_f<0x140>(v);
    return (lane_f(v, 0) + lane_f(v, 16)) + (lane_f(v, 32) + lane_f(v, 48));
}
__device__ __forceinline__ float sigmoidf_(float x) { return 1.0f / (1.0f + __expf(-x)); }

#define LAS __attribute__((address_space(3)))
#define GAS __attribute__((address_space(1)))
namespace pg8 {
constexpr int BM = 256, BK = 64, HALF = 128, HTB = HALF * BK * 2  , STAGE_BYTES = 8 * HTB, NXCD = 8, WGM = 8;
__host__ __device__ __forceinline__ int lds_byte(int r, int c) { const int st = (r >> 4) * 2 + (c >> 5), rr = r & 15, cc = c & 31, ob = rr * 64 + cc * 2; return st * 1024 + (ob ^ (((ob >> 9) & 1) << 5)); }
__host__ __device__ __forceinline__ void stage_rc(int b, int& R, int& C) { const int st = b / 1024, sb = b % 1024, swz = sb ^ (((sb >> 9) & 1) << 5); R = (st >> 1) * 16 + swz / 64; C = (st & 1) * 32 + (swz % 64) / 2; }
__host__ __device__ __forceinline__ int perm32(int rho) { const int n = rho >> 4, i = rho & 15; return 8 * (i >> 2) + 4 * n + (i & 3); }
struct Unit { int pm, pn, e, lrow0, nvalid; };
template <class E> struct PermOf { static __host__ __device__ __forceinline__ int f(int rho) { return perm32(rho); } };
typedef float f32x2_t __attribute__((ext_vector_type(2))); typedef __bf16 bf16x2_t __attribute__((ext_vector_type(2)));
__device__ __forceinline__ unsigned cvt_pk_bf16(float lo, float hi) { f32x2_t v = {lo, hi}; bf16x2_t b = __builtin_convertvector(v, bf16x2_t); return __builtin_bit_cast(unsigned, b); }

struct DenseOrder {
    int nM, nN, nwg, G, c; const char* A; const char* Bt; size_t tstep;
    __device__ void init(int M, int N, int K, int G_, int c_, const void* A_, const void* Bt_) { nM = M / BM; nN = N / BM; nwg = nM * nN; G = G_; c = c_; A = (const char*)A_; Bt = (const char*)Bt_; tstep = (size_t)BM * K * 2; }
    __device__ bool next(int i, Unit& u) const {
        const long L = (long)i * G + c; if (L >= nwg) return false;
        int wgid = (int)L; { const int q = nwg / NXCD, r = nwg % NXCD, xcd = wgid % NXCD, off = wgid / NXCD; wgid = (xcd < r ? xcd * (q + 1) : r * (q + 1) + (xcd - r) * q) + off; }
        const int nig = WGM * nN, gid = wgid / nig, fm = gid * WGM, gsz = (nM - fm) < WGM ? (nM - fm) : WGM;
        u.pm = fm + ((wgid % nig) % gsz); u.pn = (wgid % nig) / gsz; u.e = 0; u.lrow0 = 0; u.nvalid = BM; return true;
    }
    __device__ __forceinline__ const char* a_base(const Unit& u) const { return A + (size_t)u.pm * tstep; }
    __device__ __forceinline__ const char* b_base(const Unit& u) const { return Bt + (size_t)u.pn * tstep; }
    __device__ __forceinline__ void prep(const Unit&, int, int, int) const {}
    __device__ __forceinline__ void prep_load(const Unit&, int, int&, f32x4&) const {}
    __device__ __forceinline__ void prep_store(int, int, int, int, const f32x4&) const {}
    static constexpr bool HAS_PREP = false;
    LAS unsigned* roff;
};
struct EpiF32 {
    static constexpr bool PERM = false; static constexpr int NSTORE = 16;
    float* C; int ldc;
    __device__ __forceinline__ void operator()(const f32x4 (&acc)[2][2][4][2], const Unit& u, int wr, int wc, int fr, int fq, int) const {
        const int row0 = u.pm * BM + wr * 64 + fr, col0 = u.pn * BM + wc * 32 + 4 * fq;
#pragma unroll
        for (int ai = 0; ai < 2; ++ai)
#pragma unroll
            for (int m = 0; m < 4; ++m) { float* rowp = C + (size_t)(row0 + ai * HALF + m * 16) * ldc + col0;
#pragma unroll
                for (int bj = 0; bj < 2; ++bj)
#pragma unroll
                    for (int n = 0; n < 2; ++n) *(f32x4*)(rowp + bj * HALF + n * 16) = acc[ai][bj][m][n]; }
    }
};
struct EpiBf16 {
    static constexpr bool PERM = true; static constexpr int NSTORE = 16;
    bf16_t* O; int ldc; int split_cols; size_t split_stride; float scale0; size_t estride;
    __device__ __forceinline__ void operator()(const f32x4 (&acc)[2][2][4][2], const Unit& u, int wr, int wc, int fr, int fq, int) const {
        const int row0 = u.pm * BM + wr * 64 + fr; int colt = u.pn * BM; bf16_t* base = O + (size_t)u.e * estride;
        float sc = 1.f; if (split_cols) { const int t = colt / split_cols; base += (size_t)t * split_stride; colt -= t * split_cols; if (t == 0) sc = scale0; }
        const int col0 = colt + wc * 32 + 8 * fq;
#pragma unroll
        for (int ai = 0; ai < 2; ++ai)
#pragma unroll
            for (int m = 0; m < 4; ++m) { bf16_t* rowp = base + (size_t)(row0 + ai * HALF + m * 16) * ldc + col0;
#pragma unroll
                for (int bj = 0; bj < 2; ++bj) { const f32x4 v0 = acc[ai][bj][m][0] * sc, v1 = acc[ai][bj][m][1] * sc;
                    u32x4 w; w.x = cvt_pk_bf16(v0[0], v0[1]); w.y = cvt_pk_bf16(v0[2], v0[3]); w.z = cvt_pk_bf16(v1[0], v1[1]); w.w = cvt_pk_bf16(v1[2], v1[3]);
                    *(u32x4*)(rowp + bj * HALF) = w; } }
    }
};
struct EpiRetProj {
    static constexpr bool PERM = true; static constexpr int NSTORE = 16;
    bf16_t *Q, *Kk, *V, *G; const LAS float* invf;
    __device__ __forceinline__ void operator()(const f32x4 (&acc)[2][2][4][2], const Unit& u, int wr, int wc, int fr, int fq, int) const {
        const int row0 = u.pm * BM + wr * 64 + fr, pn = u.pn;
        if (pn < 8) {
            const int h = pn & 3; bf16_t* dst = pn < 4 ? Q : Kk; const float sc = pn < 4 ? 1.0f : 0.0625f; const int d0 = wc * 32 + 8 * fq;
            const f32x4 f0 = *(const LAS f32x4*)(invf + d0), f1 = *(const LAS f32x4*)(invf + d0 + 4);
            const float fv[8] = {f0[0], f0[1], f0[2], f0[3], f1[0], f1[1], f1[2], f1[3]};
#pragma unroll
            for (int ai = 0; ai < 2; ++ai)
#pragma unroll
                for (int m = 0; m < 4; ++m) { const int r = row0 + ai * HALF + m * 16; const float pos = (float)(r & (SEQ - 1));
                    float cs[8], sn[8];
#pragma unroll
                    for (int q = 0; q < 8; ++q) { const float ang = pos * fv[q];
                        float rev = ang * 0.15915494309189535f; rev = rev - __builtin_floorf(rev); cs[q] = __builtin_amdgcn_cosf(rev); sn[q] = __builtin_amdgcn_sinf(rev); }
                    const f32x4 xa = acc[ai][0][m][0], xb = acc[ai][0][m][1], ya = acc[ai][1][m][0], yb = acc[ai][1][m][1];
                    const float x[8] = {xa[0], xa[1], xa[2], xa[3], xb[0], xb[1], xb[2], xb[3]}, y[8] = {ya[0], ya[1], ya[2], ya[3], yb[0], yb[1], yb[2], yb[3]};
                    u32x4 w1, w2;
                    w1.x = cvt_pk_bf16((x[0] * cs[0] - y[0] * sn[0]) * sc, (x[1] * cs[1] - y[1] * sn[1]) * sc); w1.y = cvt_pk_bf16((x[2] * cs[2] - y[2] * sn[2]) * sc, (x[3] * cs[3] - y[3] * sn[3]) * sc);
                    w1.z = cvt_pk_bf16((x[4] * cs[4] - y[4] * sn[4]) * sc, (x[5] * cs[5] - y[5] * sn[5]) * sc); w1.w = cvt_pk_bf16((x[6] * cs[6] - y[6] * sn[6]) * sc, (x[7] * cs[7] - y[7] * sn[7]) * sc);
                    w2.x = cvt_pk_bf16((x[0] * sn[0] + y[0] * cs[0]) * sc, (x[1] * sn[1] + y[1] * cs[1]) * sc); w2.y = cvt_pk_bf16((x[2] * sn[2] + y[2] * cs[2]) * sc, (x[3] * sn[3] + y[3] * cs[3]) * sc);
                    w2.z = cvt_pk_bf16((x[4] * sn[4] + y[4] * cs[4]) * sc, (x[5] * sn[5] + y[5] * cs[5]) * sc); w2.w = cvt_pk_bf16((x[6] * sn[6] + y[6] * cs[6]) * sc, (x[7] * sn[7] + y[7] * cs[7]) * sc);
                    bf16_t* o = dst + (size_t)r * DM + h * RDK + d0;
                    *(u32x4*)o = w1; *(u32x4*)(o + 128) = w2; }
        } else {
            bf16_t* dst = pn < 16 ? V : G; const int cb = (pn < 16 ? pn - 8 : pn - 16) * BM + wc * 32 + 8 * fq;
#pragma unroll
            for (int ai = 0; ai < 2; ++ai)
#pragma unroll
                for (int m = 0; m < 4; ++m) { bf16_t* rowp = dst + (size_t)(row0 + ai * HALF + m * 16) * RHV + cb;
#pragma unroll
                    for (int bj = 0; bj < 2; ++bj) { const f32x4 v0 = acc[ai][bj][m][0], v1 = acc[ai][bj][m][1];
                        u32x4 w; w.x = cvt_pk_bf16(v0[0], v0[1]); w.y = cvt_pk_bf16(v0[2], v0[3]); w.z = cvt_pk_bf16(v1[0], v1[1]); w.w = cvt_pk_bf16(v1[2], v1[3]);
                        *(u32x4*)(rowp + bj * HALF) = w; } }
        }
    }
};
template <bool OUT> struct EpiPle {
    static constexpr bool PERM = true; static constexpr int NSTORE = 16;
    const bf16_t* x2b; const bf16_t* pp; const float* bg; bf16_t* xb; float* out;
    __device__ __forceinline__ void operator()(const f32x4 (&acc)[2][2][4][2], const Unit& u, int wr, int wc, int fr, int fq, int) const {
        const int row0 = u.pm * BM + wr * 64 + fr, col0 = u.pn * BM + wc * 32 + 8 * fq;
        f32x4 bv[2][2];
#pragma unroll
        for (int bj = 0; bj < 2; ++bj)
#pragma unroll
            for (int n = 0; n < 2; ++n) bv[bj][n] = *(const f32x4*)(bg + col0 + bj * HALF + 4 * n);
        u32x4 xw = *(const u32x4*)(x2b + (size_t)row0 * DM + col0), pw = *(const u32x4*)(pp + (size_t)row0 * DM + col0);
#pragma unroll
        for (int s = 0; s < 16; ++s) { const int ai = s >> 3, m = (s >> 1) & 3, bj = s & 1;
            const size_t o = (size_t)(row0 + ai * HALF + m * 16) * DM + col0 + bj * HALF;
            const u32x4 xc = xw, pc = pw;
            if (s + 1 < 16) { const int s1 = s + 1, ai1 = s1 >> 3, m1 = (s1 >> 1) & 3, bj1 = s1 & 1; const size_t o1 = (size_t)(row0 + ai1 * HALF + m1 * 16) * DM + col0 + bj1 * HALF;
                xw = *(const u32x4*)(x2b + o1); pw = *(const u32x4*)(pp + o1); }
            __builtin_amdgcn_sched_barrier(0);
            const unsigned xs[4] = {xc.x, xc.y, xc.z, xc.w}, ps[4] = {pc.x, pc.y, pc.z, pc.w};
            float r[8];
#pragma unroll
            for (int q = 0; q < 4; ++q) { const f32x4 a = acc[ai][bj][m][q >> 1] + bv[bj][q >> 1]; const int e0 = 2 * (q & 1);
                r[2 * q] = bf2f(xs[q] & 0xffffu) + bf2f(ps[q] & 0xffffu) * __builtin_amdgcn_rcpf(1.0f + __expf(-a[e0])); r[2 * q + 1] = bf2f(xs[q] >> 16) + bf2f(ps[q] >> 16) * __builtin_amdgcn_rcpf(1.0f + __expf(-a[e0 + 1])); }
            u32x4 w; w.x = cvt_pk_bf16(r[0], r[1]); w.y = cvt_pk_bf16(r[2], r[3]); w.z = cvt_pk_bf16(r[4], r[5]); w.w = cvt_pk_bf16(r[6], r[7]);
            *(u32x4*)(xb + o) = w;
            if constexpr (OUT) { *(f32x4*)(out + o) = (f32x4){r[0], r[1], r[2], r[3]}; *(f32x4*)(out + o + 4) = (f32x4){r[4], r[5], r[6], r[7]}; }
            asm volatile("" ::: "memory"); }
    }
};

template <class Epi, class Sched, bool ALIGN_EPI, bool GATHER>
__device__ __forceinline__ void gemm_phase(LAS unsigned char* lds, const int Kin, const Sched& S, const Epi& E) {
    int tid = threadIdx.x; asm volatile("" : "+v"(tid));
    const int wid = __builtin_amdgcn_readfirstlane(tid >> 6), lane = tid & 63, wr = wid >> 2, wc = wid & 3, fr = lane & 15, fq = lane >> 4;
    int K = __builtin_amdgcn_readfirstlane(Kin); asm volatile("" : "+s"(K));
    const int nt = K / BK;
    unsigned voffB[2], voffA[2], vG[2][2];
#pragma unroll
    for (int i = 0; i < 2; ++i) { int R, C; stage_rc(tid * 16 + i * 8192, R, C); const int Rb = Epi::PERM ? ((R & ~31) + PermOf<Epi>::f(R & 31)) : R;
        voffB[i] = (unsigned)(Rb * K + C) * 2u; voffA[i] = (unsigned)(R * K + C) * 2u; }
    const size_t kstep = (size_t)(BK * 2);
    const size_t hstep = (size_t)HALF * K * 2;
    const unsigned ldsw = (unsigned)wid * 1024u;
    const int aoff = lds_byte(wr * 64 + fr, fq * 8), boff = lds_byte(wc * 32 + fr, fq * 8);
#define PG8_SA(b, h) (((b) * 2 + (h)) * HTB)
#define PG8_SB(b, h) ((4 + (b) * 2 + (h)) * HTB)
#define PG8_STAGE(bufoff, gbase, voff) do { _Pragma("unroll") for (int _i = 0; _i < 2; ++_i) { unsigned _o = (voff)[_i]; if constexpr (GATHER) asm volatile("" : "+v"(_o)); \
        __builtin_amdgcn_global_load_lds((const unsigned*)((const char*)(gbase) + _o), (LAS unsigned*)(lds + (bufoff) + ldsw + _i * 8192), 16, 0, 0); } } while (0)
#define PG8_STAGEA(bufoff, gbase, h, vg) do { if constexpr (GATHER) { PG8_STAGE(bufoff, gbase, vg[h]); } else { PG8_STAGE(bufoff, (gbase) + (h) * hstep, voffA); } } while (0)
#define PG8_LDA(dst, b, h) do { _Pragma("unroll") for (int m = 0; m < 4; ++m) _Pragma("unroll") for (int k = 0; k < 2; ++k) dst[m][k] = *(const LAS bf16x8*)(lds + PG8_SA(b, h) + aoff + m * 2048 + k * 1024); } while (0)
#define PG8_LDB(dst, b, h) do { _Pragma("unroll") for (int n = 0; n < 2; ++n) _Pragma("unroll") for (int k = 0; k < 2; ++k) dst[n][k] = *(const LAS bf16x8*)(lds + PG8_SB(b, h) + boff + n * 2048 + k * 1024); } while (0)
#define PG8_MMA(ai, bj, At, Bt) do { __builtin_amdgcn_s_setprio(1); _Pragma("unroll") for (int m = 0; m < 4; ++m) _Pragma("unroll") for (int n = 0; n < 2; ++n) _Pragma("unroll") for (int k = 0; k < 2; ++k) \
        acc[ai][bj][m][n] = __builtin_amdgcn_mfma_f32_16x16x32_bf16(Bt[n][k], At[m][k], acc[ai][bj][m][n], 0, 0, 0); __builtin_amdgcn_s_setprio(0); } while (0)
#define PG8_WAIT_V(n) asm volatile("s_waitcnt vmcnt(" #n ")" ::: "memory")
#define PG8_WAIT_L(n) asm volatile("s_waitcnt lgkmcnt(" #n ")" ::: "memory")
#define PG8_WAIT_VF(flag, n) asm volatile("v_cmp_ne_u32_e32 vcc, 0, %0\n\ts_cbranch_vccz .Lw8_%=\n\ts_waitcnt vmcnt(%1)\n\ts_branch .Lwd_%=\n.Lw8_%=:\n\ts_waitcnt vmcnt(8)\n.Lwd_%=:" :: "v"(flag), "n"(n) : "memory", "vcc")
#define PG8_BAR __builtin_amdgcn_s_barrier()
#define PG8_SCHED __builtin_amdgcn_sched_barrier(0)
#define PG8_TABLE(u, par) do { S.prep(u, par, tid, K); } while (0)
#define PG8_GREAD(dst) do { _Pragma("unroll") for (int _i = 0; _i < 2; ++_i) { int _R, _C; stage_rc(tid * 16 + _i * 8192, _R, _C); _Pragma("unroll") for (int _h = 0; _h < 2; ++_h) dst[_h][_i] = S.roff[_h * HALF + _R] + (unsigned)_C * 2u; } } while (0)
    Unit cur, nxt; int ui = 0; int pslot = 0; f32x4 pbias = (f32x4){0.f, 0.f, 0.f, 0.f};
    if (!S.next(0, cur)) return;
    f32x4 acc[2][2][4][2];
#pragma unroll
    for (int a = 0; a < 2; ++a)
#pragma unroll
        for (int b = 0; b < 2; ++b)
#pragma unroll
            for (int m = 0; m < 4; ++m)
#pragma unroll
                for (int n = 0; n < 2; ++n) { f32x2_t zl, zh; asm volatile("v_pk_mov_b32 %0, 0, 0" : "=v"(zl)); asm volatile("v_pk_mov_b32 %0, 0, 0" : "=v"(zh)); acc[a][b][m][n] = (f32x4){zl[0], zl[1], zh[0], zh[1]}; }
    bf16x8 At[4][2], B0[2][2], B1[2][2];
    const char* cA = S.a_base(cur); const char* cB = S.b_base(cur);
    if constexpr (Sched::HAS_PREP) { PG8_TABLE(cur, 0); asm volatile("s_waitcnt vmcnt(0) lgkmcnt(0)" ::: "memory"); __builtin_amdgcn_s_barrier(); asm volatile("" ::: "memory"); }
    if constexpr (GATHER) { PG8_GREAD(vG); }
    PG8_STAGE(PG8_SB(0, 0), cB, voffB); PG8_STAGE(PG8_SB(0, 1), cB + hstep, voffB); PG8_STAGEA(PG8_SA(0, 0), cA, 0, vG); PG8_STAGEA(PG8_SA(0, 1), cA, 1, vG);
    if (wr == 1) PG8_BAR;
    PG8_WAIT_V(2); PG8_BAR;
    PG8_STAGE(PG8_SB(1, 0), cB + kstep, voffB); PG8_STAGEA(PG8_SA(1, 0), cA + kstep, 0, vG); PG8_STAGE(PG8_SB(1, 1), cB + hstep + kstep, voffB);
    PG8_WAIT_V(6); PG8_BAR;
    for (;;) {
        const bool has_next = S.next(ui + 1, nxt);
        const char* nA = has_next ? S.a_base(nxt) : cA; const char* nB = has_next ? S.b_base(nxt) : cB;
        for (int t = 0; t < nt; t += 2) {
            const bool last = (t == nt - 2);
            const int fresh = (t == 0 && ui > 0) ? 1 : 0;
            const char* a1 = cA + (size_t)(t + 1) * kstep;
            const char* a2 = last ? nA : cA + (size_t)(t + 2) * kstep; const char* b2 = last ? nB : cB + (size_t)(t + 2) * kstep;
            const char* a3 = a2 + kstep; const char* b3 = b2 + kstep;
            if constexpr (Sched::HAS_PREP) {
                if (t == nt - 4 && has_next) S.prep_load(nxt, tid, pslot, pbias);
                if (last && has_next) S.prep_store((ui + 1) & 1, tid, K, pslot, pbias); }
            PG8_LDB(B0, 0, 0); PG8_LDB(B1, 0, 1); PG8_SCHED; PG8_LDA(At, 0, 0); PG8_STAGEA(PG8_SA(1, 1), a1, 1, vG);
            PG8_WAIT_VF(fresh, 8 + Epi::NSTORE); PG8_WAIT_L(0); PG8_BAR; PG8_MMA(0, 0, At, B0); PG8_MMA(0, 1, At, B1); PG8_BAR; PG8_SCHED;
            if constexpr (GATHER) { if (last && has_next) { PG8_GREAD(vG); } }
            PG8_LDA(At, 0, 1); PG8_STAGE(PG8_SB(0, 0), b2, voffB); PG8_STAGE(PG8_SB(0, 1), b2 + hstep, voffB); PG8_STAGEA(PG8_SA(0, 0), a2, 0, vG);
            PG8_WAIT_VF(fresh, 8 + Epi::NSTORE); PG8_WAIT_L(0); PG8_BAR; PG8_MMA(1, 0, At, B0); PG8_MMA(1, 1, At, B1); PG8_BAR; PG8_SCHED;
            PG8_LDB(B0, 1, 0); PG8_LDB(B1, 1, 1); PG8_SCHED; PG8_LDA(At, 1, 0); PG8_STAGEA(PG8_SA(0, 1), a2, 1, vG);
            PG8_WAIT_V(8); PG8_WAIT_L(0); PG8_BAR; PG8_MMA(0, 0, At, B0); PG8_MMA(0, 1, At, B1); PG8_BAR; PG8_SCHED;
            PG8_LDA(At, 1, 1); PG8_STAGE(PG8_SB(1, 0), b3, voffB); PG8_STAGE(PG8_SB(1, 1), b3 + hstep, voffB); PG8_STAGEA(PG8_SA(1, 0), a3, 0, vG);
            PG8_WAIT_V(8); PG8_WAIT_L(0); PG8_BAR; PG8_MMA(1, 0, At, B0); PG8_MMA(1, 1, At, B1); PG8_BAR; PG8_SCHED;
        }
        if constexpr (ALIGN_EPI) { if (wr == 0) PG8_BAR; }
        { int el = lane; asm volatile("" : "+v"(el));
          E(acc, cur, wr, wc, el & 15, el >> 4, ui & 1); }
        if (!has_next) break;
#pragma unroll
        for (int a = 0; a < 2; ++a)
#pragma unroll
            for (int b = 0; b < 2; ++b)
#pragma unroll
                for (int m = 0; m < 4; ++m)
#pragma unroll
                    for (int n = 0; n < 2; ++n) { f32x2_t zl, zh; asm volatile("v_pk_mov_b32 %0, 0, 0" : "=v"(zl)); asm volatile("v_pk_mov_b32 %0, 0, 0" : "=v"(zh)); acc[a][b][m][n] = (f32x4){zl[0], zl[1], zh[0], zh[1]}; }
        cur = nxt; cA = nA; cB = nB; ++ui;
        if constexpr (ALIGN_EPI) { if (wr == 1) PG8_BAR; }
    }
    PG8_WAIT_V(0);
    if constexpr (!ALIGN_EPI) { if (wr == 0) PG8_BAR; }
    PG8_BAR;
#undef PG8_SA
#undef PG8_SB
#undef PG8_STAGE
#undef PG8_STAGEA
#undef PG8_LDA
#undef PG8_LDB
#undef PG8_MMA
#undef PG8_WAIT_V
#undef PG8_WAIT_L
#undef PG8_WAIT_VF
#undef PG8_BAR
#undef PG8_SCHED
#undef PG8_TABLE
#undef PG8_GREAD
}
}
typedef float f32x2 __attribute__((ext_vector_type(2)));
constexpr int NWAVES = 8;
constexpr int RING_OFF = 0, RING_BYTES = 139264;
constexpr int LDSCTL_OFF = RING_BYTES, MISC_OFF = LDSCTL_OFF + 320;
constexpr int LDS_BYTES = 147456;
constexpr int CW_BAR = 4096;
typedef GAS unsigned gu32;
#define RLX_AGENT __ATOMIC_RELAXED, __HIP_MEMORY_SCOPE_AGENT

#define XB_TMO      128
#define XB_XCNT(j)  (256  + 64 * (j))
#define XB_XSUB(j)  (1280 + 64 * (j))
#define XB_XGEN(j)  (2304 + 64 * (j))
#define XB_TOP      3328
#define XB_TOPGEN   3392
#define XCD_BAR_WORDS 3456
#define XB_SPIN_CAP (1u << 18)
__device__ __forceinline__ unsigned xb_ld(unsigned* p)              { return __hip_atomic_load(p, __ATOMIC_RELAXED, __HIP_MEMORY_SCOPE_AGENT); }
__device__ __forceinline__ unsigned xb_add(unsigned* p, unsigned v) { return __hip_atomic_fetch_add(p, v, __ATOMIC_RELAXED, __HIP_MEMORY_SCOPE_AGENT); }
__device__ __forceinline__ unsigned xb_xcc_id() { return (unsigned)__builtin_amdgcn_s_getreg((3 << 11) | 20) & 0xFu; }
#define XB_SPIN(cond, bar) do { unsigned _sp = 0; while (cond) { __builtin_amdgcn_s_sleep(1); \
    if ((++_sp & 255u) == 0u) { if (xb_ld(&(bar)[XB_TMO])) break; if (_sp > XB_SPIN_CAP) { atomicAdd(&(bar)[XB_TMO], 1u); break; } } } } while (0)
struct XcdBarrier { unsigned* bar; unsigned x; volatile LAS unsigned* st; };
__device__ __forceinline__ XcdBarrier xcd_barrier_post(unsigned* bar, volatile LAS unsigned* st) {
    XcdBarrier b; b.bar = bar; b.x = xb_xcc_id(); b.st = st;
    if (threadIdx.x == 0) (void)xb_add(&bar[XB_XCNT(b.x)], 1u);
    return b;
}
__device__ __forceinline__ void xcd_barrier_complete(unsigned* bar, unsigned x, unsigned& nloc, unsigned& nx) {
    const unsigned G = gridDim.x * gridDim.y * gridDim.z;
    unsigned sum, cnt, mine, sp = 0u;
    for (;;) {
        sum = 0u; cnt = 0u; mine = 0u;
#pragma unroll
        for (unsigned j = 0; j < 16; ++j) { const unsigned c = xb_ld(&bar[XB_XCNT(j)]); sum += c; cnt += (c > 0u) ? 1u : 0u; mine = (j == x) ? c : mine; }
        if (sum == G) break;
        __builtin_amdgcn_s_sleep(1);
        if ((++sp & 255u) == 0u) { if (xb_ld(&bar[XB_TMO])) break; if (sp > XB_SPIN_CAP) { atomicAdd(&bar[XB_TMO], 1u); break; } }
    }
    nloc = mine > 0u ? mine : 1u; nx = cnt > 0u ? cnt : 1u;
}
__device__ __forceinline__ void xcd_barrier(const XcdBarrier& b) {
    asm volatile("s_waitcnt vmcnt(0)" ::: "memory");
    __syncthreads();
    if (threadIdx.x == 0) {
        unsigned* bar = b.bar;
        __builtin_amdgcn_s_waitcnt(0);
        unsigned nloc = b.st[0], nx = b.st[1];
        if (nloc == 0u) { xcd_barrier_complete(bar, b.x, nloc, nx); b.st[0] = nloc; b.st[1] = nx; }
        const unsigned old = xb_add(&bar[XB_XSUB(b.x)], 1u);
        const unsigned gen = old / nloc;
        if (old + 1u == (gen + 1u) * nloc) {
            __builtin_amdgcn_fence(__ATOMIC_RELEASE, "agent");
            asm volatile("s_waitcnt vmcnt(0)" ::: "memory");
            const unsigned og = xb_add(&bar[XB_TOP], 1u);
            const unsigned tg = og / nx;
            if (og + 1u == (tg + 1u) * nx) xb_add(&bar[XB_TOPGEN], 1u);
            else XB_SPIN(xb_ld(&bar[XB_TOPGEN]) == tg, bar);
            __builtin_amdgcn_fence(__ATOMIC_ACQUIRE, "agent");
            xb_add(&bar[XB_XGEN(b.x)], 1u);
            asm volatile("s_waitcnt vmcnt(0)" ::: "memory");
        } else {
            XB_SPIN(xb_ld(&bar[XB_XGEN(b.x)]) == gen, bar);
            __builtin_amdgcn_fence(__ATOMIC_ACQUIRE, "agent");
            asm volatile("s_waitcnt vmcnt(0)" ::: "memory");
        }
    }
    __syncthreads();
}

__device__ __forceinline__ void p0_transpose_item(const float* __restrict__ Wm, int K, int N, bf16_t* __restrict__ WTm, LAS float* scr, int item, int lane) {
    const int nblk = N / 32, kb = item / nblk, nbk = item % nblk, k0 = 64 * kb, n0 = 32 * nbk;
#pragma unroll 8
    for (int i = 0; i < 32; ++i) { const int kk = 2 * i + (lane >> 5); scr[kk * 33 + (lane & 31)] = Wm[(size_t)(k0 + kk) * N + n0 + (lane & 31)]; }
    asm volatile("s_waitcnt lgkmcnt(0)" ::: "memory");
    const int c = lane & 7;
#pragma unroll
    for (int j = 0; j < 4; ++j) { const int n = (lane >> 3) + 8 * j; const LAS float* s = scr + (8 * c) * 33 + n;
        u32x4 o; o.x = pk2(s[0 * 33], s[1 * 33]); o.y = pk2(s[2 * 33], s[3 * 33]); o.z = pk2(s[4 * 33], s[5 * 33]); o.w = pk2(s[6 * 33], s[7 * 33]);
        *(u32x4*)(WTm + (size_t)(n0 + n) * K + k0 + 8 * c) = o; }
    asm volatile("s_waitcnt lgkmcnt(0)" ::: "memory");
}
__device__ __forceinline__ void p0_transpose_range(const float* W, bf16_t* WT, int K, int N, LAS float* scr, long it0, long itend, int step, int lane) {
    const int nblk = N / 32, per = (K / 64) * nblk;
    if (it0 >= itend) return;
    float RA[32], RB[32];
#define P0_LOAD(R, itv) do { const int mb_ = (int)((itv) / per), item_ = (int)((itv) % per), k0_ = 64 * (item_ / nblk), n0_ = 32 * (item_ % nblk); \
        const float* src_ = W + (size_t)mb_ * K * N + (size_t)(k0_ + (lane >> 5)) * N + n0_ + (lane & 31); \
        _Pragma("unroll") for (int i_ = 0; i_ < 32; ++i_) R[i_] = __builtin_nontemporal_load(src_ + (size_t)(2 * i_) * N); } while (0)
#define P0_EMIT(R, itv) do { \
        _Pragma("unroll") for (int i_ = 0; i_ < 32; ++i_) scr[(2 * i_ + (lane >> 5)) * 33 + (lane & 31)] = R[i_]; \
        asm volatile("s_waitcnt lgkmcnt(0)" ::: "memory"); \
        { const int mb = (int)((itv) / per), item = (int)((itv) % per), k0 = 64 * (item / nblk), n0 = 32 * (item % nblk); bf16_t* WTm = WT + (size_t)mb * K * N; const int c = lane & 7; \
          _Pragma("unroll") for (int j = 0; j < 4; ++j) { const int n = (lane >> 3) + 8 * j; const LAS float* sp = scr + (8 * c) * 33 + n; \
              u32x4 o; o.x = pk2(sp[0 * 33], sp[1 * 33]); o.y = pk2(sp[2 * 33], sp[3 * 33]); o.z = pk2(sp[4 * 33], sp[5 * 33]); o.w = pk2(sp[6 * 33], sp[7 * 33]); \
              *(u32x4*)(WTm + (size_t)(n0 + n) * K + k0 + 8 * c) = o; } } \
        asm volatile("s_waitcnt lgkmcnt(0)" ::: "memory"); } while (0)
    long ia = it0, ib = it0 + step;
    P0_LOAD(RA, ia);
    if (ib < itend) P0_LOAD(RB, ib);
    for (;;) {
        const long ca = ia; P0_EMIT(RA, ca);
        ia = ib + step; if (ia < itend) P0_LOAD(RA, ia);
        if (ib >= itend) break;
        const long cb = ib; P0_EMIT(RB, cb);
        ib = ia + step; if (ib < itend) P0_LOAD(RB, ib);
        if (ia >= itend) break;
    }
#undef P0_LOAD
#undef P0_EMIT
}
__device__ __forceinline__ void p0_transpose_all(const float* W, bf16_t* WT, int nb, int K, int N, LAS float* scr, int gw, int ngw, int lane) {
    p0_transpose_range(W, WT, K, N, scr, gw, (long)nb * (K / 64) * (N / 32), ngw, lane);
}
#ifndef CVT_TAIL_CLAIMS
#define CVT_TAIL_CLAIMS 3
#endif
constexpr int CVT_GU = NE * (DM / 64) * (2 * DF / 32), CVT_DN = NE * (DF / 64) * (DM / 32), CVT_ITEMS = CVT_GU + CVT_DN;
constexpr int CW_CVT = 1024;
constexpr int LDS_CLAIM = LDSCTL_OFF + 960;
__device__ __forceinline__ void cvt_expert_weights(LAS unsigned char* lds, const float* wgu, const float* wdn, unsigned char* ws, int layer, int max_claims, int tid) {
    const int wave = __builtin_amdgcn_readfirstlane(tid >> 6), lane = tid & 63;
    LAS float* scr = (LAS float*)(lds + RING_OFF + wave * 16384);
    volatile LAS unsigned* cw = (volatile LAS unsigned*)(lds + LDS_CLAIM);
    unsigned* ctr = (unsigned*)(ws + OFF_CTL) + CW_CVT + 64 * layer;
    for (int r = 0; r < max_claims; ++r) {
        __syncthreads();
        if (tid == 0) *cw = __hip_atomic_fetch_add(ctr, 32u, RLX_AGENT);
        __syncthreads();
        const int base = __builtin_amdgcn_readfirstlane((int)*cw) + ((layer & 1) ? CVT_GU : 0);
        if (base >= CVT_ITEMS) break;
        const long it0 = base + 4 * wave;
        if (base < CVT_GU) p0_transpose_range(wgu + (size_t)layer * NE * DM * 2 * DF, (bf16_t*)(ws + OFF_WGU) + (size_t)layer * NE * 2 * DF * DM, DM, 2 * DF, scr, it0, it0 + 4, 1, lane);
        else p0_transpose_range(wdn + (size_t)layer * NE * DF * DM, (bf16_t*)(ws + OFF_WDN) + (size_t)layer * NE * DM * DF, DF, DM, scr, it0 - CVT_GU, it0 - CVT_GU + 4, 1, lane);
    }
    __syncthreads();
}

struct PPOrder {
    int G, c, lim; const char* A; const char* Bt;
    __device__ bool next(int i, pg8::Unit& u) const { const int L = i * G + c; if (L >= lim) return false; u.e = L >> 8; u.pm = (L & 255) >> 2; u.pn = L & 3; u.lrow0 = 0; u.nvalid = 256; return true; }
    __device__ __forceinline__ const char* a_base(const pg8::Unit& u) const { return A + ((size_t)u.e * T + (size_t)u.pm * 256) * DPLE * 2; }
    __device__ __forceinline__ const char* b_base(const pg8::Unit& u) const { return Bt + ((size_t)u.e * DM + (size_t)u.pn * 256) * DPLE * 2; }
    __device__ __forceinline__ void prep(const pg8::Unit&, int, int, int) const {}
    __device__ __forceinline__ void prep_load(const pg8::Unit&, int, int&, f32x4&) const {}
    __device__ __forceinline__ void prep_store(int, int, int, int, const f32x4&) const {}
    static constexpr bool HAS_PREP = false;
    LAS unsigned* roff;
};

constexpr int LDS_ROFF = LDSCTL_OFF + 2048;
constexpr int LDS_SLOT = LDSCTL_OFF + 3072;
constexpr int LDS_BIAS = LDSCTL_OFF + 5120;
constexpr int LDS_INVF = LDSCTL_OFF + 7168;
constexpr int LDS_TP = LDSCTL_OFF + 1024;
struct MoeOrder {
    LAS unsigned* roff; int G, c, nN; const LAS int* tp; const LAS int* cn; const int* elist; const char* A; const char* Bt; size_t bstride_e; bool gather;
    static __device__ __forceinline__ void setup(LAS unsigned char* lds, const unsigned* cnt) {
        LAS int* tp = (LAS int*)(lds + LDS_TP); LAS int* cn = (LAS int*)(lds + LDS_TP + 256);
        __syncthreads();
        if (threadIdx.x < NE) cn[threadIdx.x] = (int)__hip_atomic_load(cnt + threadIdx.x * 64, RLX_AGENT);
        __syncthreads();
        if (threadIdx.x == 0) { int a = 0; for (int e = 0; e < NE; ++e) { tp[e] = a; a += (cn[e] + 255) >> 8; } tp[NE] = a; }
        __syncthreads();
    }
    mutable int ehint = 0, nwg_c = -1;
    __device__ bool next(int i, pg8::Unit& u) const {
        if (nwg_c < 0) nwg_c = __builtin_amdgcn_readfirstlane(tp[NE]) * nN;
        const int nwg = nwg_c; const long L = (long)i * G + c; if (L >= nwg) return false;
        int wgid = (int)L; { const int q = nwg / 8, r = nwg % 8, xcd = wgid % 8, off = wgid / 8; wgid = (xcd < r ? xcd * (q + 1) : r * (q + 1) + (xcd - r) * q) + off; }
        int e = ehint; int t0 = __builtin_amdgcn_readfirstlane(tp[e]); if (wgid < t0 * nN) { e = 0; t0 = 0; }
        int t1 = __builtin_amdgcn_readfirstlane(tp[e + 1]);
        while (wgid >= t1 * nN) { ++e; t0 = t1; t1 = __builtin_amdgcn_readfirstlane(tp[e + 1]); }
        ehint = e;
        const int ce = __builtin_amdgcn_readfirstlane(cn[e]);
        const int w = wgid - t0 * nN, te = t1 - t0, m = w % te;
        u.pn = w / te; u.pm = t0 + m; u.e = e; u.lrow0 = m * 256; u.nvalid = ce - m * 256; return true;
    }
    __device__ __forceinline__ const char* a_base(const pg8::Unit& u) const { return gather ? A : A + (size_t)u.pm * 256 * DF * 2; }
    __device__ __forceinline__ const char* b_base(const pg8::Unit& u) const { return Bt + (size_t)u.e * bstride_e + (size_t)u.pn * 256 * DM * 2; }
    static constexpr bool HAS_PREP = true;
    const float* bias; int bias_e;
    LAS int* slotT; LAS float* biasT;
    __device__ __forceinline__ void prep(const pg8::Unit& u, int par, int tid, int K) const {
        if (tid < 256) { const int slot = tid < u.nvalid ? elist[(size_t)u.e * T + u.lrow0 + tid] : (gather ? 0 : NSLOT);
            if (gather) roff[tid] = (unsigned)(slot >> 2) * (unsigned)(K * 2); else slotT[par * 256 + tid] = slot; }
        else if (tid < 320) { const int q = tid - 256; const f32x4 b = *(const f32x4*)(bias + (size_t)u.e * bias_e + u.pn * 256 + 4 * q); *(LAS f32x4*)(biasT + par * 256 + 4 * q) = b; }
    }
    __device__ __forceinline__ void prep_load(const pg8::Unit& u, int tid, int& slot, f32x4& b) const {
        if (tid < 256) slot = tid < u.nvalid ? elist[(size_t)u.e * T + u.lrow0 + tid] : (gather ? 0 : NSLOT);
        else if (tid < 320) b = *(const f32x4*)(bias + (size_t)u.e * bias_e + u.pn * 256 + 4 * (tid - 256));
    }
    __device__ __forceinline__ void prep_store(int par, int tid, int K, int slot, const f32x4& b) const {
        if (tid < 256) { if (gather) roff[tid] = (unsigned)(slot >> 2) * (unsigned)(K * 2); else slotT[par * 256 + tid] = slot; }
        else if (tid < 320) *(LAS f32x4*)(biasT + par * 256 + 4 * (tid - 256)) = b;
    }
};
namespace pg8 {
struct EpiMoe1 {
    static constexpr bool PERM = true; static constexpr int NSTORE = 8;
    const LAS float* biasT; bf16_t* act;
    __device__ __forceinline__ void operator()(const f32x4 (&acc)[2][2][4][2], const Unit& u, int wr, int wc, int fr, int fq, int par) const {
        const int cl = wc * 32 + 8 * fq, colg = u.pn * BM + cl; const LAS float* bp = biasT + par * 256 + cl;
        f32x4 bg[2], bu[2];
#pragma unroll
        for (int bj = 0; bj < 2; ++bj) { const f32x4 b0 = *(const LAS f32x4*)(bp + bj * HALF), b1 = *(const LAS f32x4*)(bp + bj * HALF + 4);
            bg[bj] = (f32x4){b0[0], b0[2], b1[0], b1[2]}; bu[bj] = (f32x4){b0[1], b0[3], b1[1], b1[3]} + 1.0f; }
        const bool odd = (fq & 1) != 0;
#pragma unroll
        for (int ai = 0; ai < 2; ++ai)
#pragma unroll
            for (int mp = 0; mp < 2; ++mp) {
                const int lr = ai * HALF + wr * 64 + (2 * mp + (odd ? 1 : 0)) * 16 + fr;
                bf16_t* rowp = act + (size_t)(u.pm * BM + lr) * DF + (colg >> 1) - (odd ? 4 : 0);
#pragma unroll
                for (int bj = 0; bj < 2; ++bj) { u32x2 w[2];
#pragma unroll
                    for (int h = 0; h < 2; ++h) { const int m = 2 * mp + h; f32x4 G = acc[ai][bj][m][0] + bg[bj], U = acc[ai][bj][m][1] + bu[bj], R;
#pragma unroll
                        for (int q = 0; q < 4; ++q) { G[q] = fminf(G[q], 7.0f); U[q] = __builtin_amdgcn_fmed3f(U[q], -6.0f, 8.0f); }
                        const f32x4 X = G * (-1.702f * 1.4426950408889634f);
#pragma unroll
                        for (int q = 0; q < 4; ++q) R[q] = __builtin_amdgcn_exp2f(X[q]);
                        R = R + 1.0f;
#pragma unroll
                        for (int q = 0; q < 4; ++q) R[q] = __builtin_amdgcn_rcpf(R[q]);
                        const f32x4 A = U * (G * R);
                        w[h].x = cvt_pk_bf16(A[0], A[1]); w[h].y = cvt_pk_bf16(A[2], A[3]); }
                    const auto rx = __builtin_amdgcn_permlane16_swap(w[0].x, w[1].x, false, false), ry = __builtin_amdgcn_permlane16_swap(w[0].y, w[1].y, false, false);
                    *(u32x4*)(rowp + bj * (HALF / 2)) = (u32x4){rx[0], ry[0], rx[1], ry[1]}; }
                asm volatile("" ::: "memory"); }
    }
};
template <> struct PermOf<EpiMoe1> { static __host__ __device__ __forceinline__ int f(int rho) { const int n = rho >> 4, i = rho & 15; return 8 * (i >> 2) + 2 * (i & 3) + n; } };
struct EpiMoe2 {
    static constexpr bool PERM = true; static constexpr int NSTORE = 16;
    const LAS float* biasT; bf16_t* yb; const LAS int* slotT;
    __device__ __forceinline__ void operator()(const f32x4 (&acc)[2][2][4][2], const Unit& u, int wr, int wc, int fr, int fq, int par) const {
        const int cl = wc * 32 + 8 * fq, col = u.pn * BM + cl; const LAS float* bp = biasT + par * 256 + cl;
        f32x4 bv[2][2];
#pragma unroll
        for (int bj = 0; bj < 2; ++bj)
#pragma unroll
            for (int n = 0; n < 2; ++n) bv[bj][n] = *(const LAS f32x4*)(bp + bj * HALF + 4 * n);
#pragma unroll
        for (int ai = 0; ai < 2; ++ai)
#pragma unroll
            for (int m = 0; m < 4; ++m) { const int lr = ai * HALF + wr * 64 + m * 16 + fr;
                { const int slot = slotT[par * 256 + lr]; bf16_t* rowp = yb + (size_t)slot * DM + col;
#pragma unroll
                for (int bj = 0; bj < 2; ++bj) { const f32x4 v0 = acc[ai][bj][m][0] + bv[bj][0], v1 = acc[ai][bj][m][1] + bv[bj][1];
                    u32x4 w; w.x = cvt_pk_bf16(v0[0], v0[1]); w.y = cvt_pk_bf16(v0[2], v0[3]); w.z = cvt_pk_bf16(v1[0], v1[1]); w.w = cvt_pk_bf16(v1[2], v1[3]);
                    *(u32x4*)(rowp + bj * HALF) = w; } }
                asm volatile("" ::: "memory"); }
    }
};
}

constexpr int XT_ST = 2064;
constexpr int O_XH = 0, O_XL = 16 * XT_ST, O_PT = 2 * 16 * XT_ST, PT_ST = 36;
__device__ __forceinline__ void ln1_router_phase(LAS unsigned char* ring, int G, int c, int wave, int lane, const bf16_t* __restrict__ xb_in, const bf16_t* __restrict__ mix, const float* __restrict__ lg, const float* __restrict__ lb,
                                                 const float* __restrict__ rw, const float* __restrict__ rb, bf16_t* __restrict__ x1b, LAS int* rt_e, LAS float* rt_g, LAS int* rt_p, LAS int* rt_c) {
    const int fr = lane & 15, fq = lane >> 4;
    bf16x8 bh[4][2], bl[4][2];
#pragma unroll
    for (int ks = 0; ks < 4; ++ks)
#pragma unroll
        for (int nt = 0; nt < 2; ++nt) { const float* wp = rw + (size_t)(128 * wave + 32 * ks + 8 * fq) * NE + 16 * nt + fr; unsigned h[4], l[4];
#pragma unroll
            for (int q = 0; q < 4; ++q) { const float w0 = wp[(2 * q) * NE], w1 = wp[(2 * q + 1) * NE]; h[q] = pg8::cvt_pk_bf16(w0, w1);
                l[q] = pg8::cvt_pk_bf16(w0 - __uint_as_float(h[q] << 16), w1 - __uint_as_float(h[q] & 0xffff0000u)); }
            bh[ks][nt] = __builtin_bit_cast(bf16x8, (u32x4){h[0], h[1], h[2], h[3]}); bl[ks][nt] = __builtin_bit_cast(bf16x8, (u32x4){l[0], l[1], l[2], l[3]}); }
    const int nrow = 2 * G * NWAVES, t0 = 2 * (c * NWAVES + wave);
    const int nsw = (T - 2 * c * NWAVES + nrow - 1) / nrow;
    const float rbv = rb[lane & 31];
    u32x2 ra[2][4], rm[2][4];
#pragma unroll
    for (int r = 0; r < 2; ++r)
#pragma unroll
        for (int j = 0; j < 4; ++j) { const size_t o = (size_t)(t0 + r) * DM + 4 * lane + 256 * j; ra[r][j] = *(const u32x2*)(xb_in + o); rm[r][j] = *(const u32x2*)(mix + o); }
    for (int sweep = 0; sweep < nsw; ++sweep) {
        const int t = t0 + sweep * nrow;
#pragma unroll
        for (int r = 0; r < 2; ++r) {
            f32x4 y[4]; float s = 0.f; const size_t ro = (size_t)(t + r) * DM;
#pragma unroll
            for (int j = 0; j < 4; ++j) { const u32x2 aw = ra[r][j], mw = rm[r][j];
                y[j] = (f32x4){bf2f(aw.x & 0xffffu), bf2f(aw.x >> 16), bf2f(aw.y & 0xffffu), bf2f(aw.y >> 16)} * DN_ALPHA + (f32x4){bf2f(mw.x & 0xffffu), bf2f(mw.x >> 16), bf2f(mw.y & 0xffffu), bf2f(mw.y >> 16)};
                s += (y[j].x + y[j].y) + (y[j].z + y[j].w); }
            const float mean = wave_sum(s) * (1.0f / DM); float s2 = 0.f;
#pragma unroll
            for (int j = 0; j < 4; ++j) { y[j] = y[j] - mean; s2 += (y[j].x * y[j].x + y[j].y * y[j].y) + (y[j].z * y[j].z + y[j].w * y[j].w); }
            const float rstd = 1.0f / sqrtf(wave_sum(s2) * (1.0f / DM) + LN_EPS);
#pragma unroll
            for (int j = 0; j < 4; ++j) { const int cc = 4 * lane + 256 * j; const f32x4 gv = *(const f32x4*)(lg + cc), bv = *(const f32x4*)(lb + cc);
                const f32x4 o = y[j] * rstd * gv + bv;
                u32x2 hb; hb.x = pg8::cvt_pk_bf16(o.x, o.y); hb.y = pg8::cvt_pk_bf16(o.z, o.w); *(u32x2*)(x1b + ro + cc) = hb;
                u32x2 lw; lw.x = pg8::cvt_pk_bf16(o.x - __uint_as_float(hb.x << 16), o.y - __uint_as_float(hb.x & 0xffff0000u)); lw.y = pg8::cvt_pk_bf16(o.z - __uint_as_float(hb.y << 16), o.w - __uint_as_float(hb.y & 0xffff0000u));
                *(LAS u32x2*)(ring + O_XH + (2 * wave + r) * XT_ST + cc * 2) = hb; *(LAS u32x2*)(ring + O_XL + (2 * wave + r) * XT_ST + cc * 2) = lw; }
        }
        asm volatile("s_waitcnt lgkmcnt(0)" ::: "memory"); __builtin_amdgcn_s_barrier(); asm volatile("" ::: "memory");
        if (sweep + 1 < nsw) {
#pragma unroll
            for (int r = 0; r < 2; ++r)
#pragma unroll
                for (int j = 0; j < 4; ++j) { const size_t o = (size_t)(t + nrow + r) * DM + 4 * lane + 256 * j; ra[r][j] = *(const u32x2*)(xb_in + o); rm[r][j] = *(const u32x2*)(mix + o); }
        }
        f32x4 cacc[2] = {(f32x4){0.f, 0.f, 0.f, 0.f}, (f32x4){0.f, 0.f, 0.f, 0.f}};
        { LAS const unsigned char* ap = ring + fr * XT_ST + (128 * wave + 8 * fq) * 2;
#pragma unroll
          for (int ks = 0; ks < 4; ++ks) { const bf16x8 ah = *(LAS const bf16x8*)(ap + O_XH + 64 * ks), al = *(LAS const bf16x8*)(ap + O_XL + 64 * ks);
#pragma unroll
              for (int nt = 0; nt < 2; ++nt) { cacc[nt] = __builtin_amdgcn_mfma_f32_16x16x32_bf16(ah, bh[ks][nt], cacc[nt], 0, 0, 0); cacc[nt] = __builtin_amdgcn_mfma_f32_16x16x32_bf16(al, bh[ks][nt], cacc[nt], 0, 0, 0);
                  cacc[nt] = __builtin_amdgcn_mfma_f32_16x16x32_bf16(ah, bl[ks][nt], cacc[nt], 0, 0, 0); } } }
        { LAS float* pt = (LAS float*)(ring + O_PT) + (wave * 16 + 4 * fq) * PT_ST + fr;
#pragma unroll
          for (int nt = 0; nt < 2; ++nt)
#pragma unroll
              for (int i = 0; i < 4; ++i) pt[i * PT_ST + 16 * nt] = cacc[nt][i]; }
        asm volatile("s_waitcnt lgkmcnt(0)" ::: "memory"); __builtin_amdgcn_s_barrier(); asm volatile("" ::: "memory");
        const int e = lane & 31;
        float vcur;
        { LAS const float* pt = (LAS const float*)(ring + O_PT) + (2 * wave + (lane >> 5)) * PT_ST + e; float v = 0.f;
#pragma unroll
          for (int w = 0; w < 8; ++w) v += pt[w * 16 * PT_ST];
          vcur = v + rbv; }
        float topv[4]; int topi[4];
#pragma unroll
        for (int kk = 0; kk < 4; ++kk) {
            float m = vcur;
            m = fmaxf(m, dpp_f<0xB1>(m)); m = fmaxf(m, dpp_f<0x4E>(m)); m = fmaxf(m, dpp_f<0x141>(m)); m = fmaxf(m, dpp_f<0x140>(m));
            const float h0 = fmaxf(lane_f(m, 0), lane_f(m, 16)), h1 = fmaxf(lane_f(m, 32), lane_f(m, 48));
            const float mx = lane < 32 ? h0 : h1;
            const unsigned long long bal = __ballot(vcur == mx);
            const int i0 = __builtin_ctz((unsigned)bal), i1 = __builtin_ctz((unsigned)(bal >> 32));
            const int bi = lane < 32 ? i0 : i1;
            topv[kk] = mx; topi[kk] = bi; if (e == bi) vcur = -INFINITY;
        }
        const float e1 = __expf(topv[1] - topv[0]), e2 = __expf(topv[2] - topv[0]), e3 = __expf(topv[3] - topv[0]);
        const float inv = 1.0f / (1.0f + e1 + e2 + e3);
        if (e < 4) {
            const int ee = e == 0 ? topi[0] : e == 1 ? topi[1] : e == 2 ? topi[2] : topi[3];
            const float gg = (e == 0 ? 1.0f : e == 1 ? e1 : e == 2 ? e2 : e3) * inv;
            const int sl = (16 * sweep + 2 * wave + (lane >> 5)) * 4 + e;
            rt_e[sl] = ee; rt_g[sl] = gg; rt_p[sl] = (int)__hip_atomic_fetch_add((LAS unsigned*)(rt_c + ee), 1u, __ATOMIC_RELAXED, __HIP_MEMORY_SCOPE_WORKGROUP);
        }
    }
}
__device__ __forceinline__ void ln2_row(int t, int lane, const bf16_t* __restrict__ x1b, const bf16_t* __restrict__ yb, const float* __restrict__ gates, const float* __restrict__ lg, const float* __restrict__ lb,
                                        bf16_t* __restrict__ x2b) {
    const float g0 = gates[t * 4], g1 = gates[t * 4 + 1], g2 = gates[t * 4 + 2], g3 = gates[t * 4 + 3];
    f32x4 y[4]; float s = 0.f;
#pragma unroll
    for (int j = 0; j < 4; ++j) { const int c = 4 * lane + 256 * j; const u32x2 aw = __builtin_nontemporal_load((const u32x2*)(x1b + (size_t)t * DM + c)); const f32x4 a = (f32x4){bf2f(aw.x & 0xffffu), bf2f(aw.x >> 16), bf2f(aw.y & 0xffffu), bf2f(aw.y >> 16)};
        f32x4 f = (f32x4){0.f, 0.f, 0.f, 0.f};
#pragma unroll
        for (int kk = 0; kk < 4; ++kk) { const u32x2 w = __builtin_nontemporal_load((const u32x2*)(yb + (size_t)(t * 4 + kk) * DM + c)); const float gk = kk == 0 ? g0 : kk == 1 ? g1 : kk == 2 ? g2 : g3;
            f.x += gk * bf2f(w.x & 0xffffu); f.y += gk * bf2f(w.x >> 16); f.z += gk * bf2f(w.y & 0xffffu); f.w += gk * bf2f(w.y >> 16); }
        y[j] = a * DN_ALPHA + f; s += (y[j].x + y[j].y) + (y[j].z + y[j].w); }
    const float mean = wave_sum(s) * (1.0f / DM); float s2 = 0.f;
#pragma unroll
    for (int j = 0; j < 4; ++j) { y[j] = y[j] - mean; s2 += (y[j].x * y[j].x + y[j].y * y[j].y) + (y[j].z * y[j].z + y[j].w * y[j].w); }
    const float rstd = 1.0f / sqrtf(wave_sum(s2) * (1.0f / DM) + LN_EPS);
#pragma unroll
    for (int j = 0; j < 4; ++j) { const int c = 4 * lane + 256 * j; const f32x4 gv = *(const f32x4*)(lg + c), bv = *(const f32x4*)(lb + c);
        const f32x4 o = y[j] * rstd * gv + bv;
        u32x2 pb; pb.x = pk2(o.x, o.y); pb.y = pk2(o.z, o.w); *(u32x2*)(x2b + (size_t)t * DM + c) = pb; }
}
__device__ __forceinline__ void ln2_row2(int ta, int tb, int lane, const bf16_t* __restrict__ x1b, const bf16_t* __restrict__ yb, const float* __restrict__ gates, const float* __restrict__ lg, const float* __restrict__ lb,
                                         bf16_t* __restrict__ x2b) {
    u32x2 xa[2][4], ya[2][4][4]; float gk[2][4];
#pragma unroll
    for (int r = 0; r < 2; ++r) { const int t = r ? tb : ta;
#pragma unroll
        for (int kk = 0; kk < 4; ++kk) gk[r][kk] = gates[t * 4 + kk];
#pragma unroll
        for (int j = 0; j < 4; ++j) { const int c = 4 * lane + 256 * j; xa[r][j] = __builtin_nontemporal_load((const u32x2*)(x1b + (size_t)t * DM + c));
#pragma unroll
            for (int kk = 0; kk < 4; ++kk) ya[r][j][kk] = __builtin_nontemporal_load((const u32x2*)(yb + (size_t)(t * 4 + kk) * DM + c)); } }
    __builtin_amdgcn_sched_barrier(0);
#pragma unroll
    for (int r = 0; r < 2; ++r) { const int t = r ? tb : ta;
        f32x4 y[4]; float s = 0.f;
#pragma unroll
        for (int j = 0; j < 4; ++j) { const u32x2 aw = xa[r][j]; const f32x4 a = (f32x4){bf2f(aw.x & 0xffffu), bf2f(aw.x >> 16), bf2f(aw.y & 0xffffu), bf2f(aw.y >> 16)};
            f32x4 f = (f32x4){0.f, 0.f, 0.f, 0.f};
#pragma unroll
            for (int kk = 0; kk < 4; ++kk) { const u32x2 w = ya[r][j][kk]; const float g = gk[r][kk];
                f.x += g * bf2f(w.x & 0xffffu); f.y += g * bf2f(w.x >> 16); f.z += g * bf2f(w.y & 0xffffu); f.w += g * bf2f(w.y >> 16); }
            y[j] = a * DN_ALPHA + f; s += (y[j].x + y[j].y) + (y[j].z + y[j].w); }
        const float mean = wave_sum(s) * (1.0f / DM); float s2 = 0.f;
#pragma unroll
        for (int j = 0; j < 4; ++j) { y[j] = y[j] - mean; s2 += (y[j].x * y[j].x + y[j].y * y[j].y) + (y[j].z * y[j].z + y[j].w * y[j].w); }
        const float rstd = 1.0f / sqrtf(wave_sum(s2) * (1.0f / DM) + LN_EPS);
#pragma unroll
        for (int j = 0; j < 4; ++j) { const int c = 4 * lane + 256 * j; const f32x4 gv = *(const f32x4*)(lg + c), bv = *(const f32x4*)(lb + c);
            const f32x4 o = y[j] * rstd * gv + bv;
            u32x2 pb; pb.x = pk2(o.x, o.y); pb.y = pk2(o.z, o.w); *(u32x2*)(x2b + (size_t)t * DM + c) = pb; }
    }
}
typedef _Float16 f16x8 __attribute__((ext_vector_type(8)));
typedef _Float16 f16x2 __attribute__((ext_vector_type(2)));
typedef float f32x16 __attribute__((ext_vector_type(16)));
typedef short s16x4 __attribute__((ext_vector_type(4)));
__device__ __forceinline__ s16x4 lds_tr16(LAS const unsigned char* p) { return __builtin_bit_cast(s16x4, __builtin_amdgcn_ds_read_tr16_b64_v4i16((LAS s16x4*)p)); }
__device__ __forceinline__ bf16x8 cat4(s16x4 a, s16x4 b) { return __builtin_shufflevector(a, b, 0, 1, 2, 3, 4, 5, 6, 7); }
__device__ __forceinline__ unsigned cvtpk_c(float lo, float hi) { return pg8::cvt_pk_bf16(lo, hi); }
__device__ __forceinline__ float fexp2(float x) { return __builtin_amdgcn_exp2f(x); }
__device__ __forceinline__ float flog2(float x) { return __builtin_amdgcn_logf(x); }

namespace sb {
constexpr int KST = 144, SUB_B = 32 * KST, SLOT_B = 2 * SUB_B, NSLOT_R = 10;
__device__ __forceinline__ void attn_phase(LAS unsigned char* lds, const bf16_t* __restrict__ Q, const bf16_t* __restrict__ K, const bf16_t* __restrict__ V, bf16_t* __restrict__ O, int G, int c) {
    int tid = threadIdx.x; asm volatile("" : "+v"(tid));
    const int wid = __builtin_amdgcn_readfirstlane(tid >> 6), lane = tid & 63, n = lane & 31, hi = lane >> 5;
    f16x8 U0, U1, ONE;
#pragma unroll
    for (int j = 0; j < 8; ++j) { const int jp = 8 * (j >> 2) + 4 * hi + (j & 3); U0[j] = (jp > n) ? (_Float16)1.0f : (_Float16)0.0f; U1[j] = (16 + jp > n) ? (_Float16)1.0f : (_Float16)0.0f; ONE[j] = (_Float16)1.0f; }
    const int half = tid >> 8, srow = (tid & 255) >> 3, sch = tid & 7;
    const int trq = (lane & 15) >> 2, trp = lane & 3, blk = (lane >> 4) & 1;
    LAS unsigned* flg = (LAS unsigned*)(lds + NSLOT_R * SLOT_B);
    for (int it = 0;; ++it) {
        const int L = it * G + c; if (L >= NB * SH * 8) break;
        const int bh = L >> 3, qp = L & 7, qb = ((L >> 8) & 1) ? 7 - qp : qp, b = bh >> 4, h = bh & 15;
        const size_t rowbase = (size_t)b * SEQ;
        const int q0 = qb * 256 + wid * 32;
        bf16x8 qf[4];
        { const bf16_t* qrow = Q + (rowbase + q0 + n) * DM + h * SD + 8 * hi;
#pragma unroll
          for (int ks = 0; ks < 4; ++ks) qf[ks] = *(const bf16x8*)(qrow + 16 * ks); }
        f32x16 o0, o1, carry;
#pragma unroll
        for (int r = 0; r < 16; ++r) { o0[r] = 0.f; o1[r] = 0.f; carry[r] = 0.f; }
        const bf16_t* sg = (half ? V : K) + (rowbase + srow) * DM + h * SD + sch * 8;
        const int soff = half * SUB_B + srow * KST + sch * 16;
        { u32x4 r[9];
#pragma unroll
          for (int x = 0; x < 9; ++x) { const int g = 8 * qb + 7 - x; if (g >= 0) r[x] = *(const u32x4*)(sg + (size_t)g * 32 * DM); }
#pragma unroll
          for (int x = 0; x < 9; ++x) { const int g = 8 * qb + 7 - x; if (g >= 0) *(LAS u32x4*)(lds + (g % NSLOT_R) * SLOT_B + soff) = r[x]; } }
        asm volatile("s_waitcnt lgkmcnt(0)" ::: "memory"); __builtin_amdgcn_s_barrier(); asm volatile("" ::: "memory");
        int par = 0, j = 0;
        for (;; ++j) {
            const int gpre = 8 * qb - j - 2;
            u32x4 pr; if (gpre >= 0) pr = *(const u32x4*)(sg + (size_t)gpre * 32 * DM);
            const int g = 8 * qb + wid - j;
            int fin;
            {
                const bool diag = (j == 0);
                LAS const unsigned char* kb = lds + (g % NSLOT_R) * SLOT_B; LAS const unsigned char* vb = kb + SUB_B;
                f32x16 z;
#pragma unroll
                for (int r = 0; r < 16; ++r) z[r] = 0.f;
                { LAS const unsigned char* kp = kb + n * KST + hi * 16;
#pragma unroll
                  for (int ks = 0; ks < 4; ++ks) { const bf16x8 kf = *(LAS const bf16x8*)(kp + ks * 32); z = __builtin_amdgcn_mfma_f32_32x32x16_bf16(kf, qf[ks], z, 0, 0, 0); } }
                f16x8 lf0, lf1;
                { f32x16 t, mx;
#pragma unroll
                  for (int r = 0; r < 16; ++r) t[r] = fexp2(-fabsf(z[r]));
                  t = t + 1.0f;
#pragma unroll
                  for (int r = 0; r < 16; ++r) { t[r] = flog2(t[r]); mx[r] = __builtin_amdgcn_fmed3f(z[r], 0.f, 3.0e38f); }
                  f32x16 l = (-mx) - t;
                  z = z + l;
                  if (diag) {
#pragma unroll
                      for (int r = 0; r < 16; ++r) { const bool valid = ((r & 3) + 8 * (r >> 2) + 4 * hi) < n; l[r] = valid ? l[r] : 0.f; z[r] = valid ? z[r] : -INFINITY; } }
                  unsigned hw[8];
#pragma unroll
                  for (int r2 = 0; r2 < 8; ++r2) { const pg8::f32x2_t pr2 = {l[2 * r2], l[2 * r2 + 1]}; hw[r2] = __builtin_bit_cast(unsigned, __builtin_convertvector(pr2, f16x2)); }
                  lf0 = __builtin_bit_cast(f16x8, (u32x4){hw[0], hw[1], hw[2], hw[3]}); lf1 = __builtin_bit_cast(f16x8, (u32x4){hw[4], hw[5], hw[6], hw[7]}); }
                f32x16 y = carry;
                y = __builtin_amdgcn_mfma_f32_32x32x16_f16(U0, lf0, y, 0, 0, 0); y = __builtin_amdgcn_mfma_f32_32x32x16_f16(U1, lf1, y, 0, 0, 0);
                carry = __builtin_amdgcn_mfma_f32_32x32x16_f16(ONE, lf0, carry, 0, 0, 0); carry = __builtin_amdgcn_mfma_f32_32x32x16_f16(ONE, lf1, carry, 0, 0, 0);
                bf16x8 pf0, pf1;
                { unsigned w[8]; const f32x16 zy = z + y;
#pragma unroll
                  for (int r2 = 0; r2 < 8; ++r2) w[r2] = cvtpk_c(fexp2(zy[2 * r2]), fexp2(zy[2 * r2 + 1]));
                  pf0 = __builtin_bit_cast(bf16x8, (u32x4){w[0], w[1], w[2], w[3]}); pf1 = __builtin_bit_cast(bf16x8, (u32x4){w[4], w[5], w[6], w[7]}); }
                LAS const unsigned char* vp = vb + (4 * hi + trq) * KST + (16 * blk + 4 * trp) * 2;
#pragma unroll
                for (int s = 0; s < 2; ++s) {
                    const bf16x8 va = cat4(lds_tr16(vp + (16 * s) * KST), lds_tr16(vp + (16 * s + 8) * KST));
                    const bf16x8 vc = cat4(lds_tr16(vp + (16 * s) * KST + 64), lds_tr16(vp + (16 * s + 8) * KST + 64));
                    o0 = __builtin_amdgcn_mfma_f32_32x32x16_bf16(va, s ? pf1 : pf0, o0, 0, 0, 0);
                    o1 = __builtin_amdgcn_mfma_f32_32x32x16_bf16(vc, s ? pf1 : pf0, o1, 0, 0, 0);
                }
                fin = (__all(carry[0] < -160.0f) || g == 0) ? 1 : 0;
            }
            if (lane == 0) flg[par * 8 + wid] = (unsigned)fin;
            if (gpre >= 0) *(LAS u32x4*)(lds + (gpre % NSLOT_R) * SLOT_B + soff) = pr;
            asm volatile("s_waitcnt lgkmcnt(0)" ::: "memory"); __builtin_amdgcn_s_barrier(); asm volatile("" ::: "memory");
            par ^= 1;
            if (fin) { ++j; break; }
        }
        bf16_t* orow = O + (rowbase + q0 + n) * DM + h * SD + 4 * hi;
#pragma unroll
        for (int g4 = 0; g4 < 4; ++g4) {
            u32x2 w0, w1; w0.x = pg8::cvt_pk_bf16(o0[4 * g4], o0[4 * g4 + 1]); w0.y = pg8::cvt_pk_bf16(o0[4 * g4 + 2], o0[4 * g4 + 3]);
            w1.x = pg8::cvt_pk_bf16(o1[4 * g4], o1[4 * g4 + 1]); w1.y = pg8::cvt_pk_bf16(o1[4 * g4 + 2], o1[4 * g4 + 3]);
            *(u32x2*)(orow + 8 * g4) = w0; *(u32x2*)(orow + 32 + 8 * g4) = w1; }
        for (;; ++j) {
            { const unsigned f = lane < 8 ? flg[(par ^ 1) * 8 + lane] : 1u; if (__all(f != 0u)) break; }
            const int gpre = 8 * qb - j - 2;
            u32x4 pr; if (gpre >= 0) pr = *(const u32x4*)(sg + (size_t)gpre * 32 * DM);
            if (lane == 0) flg[par * 8 + wid] = 1u;
            if (gpre >= 0) *(LAS u32x4*)(lds + (gpre % NSLOT_R) * SLOT_B + soff) = pr;
            asm volatile("s_waitcnt lgkmcnt(0)" ::: "memory"); __builtin_amdgcn_s_barrier(); asm volatile("" ::: "memory");
            par ^= 1;
        }
        asm volatile("s_waitcnt lgkmcnt(0)" ::: "memory"); __builtin_amdgcn_s_barrier(); asm volatile("" ::: "memory");
    }
}
}

namespace ret {
constexpr int QST = 528, VST = 144;
constexpr int O_Q = 0, O_K = 64 * QST, O_ST = 2 * 64 * QST, O_V = 3 * 64 * QST, O_VD = O_V + 64 * VST, O_P = O_VD + 64 * VST, LDS_END = O_P + 64 * VST;
static_assert(LDS_END <= 131072, "retention LDS");
__device__ __forceinline__ void scan_phase(LAS unsigned char* lds, const bf16_t* __restrict__ Q, const bf16_t* __restrict__ K, const bf16_t* __restrict__ V, bf16_t* __restrict__ RO, int G, int c, const float* __restrict__ cw, bf16_t* __restrict__ cwt) {
    int tid = threadIdx.x; asm volatile("" : "+v"(tid));
    const int wid = __builtin_amdgcn_readfirstlane(tid >> 6), lane = tid & 63, lr = lane & 15, g = lane >> 4;
    const int trq = (lane & 15) >> 2, trp = lane & 3;
    const int tqt = wid >> 1, e2 = 2 * (wid & 1);
    for (int it = 0;; ++it) {
        const int L = it * G + c; if (L >= NB * RH * 8) break;
        const int bh = (L & 7) * 4 + (L >> 6), es = (L >> 3) & 7, b = bh >> 2, h = bh & 3;
        const size_t rowbase = (size_t)b * SEQ;
        const float lg2 = flog2(1.0f - fexp2(-5.0f - (float)h));
        const float cdec = fexp2(lg2 * 64.0f);
        f32x4 S[2][4];
#pragma unroll
        for (int a = 0; a < 2; ++a)
#pragma unroll
            for (int e = 0; e < 4; ++e) S[a][e] = (f32x4){0.f, 0.f, 0.f, 0.f};
        const bf16_t* qg = Q + (rowbase + (tid >> 5)) * DM + h * RDK + (tid & 31) * 8; const bf16_t* kg = K + (rowbase + (tid >> 5)) * DM + h * RDK + (tid & 31) * 8;
        const bf16_t* vg = V + (rowbase + (tid >> 3)) * RHV + h * RDV + es * 64 + (tid & 7) * 8;
        const int sq = (tid >> 5) * QST + (tid & 31) * 16, sv = (tid >> 3) * VST + (tid & 7) * 16;
        const float kdv = fexp2(lg2 * (float)(63 - (tid >> 3)));
        u32x4 rq[4], rk[4], rv;
#pragma unroll
        for (int i = 0; i < 4; ++i) { rq[i] = *(const u32x4*)(qg + (size_t)(16 * i) * DM); rk[i] = *(const u32x4*)(kg + (size_t)(16 * i) * DM); }
        rv = *(const u32x4*)vg;
        __builtin_amdgcn_s_barrier();
        for (int ci = 0; ci < SEQ / 64; ++ci) {
#pragma unroll
            for (int i = 0; i < 4; ++i) { *(LAS u32x4*)(lds + O_Q + sq + 16 * i * QST) = rq[i]; *(LAS u32x4*)(lds + O_K + sq + 16 * i * QST) = rk[i]; }
            { *(LAS u32x4*)(lds + O_V + sv) = rv;
              u32x4 d; d.x = pk2(bf2f(rv.x & 0xffffu) * kdv, bf2f(rv.x >> 16) * kdv); d.y = pk2(bf2f(rv.y & 0xffffu) * kdv, bf2f(rv.y >> 16) * kdv);
              d.z = pk2(bf2f(rv.z & 0xffffu) * kdv, bf2f(rv.z >> 16) * kdv); d.w = pk2(bf2f(rv.w & 0xffffu) * kdv, bf2f(rv.w >> 16) * kdv);
              *(LAS u32x4*)(lds + O_VD + sv) = d; }
#pragma unroll
            for (int a = 0; a < 2; ++a)
#pragma unroll
                for (int e = 0; e < 4; ++e) { u32x2 w; w.x = pg8::cvt_pk_bf16(S[a][e][0], S[a][e][1]); w.y = pg8::cvt_pk_bf16(S[a][e][2], S[a][e][3]);
                    *(LAS u32x2*)(lds + O_ST + (16 * e + lr) * QST + (32 * wid + 16 * a + 4 * g) * 2) = w; }
            asm volatile("s_waitcnt lgkmcnt(0)" ::: "memory"); __builtin_amdgcn_s_barrier(); asm volatile("" ::: "memory");
            if (ci + 1 < SEQ / 64) {
#pragma unroll
                for (int i = 0; i < 4; ++i) { rq[i] = *(const u32x4*)(qg + (size_t)((ci + 1) * 64 + 16 * i) * DM); rk[i] = *(const u32x4*)(kg + (size_t)((ci + 1) * 64 + 16 * i) * DM); }
                rv = *(const u32x4*)(vg + (size_t)(ci + 1) * 64 * RHV);
            }
            float cv[16]; size_t cdst = 0;
            if (cw) { const int item = (L * 8 + wid) * 8 + (ci >> 2), sub = ci & 3, m = item >> 9, kb = (item >> 5) & 15, nb = item & 31;
                const float* su = cw + ((size_t)m * DM + kb * 64) * (2 * DF) + nb * 64 + sub * 16;
                const int lo = (lane >> 4) * 16 * (2 * DF) + (lane & 15);
#pragma unroll
                for (int j = 0; j < 16; ++j) { const float* sj = su + (size_t)j * (2 * DF); asm volatile("" : "+s"(sj)); cv[j] = ((const GAS float*)sj)[lo]; }
                cdst = ((size_t)m * 2 * DF + nb * 64 + sub * 16 + (lane & 15)) * DM + kb * 64 + (lane >> 4) * 16; }
            f32x4 pacc[2], oacc[2];
#pragma unroll
            for (int x = 0; x < 2; ++x) { pacc[x] = (f32x4){0.f, 0.f, 0.f, 0.f}; oacc[x] = (f32x4){0.f, 0.f, 0.f, 0.f}; }
            { LAS const unsigned char* qp = lds + O_Q + (16 * tqt + lr) * QST + 16 * g;
              LAS const unsigned char* kp = lds + O_K + (16 * e2 + lr) * QST + 16 * g;
              LAS const unsigned char* sp = lds + O_ST + (16 * e2 + lr) * QST + 16 * g;
#pragma unroll
              for (int ks = 0; ks < 8; ++ks) {
                  const bf16x8 qa = *(LAS const bf16x8*)(qp + 64 * ks);
                  const bf16x8 k0 = *(LAS const bf16x8*)(kp + 64 * ks), k1 = *(LAS const bf16x8*)(kp + 16 * QST + 64 * ks);
                  const bf16x8 s0 = *(LAS const bf16x8*)(sp + 64 * ks), s1 = *(LAS const bf16x8*)(sp + 16 * QST + 64 * ks);
                  pacc[0] = __builtin_amdgcn_mfma_f32_16x16x32_bf16(k0, qa, pacc[0], 0, 0, 0); pacc[1] = __builtin_amdgcn_mfma_f32_16x16x32_bf16(k1, qa, pacc[1], 0, 0, 0);
                  oacc[0] = __builtin_amdgcn_mfma_f32_16x16x32_bf16(s0, qa, oacc[0], 0, 0, 0); oacc[1] = __builtin_amdgcn_mfma_f32_16x16x32_bf16(s1, qa, oacc[1], 0, 0, 0);
              } }
#pragma unroll
            for (int x = 0; x < 2; ++x) { float pv[4];
#pragma unroll
                for (int i = 0; i < 4; ++i) { const int dist = (16 * tqt + lr) - (16 * (e2 + x) + 4 * g + i); pv[i] = pacc[x][i] * fexp2(lg2 * fabsf((float)dist)); }
                u32x2 w; w.x = pg8::cvt_pk_bf16(pv[0], pv[1]); w.y = pg8::cvt_pk_bf16(pv[2], pv[3]);
                *(LAS u32x2*)(lds + O_P + (16 * tqt + lr) * VST + (16 * (e2 + x) + 4 * g) * 2) = w; }
            { const float qd = fexp2(lg2 * (float)(16 * tqt + lr + 1)); oacc[0] = oacc[0] * qd; oacc[1] = oacc[1] * qd; }
            asm volatile("s_waitcnt lgkmcnt(0)" ::: "memory"); __builtin_amdgcn_s_barrier(); asm volatile("" ::: "memory");
            { LAS const unsigned char* pp = lds + O_P + (16 * tqt + lr) * VST + 16 * g;
              LAS const unsigned char* vp = lds + O_V + (8 * g + trq) * VST + (16 * e2 + 4 * trp) * 2;
#pragma unroll
              for (int ks = 0; ks < 2; ++ks) {
                  const bf16x8 pa = *(LAS const bf16x8*)(pp + 64 * ks);
                  const bf16x8 v0 = cat4(lds_tr16(vp + (32 * ks) * VST), lds_tr16(vp + (32 * ks + 4) * VST));
                  const bf16x8 v1 = cat4(lds_tr16(vp + (32 * ks) * VST + 32), lds_tr16(vp + (32 * ks + 4) * VST + 32));
                  oacc[0] = __builtin_amdgcn_mfma_f32_16x16x32_bf16(v0, pa, oacc[0], 0, 0, 0); oacc[1] = __builtin_amdgcn_mfma_f32_16x16x32_bf16(v1, pa, oacc[1], 0, 0, 0);
              } }
            { bf16_t* op = RO + (rowbase + ci * 64 + 16 * tqt + lr) * RHV + h * RDV + es * 64 + 16 * e2 + 4 * g;
#pragma unroll
              for (int x = 0; x < 2; ++x) { u32x2 w; w.x = pk2(oacc[x][0], oacc[x][1]); w.y = pk2(oacc[x][2], oacc[x][3]); *(u32x2*)(op + 16 * x) = w; } }
#pragma unroll
            for (int a = 0; a < 2; ++a)
#pragma unroll
                for (int e = 0; e < 4; ++e) S[a][e] = S[a][e] * cdec;
            { LAS const unsigned char* ktp = lds + O_K + (8 * g + trq) * QST + (32 * wid + 4 * trp) * 2;
              LAS const unsigned char* vtp = lds + O_VD + (8 * g + trq) * VST + (4 * trp) * 2;
#pragma unroll
              for (int ks = 0; ks < 2; ++ks) {
                  bf16x8 ka[2], vb[4];
#pragma unroll
                  for (int a = 0; a < 2; ++a) ka[a] = cat4(lds_tr16(ktp + (32 * ks) * QST + 32 * a), lds_tr16(ktp + (32 * ks + 4) * QST + 32 * a));
#pragma unroll
                  for (int e = 0; e < 4; ++e) vb[e] = cat4(lds_tr16(vtp + (32 * ks) * VST + 32 * e), lds_tr16(vtp + (32 * ks + 4) * VST + 32 * e));
#pragma unroll
                  for (int a = 0; a < 2; ++a)
#pragma unroll
                      for (int e = 0; e < 4; ++e) S[a][e] = __builtin_amdgcn_mfma_f32_16x16x32_bf16(ka[a], vb[e], S[a][e], 0, 0, 0);
              } }
            if (cw) { u32x4 w0, w1; w0.x = pk2(cv[0], cv[1]); w0.y = pk2(cv[2], cv[3]); w0.z = pk2(cv[4], cv[5]); w0.w = pk2(cv[6], cv[7]);
                w1.x = pk2(cv[8], cv[9]); w1.y = pk2(cv[10], cv[11]); w1.z = pk2(cv[12], cv[13]); w1.w = pk2(cv[14], cv[15]);
                *(u32x4*)(cwt + cdst) = w0; *(u32x4*)(cwt + cdst + 8) = w1; }
            asm volatile("s_waitcnt lgkmcnt(0)" ::: "memory"); __builtin_amdgcn_s_barrier(); asm volatile("" ::: "memory");
        }
    }
}
__device__ __forceinline__ void gate_row(int w, int lane, const bf16_t* __restrict__ ro, const bf16_t* __restrict__ g, bf16_t* __restrict__ gn) {
    const u32x4 rw = __builtin_nontemporal_load((const u32x4*)(ro + (size_t)w * RDV + 8 * lane)), gw = __builtin_nontemporal_load((const u32x4*)(g + (size_t)w * RDV + 8 * lane));
    float xv[8] = {bf2f(rw.x & 0xffffu), bf2f(rw.x >> 16), bf2f(rw.y & 0xffffu), bf2f(rw.y >> 16), bf2f(rw.z & 0xffffu), bf2f(rw.z >> 16), bf2f(rw.w & 0xffffu), bf2f(rw.w >> 16)};
    float gv[8] = {bf2f(gw.x & 0xffffu), bf2f(gw.x >> 16), bf2f(gw.y & 0xffffu), bf2f(gw.y >> 16), bf2f(gw.z & 0xffffu), bf2f(gw.z >> 16), bf2f(gw.w & 0xffffu), bf2f(gw.w >> 16)};
    float s = 0.f;
#pragma unroll
    for (int j = 0; j < 8; ++j) s += xv[j];
    const float mean = wave_sum(s) * (1.0f / RDV); float s2 = 0.f;
#pragma unroll
    for (int j = 0; j < 8; ++j) { xv[j] -= mean; s2 += xv[j] * xv[j]; }
    const float rstd = 1.0f / sqrtf(wave_sum(s2) * (1.0f / RDV) + GN_EPS);
    unsigned wv[4];
#pragma unroll
    for (int j = 0; j < 4; ++j) { const float g0 = gv[2 * j], g1 = gv[2 * j + 1];
        wv[j] = pg8::cvt_pk_bf16(g0 * __builtin_amdgcn_rcpf(1.0f + __expf(-g0)) * (xv[2 * j] * rstd), g1 * __builtin_amdgcn_rcpf(1.0f + __expf(-g1)) * (xv[2 * j + 1] * rstd)); }
    *(u32x4*)(gn + (size_t)w * RDV + 8 * lane) = (u32x4){wv[0], wv[1], wv[2], wv[3]};
}
}
struct Args { const float* in[19]; float* out; unsigned char* ws; int ph_lo, ph_hi, bar_region, pad; };
#define CAS __attribute__((address_space(4)))
#define PHASE_ARGS() const CAS Args* ka = (const CAS Args*)__builtin_amdgcn_kernarg_segment_ptr(); asm volatile("" : "+s"(ka) :: "memory"); unsigned char* const ws = ka->ws; (void)ws; int ptid = threadIdx.x; asm volatile("" : "+v"(ptid)); const int lane = ptid & 63, wave = __builtin_amdgcn_readfirstlane(ptid >> 6); (void)lane; (void)wave
#define WSP(type, off) ((type*)(ws + (off)))
#ifndef PH_MASK
#define PH_MASK 0xffff
#endif
#define ON(b) ((PH_MASK >> (b)) & 1)
#ifndef REP_MASK
#define REP_MASK 0
#endif
#define REP(b) _Pragma("unroll 1") for (int rep_ = 0; rep_ < 1 + ((REP_MASK >> (b)) & 1); ++rep_)
__global__ void __launch_bounds__(NWAVES * 64, 2) mega(Args args) {
    extern __shared__ __attribute__((aligned(16))) unsigned char lds_raw[];
    LAS unsigned char* lds = (LAS unsigned char*)lds_raw;
    const int tid = threadIdx.x;
    const int G = gridDim.x;
    for (int u = tid; u < (LDS_BYTES - LDSCTL_OFF) / 4; u += NWAVES * 64) ((LAS unsigned*)(lds + LDSCTL_OFF))[u] = 0u;
    __syncthreads();
    XcdBarrier bar = xcd_barrier_post((unsigned*)(args.ws + OFF_CTL) + CW_BAR + args.bar_region * XCD_BAR_WORDS, (volatile LAS unsigned*)(lds + MISC_OFF) + 8);
    const int lo = args.ph_lo, hi = args.ph_hi;
#define IN(k) (lo <= (k) && (k) < hi)
#define SEAM(k) do { if (IN(k) && IN((k) + 1)) xcd_barrier(bar); } while (0)

    REP(0) if (ON(0) && IN(0)) {
        PHASE_ARGS();
        LAS float* scr = (LAS float*)(lds + RING_OFF + wave * 16384);
        const int gw = blockIdx.x * NWAVES + wave, ngw = G * NWAVES;
        p0_transpose_all(ka->in[2], WSP(bf16_t, OFF_WRI), 2, DM, RIN, scr, gw, ngw, lane);
        p0_transpose_all(ka->in[3], WSP(bf16_t, OFF_WRO), 2, RHV, DM, scr, gw, ngw, lane);
        p0_transpose_all(ka->in[4], WSP(bf16_t, OFF_WSI), 2, DM, 3 * DM, scr, gw, ngw, lane);
        p0_transpose_all(ka->in[5], WSP(bf16_t, OFF_WSO), 2, DM, DM, scr, gw, ngw, lane);
        p0_transpose_all(ka->in[17], WSP(bf16_t, OFF_WPG), 4, DM, DM, scr, gw, ngw, lane);
        p0_transpose_all(ka->in[16], WSP(bf16_t, OFF_WPW), 4, DPLE, DM, scr, gw, ngw, lane);
        p0_transpose_all(ka->in[10], WSP(bf16_t, OFF_WGU), NE, DM, 2 * DF, scr, gw, ngw, lane);
        p0_transpose_all(ka->in[12], WSP(bf16_t, OFF_WDN), NE, DF, DM, scr, gw, ngw, lane);
        const size_t gt = (size_t)blockIdx.x * (NWAVES * 64) + ptid, ngt = (size_t)G * NWAVES * 64;
        { const f32x4* x = (const f32x4*)ka->in[0]; u32x2* xb = WSP(u32x2, OFF_XB);
          for (size_t i = gt; i < (size_t)T * DM / 4; i += ngt) { const f32x4 v = x[i]; u32x2 o; o.x = pk2(v.x, v.y); o.y = pk2(v.z, v.w); xb[i] = o; } }
        { const f32x4* p = (const f32x4*)ka->in[1]; u32x2* pb = WSP(u32x2, OFF_PB);
          for (size_t i = gt; i < (size_t)4 * T * DPLE / 4; i += ngt) { const f32x4 v = p[i]; u32x2 o; o.x = pk2(v.x, v.y); o.y = pk2(v.z, v.w); pb[i] = o; } }
    }
    SEAM(0);
#pragma unroll 1
    for (int i = 0; i < DEPTH; ++i) {
        const int pb = 2 + 10 * i, j = i >> 1;
        if (IN(pb)) {
            REP(2) if (ON(2) && (i & 1) == 0) {
                PHASE_ARGS();
                pg8::DenseOrder S; S.init(T, RIN, DM, G, (int)blockIdx.x, WSP(bf16_t, OFF_XB), WSP(bf16_t, OFF_WRI) + (size_t)j * RIN * DM);
                if (ptid < 128) ((LAS float*)(lds + LDS_INVF))[ptid] = 1.0f / powf(10000.0f, (float)ptid / 128.0f);
                __syncthreads();
                pg8::EpiRetProj E{WSP(bf16_t, OFF_Q), WSP(bf16_t, OFF_K), WSP(bf16_t, OFF_V), WSP(bf16_t, OFF_G), (const LAS float*)(lds + LDS_INVF)};
                pg8::gemm_phase<pg8::EpiRetProj, pg8::DenseOrder, true, false>(lds + RING_OFF, DM, S, E);
            } REP(3) if (ON(3) && (i & 1) == 1) {
                PHASE_ARGS();
                pg8::DenseOrder S; S.init(T, 3 * DM, DM, G, (int)blockIdx.x, WSP(bf16_t, OFF_XB), WSP(bf16_t, OFF_WSI) + (size_t)j * 3 * DM * DM);
                pg8::EpiBf16 E{WSP(bf16_t, OFF_Q), DM, DM, (size_t)(OFF_K - OFF_Q) / 2, 0.125f * 1.4426950408889634f, 0};
                pg8::gemm_phase<pg8::EpiBf16, pg8::DenseOrder, true, false>(lds + RING_OFF, DM, S, E);
            }
        }
        SEAM(pb);
        if (IN(pb + 1)) {
            REP(10) if (ON(10) && (i & 1) == 0) { PHASE_ARGS(); ret::scan_phase(lds + RING_OFF, WSP(bf16_t, OFF_Q), WSP(bf16_t, OFF_K), WSP(bf16_t, OFF_V), WSP(bf16_t, OFF_RO), G, (int)blockIdx.x,
                ka->in[10] + (size_t)(i + 1) * NE * DM * 2 * DF, WSP(bf16_t, OFF_WGU) + (size_t)(i + 1) * NE * 2 * DF * DM); }
            REP(11) if (ON(11) && (i & 1) == 1) { PHASE_ARGS(); sb::attn_phase(lds + RING_OFF, WSP(bf16_t, OFF_Q), WSP(bf16_t, OFF_K), WSP(bf16_t, OFF_V), WSP(bf16_t, OFF_GN), G, (int)blockIdx.x); }
        }
        SEAM(pb + 1);
        REP(12) if (ON(12) && IN(pb + 2) && (i & 1) == 0) {
            PHASE_ARGS();
            for (int w = blockIdx.x * NWAVES + wave; w < T * RH; w += G * NWAVES) ret::gate_row(w, lane, WSP(bf16_t, OFF_RO), WSP(bf16_t, OFF_G), WSP(bf16_t, OFF_GN));
        }
        if ((i & 1) == 0) SEAM(pb + 2);
        REP(4) if (ON(4) && IN(pb + 3)) {
            PHASE_ARGS();
            pg8::EpiBf16 E{WSP(bf16_t, OFF_MIX), DM, 0, 0, 1.0f, 0};
            const int Kx = (i & 1) ? DM : RHV;
            pg8::DenseOrder S; S.init(T, DM, Kx, G, (int)blockIdx.x, WSP(bf16_t, OFF_GN), (i & 1) ? (const void*)(WSP(bf16_t, OFF_WSO) + (size_t)j * DM * DM) : (const void*)(WSP(bf16_t, OFF_WRO) + (size_t)j * DM * RHV));
            pg8::gemm_phase<pg8::EpiBf16, pg8::DenseOrder, false, false>(lds + RING_OFF, Kx, S, E);
        }
        SEAM(pb + 3);
        REP(6) if (ON(6) && IN(pb + 4)) {
            PHASE_ARGS();
            if (i > 0) cvt_expert_weights(lds, ka->in[10], ka->in[12], ws, i, 1 << 20, ptid);
            __syncthreads();
            unsigned* cnt = WSP(unsigned, OFF_CTL) + CW_CNT + i * 2048;
            const float* lg = ka->in[6] + (size_t)i * DM; const float* lb = ka->in[7] + (size_t)i * DM; const float* rb = ka->in[9] + (size_t)i * NE;
            LAS int* rt_e = (LAS int*)(lds + LDS_ROFF); LAS float* rt_g = (LAS float*)(lds + LDS_SLOT); LAS int* rt_p = (LAS int*)(lds + LDS_SLOT + 1024); LAS int* rt_c = (LAS int*)(lds + LDS_BIAS); LAS int* rt_b = (LAS int*)(lds + LDS_BIAS + 128);
            if (ptid < NE) rt_c[ptid] = 0;
            __syncthreads();
            const int nrow = 2 * G * NWAVES;
            ln1_router_phase(lds + RING_OFF, G, (int)blockIdx.x, wave, lane, WSP(bf16_t, OFF_XB), WSP(bf16_t, OFF_MIX), lg, lb, ka->in[8] + (size_t)i * DM * NE, rb, WSP(bf16_t, OFF_X1B), rt_e, rt_g, rt_p, rt_c);
            __syncthreads();
            if (ptid < NE) rt_b[ptid] = (int)__hip_atomic_fetch_add(cnt + ptid * 64, (unsigned)rt_c[ptid], RLX_AGENT);
            __syncthreads();
            { const int nsw = (T - 2 * (int)blockIdx.x * NWAVES + nrow - 1) / nrow;
              int* elist = WSP(int, OFF_EL); float* gates = WSP(float, OFF_GT);
              for (int s = ptid; s < nsw * 64; s += NWAVES * 64) { const int li = s >> 2, kk = s & 3, sweep = li >> 4, wv = (li >> 1) & 7, r = li & 1;
                  const int t = 2 * ((int)blockIdx.x * NWAVES + wv) + sweep * nrow + r; const int ee = rt_e[s];
                  elist[(size_t)ee * T + rt_b[ee] + rt_p[s]] = t * 4 + kk; gates[t * 4 + kk] = rt_g[s]; } }
            __syncthreads();
        }
        SEAM(pb + 4);
        REP(7) if (ON(7) && IN(pb + 5)) {
            PHASE_ARGS();
            MoeOrder::setup(lds, WSP(unsigned, OFF_CTL) + CW_CNT + i * 2048);
            MoeOrder S; S.G = G; S.c = (int)blockIdx.x; S.nN = 2 * DF / 256; S.tp = (const LAS int*)(lds + LDS_TP); S.cn = (const LAS int*)(lds + LDS_TP + 256); S.elist = WSP(int, OFF_EL);
            S.A = (const char*)WSP(bf16_t, OFF_X1B); S.Bt = (const char*)(WSP(bf16_t, OFF_WGU) + (size_t)i * NE * 2 * DF * DM); S.bstride_e = (size_t)2 * DF * DM * 2; S.gather = true; S.roff = (LAS unsigned*)(lds + LDS_ROFF);
            S.bias = ka->in[11] + (size_t)i * NE * 2 * DF; S.bias_e = 2 * DF; S.slotT = (LAS int*)(lds + LDS_SLOT); S.biasT = (LAS float*)(lds + LDS_BIAS);
            pg8::EpiMoe1 E{(const LAS float*)(lds + LDS_BIAS), WSP(bf16_t, OFF_ACT)};
            pg8::gemm_phase<pg8::EpiMoe1, MoeOrder, true, true>(lds + RING_OFF, DM, S, E);
            if (i + 1 < DEPTH) { const int nwg = S.tp[NE] * S.nN, mine = (nwg - (int)blockIdx.x + G - 1) / G, most = (nwg + G - 1) / G;
                if (mine < most) cvt_expert_weights(lds, ka->in[10], ka->in[12], ws, i + 1, (most - mine) * CVT_TAIL_CLAIMS, ptid); }
        }
        SEAM(pb + 5);
        REP(8) if (ON(8) && IN(pb + 6)) {
            PHASE_ARGS();
            MoeOrder::setup(lds, WSP(unsigned, OFF_CTL) + CW_CNT + i * 2048);
            MoeOrder S; S.G = G; S.c = (int)blockIdx.x; S.nN = DM / 256; S.tp = (const LAS int*)(lds + LDS_TP); S.cn = (const LAS int*)(lds + LDS_TP + 256); S.elist = WSP(int, OFF_EL);
            S.A = (const char*)WSP(bf16_t, OFF_ACT); S.Bt = (const char*)(WSP(bf16_t, OFF_WDN) + (size_t)i * NE * DM * DF); S.bstride_e = (size_t)DM * DF * 2; S.gather = false; S.roff = (LAS unsigned*)(lds + LDS_ROFF);
            S.bias = ka->in[13] + (size_t)i * NE * DM; S.bias_e = DM; S.slotT = (LAS int*)(lds + LDS_SLOT); S.biasT = (LAS float*)(lds + LDS_BIAS);
            pg8::EpiMoe2 E{(const LAS float*)(lds + LDS_BIAS), WSP(bf16_t, OFF_YB), (const LAS int*)(lds + LDS_SLOT)};
            pg8::gemm_phase<pg8::EpiMoe2, MoeOrder, true, false>(lds + RING_OFF, DF, S, E);
            { const int nwg = S.tp[NE] * S.nN, rem = nwg % G, mine = (nwg - (int)blockIdx.x + G - 1) / G, most = (nwg + G - 1) / G;
              int nidle = rem ? G - rem : 0, q = (int)blockIdx.x - rem;
              if (nidle < 64) { nidle = G; q = (int)blockIdx.x; }
              int ppu = 0;
              if (q >= 0) { PPOrder P; P.G = nidle; P.c = 256 * i + q; P.lim = 256 * (i + 1); P.A = (const char*)WSP(bf16_t, OFF_PB); P.Bt = (const char*)WSP(bf16_t, OFF_WPW);
                  pg8::EpiBf16 E2{WSP(bf16_t, OFF_PPB), DM, 0, 0, 1.0f, (size_t)T * DM};
                  pg8::gemm_phase<pg8::EpiBf16, PPOrder, true, false>(lds + RING_OFF, DPLE, P, E2);
                  ppu = (256 - q + nidle - 1) / nidle; }
              if (i + 1 < DEPTH && mine < most) { const int claims = (most - mine) * CVT_TAIL_CLAIMS - ppu;
                  if (claims > 0) cvt_expert_weights(lds, ka->in[10], ka->in[12], ws, i + 1, claims, ptid); } }
        }
        SEAM(pb + 6);
        REP(9) if (ON(9) && IN(pb + 7)) {
            PHASE_ARGS();
            const float* lg = ka->in[14] + (size_t)i * DM; const float* lb = ka->in[15] + (size_t)i * DM;
            { const int st = G * NWAVES; int t = blockIdx.x * NWAVES + wave;
              for (; t + st < T; t += 2 * st) ln2_row2(t, t + st, lane, WSP(bf16_t, OFF_X1B), WSP(bf16_t, OFF_YB), WSP(float, OFF_GT), lg, lb, WSP(bf16_t, OFF_X2B));
              if (t < T) ln2_row(t, lane, WSP(bf16_t, OFF_X1B), WSP(bf16_t, OFF_YB), WSP(float, OFF_GT), lg, lb, WSP(bf16_t, OFF_X2B)); }
        }
        SEAM(pb + 7);
        REP(5) if (ON(5) && IN(pb + 8)) {
            PHASE_ARGS();
            pg8::DenseOrder S; S.init(T, DM, DM, G, (int)blockIdx.x, WSP(bf16_t, OFF_X2B), WSP(bf16_t, OFF_WPG) + (size_t)i * DM * DM);
            if (i == DEPTH - 1) { pg8::EpiPle<true> E{WSP(bf16_t, OFF_X2B), WSP(bf16_t, OFF_PPB) + (size_t)i * T * DM, ka->in[18] + (size_t)i * DM, WSP(bf16_t, OFF_XB), ka->out};
                pg8::gemm_phase<pg8::EpiPle<true>, pg8::DenseOrder, false, false>(lds + RING_OFF, DM, S, E); }
            else { pg8::EpiPle<false> E{WSP(bf16_t, OFF_X2B), WSP(bf16_t, OFF_PPB) + (size_t)i * T * DM, ka->in[18] + (size_t)i * DM, WSP(bf16_t, OFF_XB), nullptr};
                pg8::gemm_phase<pg8::EpiPle<false>, pg8::DenseOrder, false, false>(lds + RING_OFF, DM, S, E); }
        }
        SEAM(pb + 8);
    }
#undef IN
#undef SEAM
}
static int g_grid = 0;
extern "C" void kernel_launch(void* const* d_in, const int* in_sizes, int n_in, void* d_out, int out_size, void* d_ws, size_t ws_size, hipStream_t stream) {
    if (n_in != 19 || ws_size < WS_END || out_size != T * DM) { fprintf(stderr, "kernel_launch: unexpected arguments (n_in %d, ws %zu need %zu, out %d)\n", n_in, ws_size, (size_t)WS_END, out_size); return; }
    if (g_grid == 0) {
        int dev = 0, cus = 0;
        if (hipGetDevice(&dev) != hipSuccess || hipDeviceGetAttribute(&cus, hipDeviceAttributeMultiprocessorCount, dev) != hipSuccess) { g_grid = -1; return; }
        if (hipFuncSetAttribute((const void*)mega, hipFuncAttributeMaxDynamicSharedMemorySize, LDS_BYTES) != hipSuccess) { g_grid = -1; return; }
        int per_cu = 0; (void)hipOccupancyMaxActiveBlocksPerMultiprocessor(&per_cu, (const void*)mega, NWAVES * 64, LDS_BYTES); (void)hipGetLastError();
        if (per_cu < 1) fprintf(stderr, "kernel_launch: occupancy query reports %d workgroups per CU\n", per_cu);
        if (cus < 256) { fprintf(stderr, "kernel_launch: built for a 256-CU device (per-block routing tables hold 64 token rows); found %d CUs, nothing launched\n", cus); g_grid = -1; return; }
        g_grid = cus;
    }
    if (g_grid < 0) return;
    (void)hipMemsetAsync((unsigned char*)d_ws + OFF_CTL, 0, 128 * 1024, stream);
    Args a{};
    for (int i = 0; i < 19; ++i) a.in[i] = (const float*)d_in[i];
    a.out = (float*)d_out; a.ws = (unsigned char*)d_ws; a.ph_lo = 0; a.ph_hi = 2 + 10 * DEPTH; a.bar_region = 0; a.pad = 0;
    hipLaunchKernelGGL(mega, dim3(g_grid), dim3(NWAVES * 64), LDS_BYTES, stream, a);
}
```

```cpp
#include <hip/hip_runtime.h>
#include <stdint.h>
#include <cstdio>

typedef unsigned short bf16_t;
typedef short bf16x8 __attribute__((ext_vector_type(8)));
typedef float f32x4 __attribute__((ext_vector_type(4)));
typedef unsigned u32x4 __attribute__((ext_vector_type(4)));
typedef unsigned u32x2 __attribute__((ext_vector_type(2)));

constexpr int DM = 1024, NB = 8, SEQ = 2048, DEPTH = 4, T = NB * SEQ;
constexpr int RH = 4, RDK = 256, RDV = 512, RIN = 6144, RHV = RH * RDV;
constexpr int SH = 16, SD = 64;
constexpr int NE = 32, TOPK = 4, DF = 1024, DPLE = 256;
constexpr int NSLOT = T * TOPK;
constexpr int RPAD = NSLOT + NE * 256;
constexpr float DN_ALPHA = 1.6817928305074290f;
constexpr float LN_EPS = 1e-5f, GN_EPS = 1e-6f;

constexpr size_t MiB = (size_t)1 << 20;
constexpr size_t al(size_t x) { return (x + 255) & ~(size_t)255; }
constexpr size_t OFF_CTL = 0;
constexpr size_t OFF_WRI = OFF_CTL + MiB;
constexpr size_t OFF_WRO = OFF_WRI + al((size_t)2 * RIN * DM * 2);
constexpr size_t OFF_WSI = OFF_WRO + al((size_t)2 * DM * RHV * 2);
constexpr size_t OFF_WSO = OFF_WSI + al((size_t)2 * 3 * DM * DM * 2);
constexpr size_t OFF_WPG = OFF_WSO + al((size_t)2 * DM * DM * 2);
constexpr size_t OFF_WPW = OFF_WPG + al((size_t)4 * DM * DM * 2);
constexpr size_t OFF_WGU = OFF_WPW + al((size_t)4 * DM * DPLE * 2);
constexpr size_t OFF_WDN = OFF_WGU + al((size_t)128 * 2 * DF * DM * 2);
constexpr size_t OFF_PB  = OFF_WDN + al((size_t)128 * DM * DF * 2);
constexpr size_t OFF_XF  = OFF_PB  + al((size_t)4 * T * DPLE * 2);
constexpr size_t OFF_XB  = OFF_XF  + al((size_t)T * DM * 4);
constexpr size_t OFF_X1F = OFF_XB  + al((size_t)T * DM * 2);
constexpr size_t OFF_X1B = OFF_X1F + al((size_t)T * DM * 4);
constexpr size_t OFF_X2F = OFF_X1B + al((size_t)T * DM * 2);
constexpr size_t OFF_X2B = OFF_X2F + al((size_t)T * DM * 4);
constexpr size_t OFF_MIX = OFF_X2B + al((size_t)T * DM * 2);
constexpr size_t OFF_Q   = OFF_MIX + al((size_t)T * DM * 4);
constexpr size_t OFF_K   = OFF_Q   + al((size_t)T * DM * 2);
constexpr size_t OFF_V   = OFF_K   + al((size_t)T * DM * 2);
constexpr size_t OFF_G   = OFF_V   + al((size_t)T * RHV * 2);
constexpr size_t OFF_RO  = OFF_G   + al((size_t)T * RHV * 2);
constexpr size_t OFF_GN  = OFF_RO  + al((size_t)T * RHV * 4);
constexpr size_t OFF_ACT = OFF_GN  + al((size_t)T * RHV * 2);
constexpr size_t OFF_YB  = OFF_ACT + al((size_t)RPAD * DF * 2);
constexpr size_t OFF_PPB = OFF_YB  + al((size_t)(NSLOT + 1) * DM * 2);
constexpr size_t OFF_EL  = OFF_PPB + al((size_t)4 * T * DM * 2);
constexpr size_t OFF_GT  = OFF_EL  + al((size_t)NE * T * 4);
constexpr size_t OFF_ROPE= OFF_GT  + al((size_t)NSLOT * 4);
constexpr size_t OFF_PROJ= OFF_ROPE+ al((size_t)SEQ * 128 * 2 * 4);
constexpr size_t WS_END  = OFF_PROJ+ al((size_t)T * RIN * 4);
constexpr int CW_CNT = 16384;

__device__ __forceinline__ unsigned f2bf(float f) { unsigned u = __float_as_uint(f); return (u + 0x7fffu + ((u >> 16) & 1u)) >> 16; }
typedef float pk_f32x2 __attribute__((ext_vector_type(2))); typedef __bf16 pk_bf16x2 __attribute__((ext_vector_type(2)));
__device__ __forceinline__ unsigned pk2(float lo, float hi) { pk_f32x2 v = {lo, hi}; return __builtin_bit_cast(unsigned, __builtin_convertvector(v, pk_bf16x2)); }
__device__ __forceinline__ float bf2f(unsigned b) { return __uint_as_float(b << 16); }
template <int CTRL> __device__ __forceinline__ float dpp_f(float v) { return __builtin_bit_cast(float, __builtin_amdgcn_update_dpp(0, __builtin_bit_cast(int, v), CTRL, 0xf, 0xf, true)); }
__device__ __forceinline__ float lane_f(float v, int l) { return __builtin_bit_cast(float, __builtin_amdgcn_readlane(__builtin_bit_cast(int, v), l)); }
__device__ __forceinline__ float wave_sum(float v) {
    v += dpp_f<0xB1>(v); v += dpp_f<0x4E>(v); v += dpp_f<0x141>(v); v += dpp_f<0x140>(v);
    return (lane_f(v, 0) + lane_f(v, 16)) + (lane_f(v, 32) + lane_f(v, 48));
}
__device__ __forceinline__ float sigmoidf_(float x) { return 1.0f / (1.0f + __expf(-x)); }

#define LAS __attribute__((address_space(3)))
#define GAS __attribute__((address_space(1)))
namespace pg8 {
constexpr int BM = 256, BK = 64, HALF = 128, HTB = HALF * BK * 2  , STAGE_BYTES = 8 * HTB, NXCD = 8, WGM = 8;
__host__ __device__ __forceinline__ int lds_byte(int r, int c) { const int st = (r >> 4) * 2 + (c >> 5), rr = r & 15, cc = c & 31, ob = rr * 64 + cc * 2; return st * 1024 + (ob ^ (((ob >> 9) & 1) << 5)); }
__host__ __device__ __forceinline__ void stage_rc(int b, int& R, int& C) { const int st = b / 1024, sb = b % 1024, swz = sb ^ (((sb >> 9) & 1) << 5); R = (st >> 1) * 16 + swz / 64; C = (st & 1) * 32 + (swz % 64) / 2; }
__host__ __device__ __forceinline__ int perm32(int rho) { const int n = rho >> 4, i = rho & 15; return 8 * (i >> 2) + 4 * n + (i & 3); }
struct Unit { int pm, pn, e, lrow0, nvalid; };
template <class E> struct InitOf { static constexpr bool BIAS = false; };
template <class E> struct PermOf { static __host__ __device__ __forceinline__ int f(int rho) { return perm32(rho); } };
typedef float f32x2_t __attribute__((ext_vector_type(2))); typedef __bf16 bf16x2_t __attribute__((ext_vector_type(2)));
__device__ __forceinline__ unsigned cvt_pk_bf16(float lo, float hi) { f32x2_t v = {lo, hi}; bf16x2_t b = __builtin_convertvector(v, bf16x2_t); return __builtin_bit_cast(unsigned, b); }

struct DenseOrder {
    int nM, nN, nwg, G, c; const char* A; const char* Bt; size_t tstep;
    __device__ void init(int M, int N, int K, int G_, int c_, const void* A_, const void* Bt_) { nM = M / BM; nN = N / BM; nwg = nM * nN; G = G_; c = c_; A = (const char*)A_; Bt = (const char*)Bt_; tstep = (size_t)BM * K * 2; }
    __device__ bool next(int i, Unit& u) const {
        const long L = (long)i * G + c; if (L >= nwg) return false;
        int wgid = (int)L; { const int q = nwg / NXCD, r = nwg % NXCD, xcd = wgid % NXCD, off = wgid / NXCD; wgid = (xcd < r ? xcd * (q + 1) : r * (q + 1) + (xcd - r) * q) + off; }
        const int nig = WGM * nN, gid = wgid / nig, fm = gid * WGM, gsz = (nM - fm) < WGM ? (nM - fm) : WGM;
        u.pm = fm + ((wgid % nig) % gsz); u.pn = (wgid % nig) / gsz; u.e = 0; u.lrow0 = 0; u.nvalid = BM; return true;
    }
    __device__ __forceinline__ const char* a_base(const Unit& u) const { return A + (size_t)u.pm * tstep; }
    __device__ __forceinline__ const char* b_base(const Unit& u) const { return Bt + (size_t)u.pn * tstep; }
    __device__ __forceinline__ void prep(const Unit&, int, int, int) const {}
    __device__ __forceinline__ void prep_load(const Unit&, int, int&, f32x4&) const {}
    __device__ __forceinline__ void prep_store(int, int, int, int, const f32x4&) const {}
    static constexpr bool HAS_PREP = false;
    LAS unsigned* roff;
};
struct EpiF32 {
    static constexpr bool PERM = false; static constexpr int NSTORE = 16;
    float* C; int ldc;
    __device__ __forceinline__ void operator()(const f32x4 (&acc)[2][2][4][2], const Unit& u, int wr, int wc, int fr, int fq, int) const {
        const int row0 = u.pm * BM + wr * 64 + fr, col0 = u.pn * BM + wc * 32 + 4 * fq;
#pragma unroll
        for (int ai = 0; ai < 2; ++ai)
#pragma unroll
            for (int m = 0; m < 4; ++m) { float* rowp = C + (size_t)(row0 + ai * HALF + m * 16) * ldc + col0;
#pragma unroll
                for (int bj = 0; bj < 2; ++bj)
#pragma unroll
                    for (int n = 0; n < 2; ++n) *(f32x4*)(rowp + bj * HALF + n * 16) = acc[ai][bj][m][n]; }
    }
};
struct EpiBf16 {
    static constexpr bool PERM = true; static constexpr int NSTORE = 16;
    bf16_t* O; int ldc; int split_cols; size_t split_stride; float scale0; size_t estride;
    __device__ __forceinline__ void operator()(const f32x4 (&acc)[2][2][4][2], const Unit& u, int wr, int wc, int fr, int fq, int) const {
        const int row0 = u.pm * BM + wr * 64 + fr; int colt = u.pn * BM; bf16_t* base = O + (size_t)u.e * estride;
        float sc = 1.f; if (split_cols) { const int t = colt / split_cols; base += (size_t)t * split_stride; colt -= t * split_cols; if (t == 0) sc = scale0; }
        const int col0 = colt + wc * 32 + 8 * fq;
#pragma unroll
        for (int ai = 0; ai < 2; ++ai)
#pragma unroll
            for (int m = 0; m < 4; ++m) { bf16_t* rowp = base + (size_t)(row0 + ai * HALF + m * 16) * ldc + col0;
#pragma unroll
                for (int bj = 0; bj < 2; ++bj) { const f32x4 v0 = acc[ai][bj][m][0] * sc, v1 = acc[ai][bj][m][1] * sc;
                    u32x4 w; w.x = cvt_pk_bf16(v0[0], v0[1]); w.y = cvt_pk_bf16(v0[2], v0[3]); w.z = cvt_pk_bf16(v1[0], v1[1]); w.w = cvt_pk_bf16(v1[2], v1[3]);
                    *(u32x4*)(rowp + bj * HALF) = w; } }
    }
};
struct EpiRetProj {
    static constexpr bool PERM = true; static constexpr int NSTORE = 16;
    bf16_t *Q, *Kk, *V, *G; const LAS float* invf;
    __device__ __forceinline__ void operator()(const f32x4 (&acc)[2][2][4][2], const Unit& u, int wr, int wc, int fr, int fq, int) const {
        const int row0 = u.pm * BM + wr * 64 + fr, pn = u.pn;
        if (pn < 8) {
            const int h = pn & 3; bf16_t* dst = pn < 4 ? Q : Kk; const float sc = pn < 4 ? 1.0f : 0.0625f; const int d0 = wc * 32 + 8 * fq;
            const f32x4 f0 = *(const LAS f32x4*)(invf + d0), f1 = *(const LAS f32x4*)(invf + d0 + 4);
            const float fv[8] = {f0[0], f0[1], f0[2], f0[3], f1[0], f1[1], f1[2], f1[3]};
#pragma unroll
            for (int ai = 0; ai < 2; ++ai)
#pragma unroll
                for (int m = 0; m < 4; ++m) { const int r = row0 + ai * HALF + m * 16; const float pos = (float)(r & (SEQ - 1));
                    float cs[8], sn[8];
#pragma unroll
                    for (int q = 0; q < 8; ++q) { const float ang = pos * fv[q];
                        float rev = ang * 0.15915494309189535f; rev = rev - __builtin_floorf(rev); cs[q] = __builtin_amdgcn_cosf(rev); sn[q] = __builtin_amdgcn_sinf(rev); }
                    const f32x4 xa = acc[ai][0][m][0], xb = acc[ai][0][m][1], ya = acc[ai][1][m][0], yb = acc[ai][1][m][1];
                    const float x[8] = {xa[0], xa[1], xa[2], xa[3], xb[0], xb[1], xb[2], xb[3]}, y[8] = {ya[0], ya[1], ya[2], ya[3], yb[0], yb[1], yb[2], yb[3]};
                    u32x4 w1, w2;
                    w1.x = cvt_pk_bf16((x[0] * cs[0] - y[0] * sn[0]) * sc, (x[1] * cs[1] - y[1] * sn[1]) * sc); w1.y = cvt_pk_bf16((x[2] * cs[2] - y[2] * sn[2]) * sc, (x[3] * cs[3] - y[3] * sn[3]) * sc);
                    w1.z = cvt_pk_bf16((x[4] * cs[4] - y[4] * sn[4]) * sc, (x[5] * cs[5] - y[5] * sn[5]) * sc); w1.w = cvt_pk_bf16((x[6] * cs[6] - y[6] * sn[6]) * sc, (x[7] * cs[7] - y[7] * sn[7]) * sc);
                    w2.x = cvt_pk_bf16((x[0] * sn[0] + y[0] * cs[0]) * sc, (x[1] * sn[1] + y[1] * cs[1]) * sc); w2.y = cvt_pk_bf16((x[2] * sn[2] + y[2] * cs[2]) * sc, (x[3] * sn[3] + y[3] * cs[3]) * sc);
                    w2.z = cvt_pk_bf16((x[4] * sn[4] + y[4] * cs[4]) * sc, (x[5] * sn[5] + y[5] * cs[5]) * sc); w2.w = cvt_pk_bf16((x[6] * sn[6] + y[6] * cs[6]) * sc, (x[7] * sn[7] + y[7] * cs[7]) * sc);
                    bf16_t* o = dst + (size_t)r * DM + h * RDK + d0;
                    *(u32x4*)o = w1; *(u32x4*)(o + 128) = w2; }
        } else {
            bf16_t* dst = pn < 16 ? V : G; const int cb = (pn < 16 ? pn - 8 : pn - 16) * BM + wc * 32 + 8 * fq;
#pragma unroll
            for (int ai = 0; ai < 2; ++ai)
#pragma unroll
                for (int m = 0; m < 4; ++m) { bf16_t* rowp = dst + (size_t)(row0 + ai * HALF + m * 16) * RHV + cb;
#pragma unroll
                    for (int bj = 0; bj < 2; ++bj) { const f32x4 v0 = acc[ai][bj][m][0], v1 = acc[ai][bj][m][1];
                        u32x4 w; w.x = cvt_pk_bf16(v0[0], v0[1]); w.y = cvt_pk_bf16(v0[2], v0[3]); w.z = cvt_pk_bf16(v1[0], v1[1]); w.w = cvt_pk_bf16(v1[2], v1[3]);
                        *(u32x4*)(rowp + bj * HALF) = w; } }
        }
    }
};
template <bool OUT> struct EpiPle {
    static constexpr bool PERM = true; static constexpr int NSTORE = 16;
    const bf16_t* x2b; const bf16_t* pp; const float* bg; bf16_t* xb; float* out;
    __device__ __forceinline__ void operator()(const f32x4 (&acc)[2][2][4][2], const Unit& u, int wr, int wc, int fr, int fq, int) const {
        const int row0 = u.pm * BM + wr * 64 + fr, col0 = u.pn * BM + wc * 32 + 8 * fq;
        f32x4 bv[2][2];
#pragma unroll
        for (int bj = 0; bj < 2; ++bj)
#pragma unroll
            for (int n = 0; n < 2; ++n) bv[bj][n] = *(const f32x4*)(bg + col0 + bj * HALF + 4 * n);
        u32x4 xw = *(const u32x4*)(x2b + (size_t)row0 * DM + col0), pw = *(const u32x4*)(pp + (size_t)row0 * DM + col0);
#pragma unroll
        for (int s = 0; s < 16; ++s) { const int ai = s >> 3, m = (s >> 1) & 3, bj = s & 1;
            const size_t o = (size_t)(row0 + ai * HALF + m * 16) * DM + col0 + bj * HALF;
            const u32x4 xc = xw, pc = pw;
            if (s + 1 < 16) { const int s1 = s + 1, ai1 = s1 >> 3, m1 = (s1 >> 1) & 3, bj1 = s1 & 1; const size_t o1 = (size_t)(row0 + ai1 * HALF + m1 * 16) * DM + col0 + bj1 * HALF;
                xw = *(const u32x4*)(x2b + o1); pw = *(const u32x4*)(pp + o1); }
            __builtin_amdgcn_sched_barrier(0);
            const unsigned xs[4] = {xc.x, xc.y, xc.z, xc.w}, ps[4] = {pc.x, pc.y, pc.z, pc.w};
            float r[8];
#pragma unroll
            for (int q = 0; q < 4; ++q) { const f32x4 a = acc[ai][bj][m][q >> 1] + bv[bj][q >> 1]; const int e0 = 2 * (q & 1);
                r[2 * q] = bf2f(xs[q] & 0xffffu) + bf2f(ps[q] & 0xffffu) * __builtin_amdgcn_rcpf(1.0f + __expf(-a[e0])); r[2 * q + 1] = bf2f(xs[q] >> 16) + bf2f(ps[q] >> 16) * __builtin_amdgcn_rcpf(1.0f + __expf(-a[e0 + 1])); }
            u32x4 w; w.x = cvt_pk_bf16(r[0], r[1]); w.y = cvt_pk_bf16(r[2], r[3]); w.z = cvt_pk_bf16(r[4], r[5]); w.w = cvt_pk_bf16(r[6], r[7]);
            *(u32x4*)(xb + o) = w;
            if constexpr (OUT) { *(f32x4*)(out + o) = (f32x4){r[0], r[1], r[2], r[3]}; *(f32x4*)(out + o + 4) = (f32x4){r[4], r[5], r[6], r[7]}; }
            asm volatile("" ::: "memory"); }
    }
};

template <class Epi, class Sched, bool ALIGN_EPI, bool GATHER>
__device__ __forceinline__ void gemm_phase(LAS unsigned char* lds, const int Kin, const Sched& S, const Epi& E) {
    int tid = threadIdx.x; asm volatile("" : "+v"(tid));
    const int wid = __builtin_amdgcn_readfirstlane(tid >> 6), lane = tid & 63, wr = wid >> 2, wc = wid & 3, fr = lane & 15, fq = lane >> 4;
    int K = __builtin_amdgcn_readfirstlane(Kin); asm volatile("" : "+s"(K));
    const int nt = K / BK;
    unsigned voffB[2], voffA[2], vG[2][2];
#pragma unroll
    for (int i = 0; i < 2; ++i) { int R, C; stage_rc(tid * 16 + i * 8192, R, C); const int Rb = Epi::PERM ? ((R & ~31) + PermOf<Epi>::f(R & 31)) : R;
        voffB[i] = (unsigned)(Rb * K + C) * 2u; voffA[i] = (unsigned)(R * K + C) * 2u; }
    const size_t kstep = (size_t)(BK * 2);
    const size_t hstep = (size_t)HALF * K * 2;
    const unsigned ldsw = (unsigned)wid * 1024u;
    const int aoff = lds_byte(wr * 64 + fr, fq * 8), boff = lds_byte(wc * 32 + fr, fq * 8);
#define PG8_SA(b, h) (((b) * 2 + (h)) * HTB)
#define PG8_SB(b, h) ((4 + (b) * 2 + (h)) * HTB)
#define PG8_STAGE(bufoff, gbase, voff) do { _Pragma("unroll") for (int _i = 0; _i < 2; ++_i) { unsigned _o = (voff)[_i]; if constexpr (GATHER) asm volatile("" : "+v"(_o)); \
        __builtin_amdgcn_global_load_lds((const unsigned*)((const char*)(gbase) + _o), (LAS unsigned*)(lds + (bufoff) + ldsw + _i * 8192), 16, 0, 0); } } while (0)
#define PG8_STAGEA(bufoff, gbase, h, vg) do { if constexpr (GATHER) { PG8_STAGE(bufoff, gbase, vg[h]); } else { PG8_STAGE(bufoff, (gbase) + (h) * hstep, voffA); } } while (0)
#define PG8_LDA(dst, b, h) do { _Pragma("unroll") for (int m = 0; m < 4; ++m) _Pragma("unroll") for (int k = 0; k < 2; ++k) dst[m][k] = *(const LAS bf16x8*)(lds + PG8_SA(b, h) + aoff + m * 2048 + k * 1024); } while (0)
#define PG8_LDB(dst, b, h) do { _Pragma("unroll") for (int n = 0; n < 2; ++n) _Pragma("unroll") for (int k = 0; k < 2; ++k) dst[n][k] = *(const LAS bf16x8*)(lds + PG8_SB(b, h) + boff + n * 2048 + k * 1024); } while (0)
#define PG8_MMA(ai, bj, At, Bt) do { __builtin_amdgcn_s_setprio(1); _Pragma("unroll") for (int m = 0; m < 4; ++m) _Pragma("unroll") for (int n = 0; n < 2; ++n) _Pragma("unroll") for (int k = 0; k < 2; ++k) \
        acc[ai][bj][m][n] = __builtin_amdgcn_mfma_f32_16x16x32_bf16(Bt[n][k], At[m][k], acc[ai][bj][m][n], 0, 0, 0); __builtin_amdgcn_s_setprio(0); } while (0)
#define PG8_WAIT_V(n) asm volatile("s_waitcnt vmcnt(" #n ")" ::: "memory")
#define PG8_WAIT_L(n) asm volatile("s_waitcnt lgkmcnt(" #n ")" ::: "memory")
#define PG8_WAIT_VF(flag, n) asm volatile("v_cmp_ne_u32_e32 vcc, 0, %0\n\ts_cbranch_vccz .Lw8_%=\n\ts_waitcnt vmcnt(%1)\n\ts_branch .Lwd_%=\n.Lw8_%=:\n\ts_waitcnt vmcnt(8)\n.Lwd_%=:" :: "v"(flag), "n"(n) : "memory", "vcc")
#define PG8_BAR __builtin_amdgcn_s_barrier()
#define PG8_SCHED __builtin_amdgcn_sched_barrier(0)
#define PG8_TABLE(u, par) do { S.prep(u, par, tid, K); } while (0)
#define PG8_INIT(u, par) do { if constexpr (InitOf<Epi>::BIAS) { int il_ = lane; asm volatile("" : "+v"(il_)); f32x4 iv_[2][2]; InitOf<Epi>::load(E, iv_, u, par, wc, il_ >> 4); \
        _Pragma("unroll") for (int a_ = 0; a_ < 2; ++a_) _Pragma("unroll") for (int b_ = 0; b_ < 2; ++b_) _Pragma("unroll") for (int m_ = 0; m_ < 4; ++m_) _Pragma("unroll") for (int n_ = 0; n_ < 2; ++n_) { \
            const f32x2_t sl_ = {iv_[b_][n_][0], iv_[b_][n_][1]}, sh_ = {iv_[b_][n_][2], iv_[b_][n_][3]}; f32x2_t zl_, zh_; \
            asm volatile("v_pk_mov_b32 %0, %1, %1 op_sel:[0,1]" : "=v"(zl_) : "v"(sl_)); asm volatile("v_pk_mov_b32 %0, %1, %1 op_sel:[0,1]" : "=v"(zh_) : "v"(sh_)); acc[a_][b_][m_][n_] = (f32x4){zl_[0], zl_[1], zh_[0], zh_[1]}; } } \
    else { _Pragma("unroll") for (int a_ = 0; a_ < 2; ++a_) _Pragma("unroll") for (int b_ = 0; b_ < 2; ++b_) _Pragma("unroll") for (int m_ = 0; m_ < 4; ++m_) _Pragma("unroll") for (int n_ = 0; n_ < 2; ++n_) { \
            f32x2_t zl_, zh_; asm volatile("v_pk_mov_b32 %0, 0, 0" : "=v"(zl_)); asm volatile("v_pk_mov_b32 %0, 0, 0" : "=v"(zh_)); acc[a_][b_][m_][n_] = (f32x4){zl_[0], zl_[1], zh_[0], zh_[1]}; } } } while (0)
#define PG8_GREAD(dst) do { _Pragma("unroll") for (int _i = 0; _i < 2; ++_i) { int _R, _C; stage_rc(tid * 16 + _i * 8192, _R, _C); _Pragma("unroll") for (int _h = 0; _h < 2; ++_h) dst[_h][_i] = S.roff[_h * HALF + _R] + (unsigned)_C * 2u; } } while (0)
    Unit cur, nxt; int ui = 0; int pslot = 0; f32x4 pbias = (f32x4){0.f, 0.f, 0.f, 0.f};
    if (!S.next(0, cur)) return;
    f32x4 acc[2][2][4][2];
    bf16x8 At[4][2], B0[2][2], B1[2][2];
    const char* cA = S.a_base(cur); const char* cB = S.b_base(cur);
    if constexpr (Sched::HAS_PREP) { PG8_TABLE(cur, 0); asm volatile("s_waitcnt vmcnt(0) lgkmcnt(0)" ::: "memory"); __builtin_amdgcn_s_barrier(); asm volatile("" ::: "memory"); }
    PG8_INIT(cur, 0);
    if constexpr (GATHER) { PG8_GREAD(vG); }
    PG8_STAGE(PG8_SB(0, 0), cB, voffB); PG8_STAGE(PG8_SB(0, 1), cB + hstep, voffB); PG8_STAGEA(PG8_SA(0, 0), cA, 0, vG); PG8_STAGEA(PG8_SA(0, 1), cA, 1, vG);
    if (wr == 1) PG8_BAR;
    PG8_WAIT_V(2); PG8_BAR;
    PG8_STAGE(PG8_SB(1, 0), cB + kstep, voffB); PG8_STAGEA(PG8_SA(1, 0), cA + kstep, 0, vG); PG8_STAGE(PG8_SB(1, 1), cB + hstep + kstep, voffB);
    PG8_WAIT_V(6); PG8_BAR;
    for (;;) {
        const bool has_next = S.next(ui + 1, nxt);
        const char* nA = has_next ? S.a_base(nxt) : cA; const char* nB = has_next ? S.b_base(nxt) : cB;
        for (int t = 0; t < nt; t += 2) {
            const bool last = (t == nt - 2);
            const int fresh = (t == 0 && ui > 0) ? 1 : 0;
            const char* a1 = cA + (size_t)(t + 1) * kstep;
            const char* a2 = last ? nA : cA + (size_t)(t + 2) * kstep; const char* b2 = last ? nB : cB + (size_t)(t + 2) * kstep;
            const char* a3 = a2 + kstep; const char* b3 = b2 + kstep;
            if constexpr (Sched::HAS_PREP) {
                if (t == nt - 4 && has_next) S.prep_load(nxt, tid, pslot, pbias);
                if (last && has_next) S.prep_store((ui + 1) & 1, tid, K, pslot, pbias); }
            PG8_LDB(B0, 0, 0); PG8_LDB(B1, 0, 1); PG8_SCHED; PG8_LDA(At, 0, 0); PG8_STAGEA(PG8_SA(1, 1), a1, 1, vG);
            PG8_WAIT_VF(fresh, 8 + Epi::NSTORE); PG8_WAIT_L(0); PG8_BAR; PG8_MMA(0, 0, At, B0); PG8_MMA(0, 1, At, B1); PG8_BAR; PG8_SCHED;
            if constexpr (GATHER) { if (last && has_next) { PG8_GREAD(vG); } }
            PG8_LDA(At, 0, 1); PG8_STAGE(PG8_SB(0, 0), b2, voffB); PG8_STAGE(PG8_SB(0, 1), b2 + hstep, voffB); PG8_STAGEA(PG8_SA(0, 0), a2, 0, vG);
            PG8_WAIT_VF(fresh, 8 + Epi::NSTORE); PG8_WAIT_L(0); PG8_BAR; PG8_MMA(1, 0, At, B0); PG8_MMA(1, 1, At, B1); PG8_BAR; PG8_SCHED;
            PG8_LDB(B0, 1, 0); PG8_LDB(B1, 1, 1); PG8_SCHED; PG8_LDA(At, 1, 0); PG8_STAGEA(PG8_SA(0, 1), a2, 1, vG);
            PG8_WAIT_V(8); PG8_WAIT_L(0); PG8_BAR; PG8_MMA(0, 0, At, B0); PG8_MMA(0, 1, At, B1); PG8_BAR; PG8_SCHED;
            PG8_LDA(At, 1, 1); PG8_STAGE(PG8_SB(1, 0), b3, voffB); PG8_STAGE(PG8_SB(1, 1), b3 + hstep, voffB); PG8_STAGEA(PG8_SA(1, 0), a3, 0, vG);
            PG8_WAIT_V(8); PG8_WAIT_L(0); PG8_BAR; PG8_MMA(1, 0, At, B0); PG8_MMA(1, 1, At, B1); PG8_BAR; PG8_SCHED;
        }
        if constexpr (ALIGN_EPI) { if (wr == 0) PG8_BAR; }
        { int el = lane; asm volatile("" : "+v"(el));
          E(acc, cur, wr, wc, el & 15, el >> 4, ui & 1); }
        if (!has_next) break;
        PG8_INIT(nxt, (ui + 1) & 1);
        cur = nxt; cA = nA; cB = nB; ++ui;
        if constexpr (ALIGN_EPI) { if (wr == 1) PG8_BAR; }
    }
    PG8_WAIT_V(0);
    if constexpr (!ALIGN_EPI) { if (wr == 0) PG8_BAR; }
    PG8_BAR;
#undef PG8_SA
#undef PG8_SB
#undef PG8_STAGE
#undef PG8_STAGEA
#undef PG8_LDA
#undef PG8_LDB
#undef PG8_MMA
#undef PG8_WAIT_V
#undef PG8_WAIT_L
#undef PG8_WAIT_VF
#undef PG8_BAR
#undef PG8_SCHED
#undef PG8_TABLE
#undef PG8_INIT
#undef PG8_GREAD
}
}
typedef float f32x2 __attribute__((ext_vector_type(2)));
constexpr int NWAVES = 8;
constexpr int RING_OFF = 0, RING_BYTES = 139264;
constexpr int LDSCTL_OFF = RING_BYTES, MISC_OFF = LDSCTL_OFF + 320;
constexpr int LDS_BYTES = 147456;
constexpr int CW_BAR = 4096;
typedef GAS unsigned gu32;
#define RLX_AGENT __ATOMIC_RELAXED, __HIP_MEMORY_SCOPE_AGENT

#define XB_TMO      128
#define XB_XCNT(j)  (256  + 64 * (j))
#define XB_XSUB(j)  (1280 + 64 * (j))
#define XB_XGEN(j)  (2304 + 64 * (j))
#define XB_TOP      3328
#define XB_TOPGEN   3392
#define XCD_BAR_WORDS 3456
#define XB_SPIN_CAP (1u << 18)
__device__ __forceinline__ unsigned xb_ld(unsigned* p)              { return __hip_atomic_load(p, __ATOMIC_RELAXED, __HIP_MEMORY_SCOPE_AGENT); }
__device__ __forceinline__ unsigned xb_add(unsigned* p, unsigned v) { return __hip_atomic_fetch_add(p, v, __ATOMIC_RELAXED, __HIP_MEMORY_SCOPE_AGENT); }
__device__ __forceinline__ unsigned xb_xcc_id() { return (unsigned)__builtin_amdgcn_s_getreg((3 << 11) | 20) & 0xFu; }
#define XB_SPIN(cond, bar) do { unsigned _sp = 0; while (cond) { __builtin_amdgcn_s_sleep(1); \
    if ((++_sp & 255u) == 0u) { if (xb_ld(&(bar)[XB_TMO])) break; if (_sp > XB_SPIN_CAP) { atomicAdd(&(bar)[XB_TMO], 1u); break; } } } } while (0)
struct XcdBarrier { unsigned* bar; unsigned x; volatile LAS unsigned* st; };
__device__ __forceinline__ XcdBarrier xcd_barrier_post(unsigned* bar, volatile LAS unsigned* st) {
    XcdBarrier b; b.bar = bar; b.x = xb_xcc_id(); b.st = st;
    if (threadIdx.x == 0) (void)xb_add(&bar[XB_XCNT(b.x)], 1u);
    return b;
}
__device__ __forceinline__ void xcd_barrier_complete(unsigned* bar, unsigned x, unsigned& nloc, unsigned& nx) {
    const unsigned G = gridDim.x * gridDim.y * gridDim.z;
    unsigned sum, cnt, mine, sp = 0u;
    for (;;) {
        sum = 0u; cnt = 0u; mine = 0u;
#pragma unroll
        for (unsigned j = 0; j < 16; ++j) { const unsigned c = xb_ld(&bar[XB_XCNT(j)]); sum += c; cnt += (c > 0u) ? 1u : 0u; mine = (j == x) ? c : mine; }
        if (sum == G) break;
        __builtin_amdgcn_s_sleep(1);
        if ((++sp & 255u) == 0u) { if (xb_ld(&bar[XB_TMO])) break; if (sp > XB_SPIN_CAP) { atomicAdd(&bar[XB_TMO], 1u); break; } }
    }
    nloc = mine > 0u ? mine : 1u; nx = cnt > 0u ? cnt : 1u;
}
__device__ __forceinline__ void xcd_barrier(const XcdBarrier& b) {
    asm volatile("s_waitcnt vmcnt(0)" ::: "memory");
    __syncthreads();
    if (threadIdx.x == 0) {
        unsigned* bar = b.bar;
        __builtin_amdgcn_s_waitcnt(0);
        unsigned nloc = b.st[0], nx = b.st[1];
        if (nloc == 0u) { xcd_barrier_complete(bar, b.x, nloc, nx); b.st[0] = nloc; b.st[1] = nx; }
        const unsigned old = xb_add(&bar[XB_XSUB(b.x)], 1u);
        const unsigned gen = old / nloc;
        if (old + 1u == (gen + 1u) * nloc) {
            __builtin_amdgcn_fence(__ATOMIC_RELEASE, "agent");
            asm volatile("s_waitcnt vmcnt(0)" ::: "memory");
            const unsigned og = xb_add(&bar[XB_TOP], 1u);
            const unsigned tg = og / nx;
            if (og + 1u == (tg + 1u) * nx) xb_add(&bar[XB_TOPGEN], 1u);
            else XB_SPIN(xb_ld(&bar[XB_TOPGEN]) == tg, bar);
            __builtin_amdgcn_fence(__ATOMIC_ACQUIRE, "agent");
            xb_add(&bar[XB_XGEN(b.x)], 1u);
            asm volatile("s_waitcnt vmcnt(0)" ::: "memory");
        } else {
            XB_SPIN(xb_ld(&bar[XB_XGEN(b.x)]) == gen, bar);
            __builtin_amdgcn_fence(__ATOMIC_ACQUIRE, "agent");
            asm volatile("s_waitcnt vmcnt(0)" ::: "memory");
        }
    }
    __syncthreads();
}

__device__ __forceinline__ void cvt_stream(const f32x4* __restrict__ src, u32x2* __restrict__ dst, size_t n, size_t gt, size_t ngt) {
    size_t i = gt;
    for (; i + 7 * ngt < n; i += 8 * ngt) {
        f32x4 v[8];
#pragma unroll
        for (int k = 0; k < 8; ++k) v[k] = __builtin_nontemporal_load(src + i + (size_t)k * ngt);
#pragma unroll
        for (int k = 0; k < 8; ++k) { u32x2 o; o.x = pk2(v[k].x, v[k].y); o.y = pk2(v[k].z, v[k].w); dst[i + (size_t)k * ngt] = o; }
    }
    for (; i < n; i += ngt) { const f32x4 v = src[i]; u32x2 o; o.x = pk2(v.x, v.y); o.y = pk2(v.z, v.w); dst[i] = o; }
}
__device__ __forceinline__ void p0_transpose_item(const float* __restrict__ Wm, int K, int N, bf16_t* __restrict__ WTm, LAS float* scr, int item, int lane) {
    const int nblk = N / 32, kb = item / nblk, nbk = item % nblk, k0 = 64 * kb, n0 = 32 * nbk;
#pragma unroll 8
    for (int i = 0; i < 32; ++i) { const int kk = 2 * i + (lane >> 5); scr[kk * 33 + (lane & 31)] = Wm[(size_t)(k0 + kk) * N + n0 + (lane & 31)]; }
    asm volatile("s_waitcnt lgkmcnt(0)" ::: "memory");
    const int c = lane & 7;
#pragma unroll
    for (int j = 0; j < 4; ++j) { const int n = (lane >> 3) + 8 * j; const LAS float* s = scr + (8 * c) * 33 + n;
        u32x4 o; o.x = pk2(s[0 * 33], s[1 * 33]); o.y = pk2(s[2 * 33], s[3 * 33]); o.z = pk2(s[4 * 33], s[5 * 33]); o.w = pk2(s[6 * 33], s[7 * 33]);
        *(u32x4*)(WTm + (size_t)(n0 + n) * K + k0 + 8 * c) = o; }
    asm volatile("s_waitcnt lgkmcnt(0)" ::: "memory");
}
__device__ __forceinline__ void p0_transpose_range(const float* W, bf16_t* WT, int K, int N, LAS float* scr, long it0, long itend, int step, int lane) {
    const int nblk = N / 32, per = (K / 64) * nblk;
    if (it0 >= itend) return;
    float RA[32], RB[32];
#define P0_LOAD(R, itv) do { const int mb_ = (int)((itv) / per), item_ = (int)((itv) % per), k0_ = 64 * (item_ / nblk), n0_ = 32 * (item_ % nblk); \
        const float* src_ = W + (size_t)mb_ * K * N + (size_t)(k0_ + (lane >> 5)) * N + n0_ + (lane & 31); \
        _Pragma("unroll") for (int i_ = 0; i_ < 32; ++i_) R[i_] = __builtin_nontemporal_load(src_ + (size_t)(2 * i_) * N); } while (0)
#define P0_EMIT(R, itv) do { \
        _Pragma("unroll") for (int i_ = 0; i_ < 32; ++i_) scr[(2 * i_ + (lane >> 5)) * 33 + (lane & 31)] = R[i_]; \
        asm volatile("s_waitcnt lgkmcnt(0)" ::: "memory"); \
        { const int mb = (int)((itv) / per), item = (int)((itv) % per), k0 = 64 * (item / nblk), n0 = 32 * (item % nblk); bf16_t* WTm = WT + (size_t)mb * K * N; const int c = lane & 7; \
          _Pragma("unroll") for (int j = 0; j < 4; ++j) { const int n = (lane >> 3) + 8 * j; const LAS float* sp = scr + (8 * c) * 33 + n; \
              u32x4 o; o.x = pk2(sp[0 * 33], sp[1 * 33]); o.y = pk2(sp[2 * 33], sp[3 * 33]); o.z = pk2(sp[4 * 33], sp[5 * 33]); o.w = pk2(sp[6 * 33], sp[7 * 33]); \
              *(u32x4*)(WTm + (size_t)(n0 + n) * K + k0 + 8 * c) = o; } } \
        asm volatile("s_waitcnt lgkmcnt(0)" ::: "memory"); } while (0)
    long ia = it0, ib = it0 + step;
    P0_LOAD(RA, ia);
    if (ib < itend) P0_LOAD(RB, ib);
    for (;;) {
        const long ca = ia; P0_EMIT(RA, ca);
        ia = ib + step; if (ia < itend) P0_LOAD(RA, ia);
        if (ib >= itend) break;
        const long cb = ib; P0_EMIT(RB, cb);
        ib = ia + step; if (ib < itend) P0_LOAD(RB, ib);
        if (ia >= itend) break;
    }
#undef P0_LOAD
#undef P0_EMIT
}
__device__ __forceinline__ void p0_transpose_all(const float* W, bf16_t* WT, int nb, int K, int N, LAS float* scr, int gw, int ngw, int lane) {
    p0_transpose_range(W, WT, K, N, scr, gw, (long)nb * (K / 64) * (N / 32), ngw, lane);
}
#ifndef CVT_TAIL_CLAIMS
#define CVT_TAIL_CLAIMS 3
#endif
constexpr int CVT_GU = NE * (DM / 64) * (2 * DF / 32), CVT_DN = NE * (DF / 64) * (DM / 32), CVT_ITEMS = CVT_GU + CVT_DN;
constexpr int CW_CVT = 1024;
constexpr int LDS_CLAIM = LDSCTL_OFF + 960;
__device__ __forceinline__ void cvt_expert_weights(LAS unsigned char* lds, const float* wgu, const float* wdn, unsigned char* ws, int layer, int max_claims, int tid) {
    const int wave = __builtin_amdgcn_readfirstlane(tid >> 6), lane = tid & 63;
    LAS float* scr = (LAS float*)(lds + RING_OFF + wave * 16384);
    volatile LAS unsigned* cw = (volatile LAS unsigned*)(lds + LDS_CLAIM);
    unsigned* ctr = (unsigned*)(ws + OFF_CTL) + CW_CVT + 64 * layer;
    for (int r = 0; r < max_claims; ++r) {
        __syncthreads();
        if (tid == 0) *cw = __hip_atomic_fetch_add(ctr, 32u, RLX_AGENT);
        __syncthreads();
        const int base = __builtin_amdgcn_readfirstlane((int)*cw) + ((layer & 1) ? CVT_GU : 0);
        if (base >= CVT_ITEMS) break;
        const long it0 = base + 4 * wave;
        if (base < CVT_GU) p0_transpose_range(wgu + (size_t)layer * NE * DM * 2 * DF, (bf16_t*)(ws + OFF_WGU) + (size_t)layer * NE * 2 * DF * DM, DM, 2 * DF, scr, it0, it0 + 4, 1, lane);
        else p0_transpose_range(wdn + (size_t)layer * NE * DF * DM, (bf16_t*)(ws + OFF_WDN) + (size_t)layer * NE * DM * DF, DF, DM, scr, it0 - CVT_GU, it0 - CVT_GU + 4, 1, lane);
    }
    __syncthreads();
}

struct PPOrder {
    int G, c, lim; const char* A; const char* Bt;
    __device__ bool next(int i, pg8::Unit& u) const { const int L = i * G + c; if (L >= lim) return false; u.e = L >> 8; u.pm = (L & 255) >> 2; u.pn = L & 3; u.lrow0 = 0; u.nvalid = 256; return true; }
    __device__ __forceinline__ const char* a_base(const pg8::Unit& u) const { return A + ((size_t)u.e * T + (size_t)u.pm * 256) * DPLE * 2; }
    __device__ __forceinline__ const char* b_base(const pg8::Unit& u) const { return Bt + ((size_t)u.e * DM + (size_t)u.pn * 256) * DPLE * 2; }
    __device__ __forceinline__ void prep(const pg8::Unit&, int, int, int) const {}
    __device__ __forceinline__ void prep_load(const pg8::Unit&, int, int&, f32x4&) const {}
    __device__ __forceinline__ void prep_store(int, int, int, int, const f32x4&) const {}
    static constexpr bool HAS_PREP = false;
    LAS unsigned* roff;
};

constexpr int LDS_ROFF = LDSCTL_OFF + 2048;
constexpr int LDS_SLOT = LDSCTL_OFF + 3072;
constexpr int LDS_BIAS = LDSCTL_OFF + 5120;
constexpr int LDS_INVF = LDSCTL_OFF + 7168;
constexpr int LDS_TP = LDSCTL_OFF + 1024;
struct MoeOrder {
    LAS unsigned* roff; int G, c, nN; const LAS int* tp; const LAS int* cn; const int* elist; const char* A; const char* Bt; size_t bstride_e; bool gather;
    static __device__ __forceinline__ void setup(LAS unsigned char* lds, const unsigned* cnt) {
        LAS int* tp = (LAS int*)(lds + LDS_TP); LAS int* cn = (LAS int*)(lds + LDS_TP + 256);
        __syncthreads();
        if (threadIdx.x < NE) cn[threadIdx.x] = (int)__hip_atomic_load(cnt + threadIdx.x * 64, RLX_AGENT);
        __syncthreads();
        if (threadIdx.x == 0) { int a = 0; for (int e = 0; e < NE; ++e) { tp[e] = a; a += (cn[e] + 255) >> 8; } tp[NE] = a; }
        __syncthreads();
    }
    mutable int ehint = 0, nwg_c = -1;
    __device__ bool next(int i, pg8::Unit& u) const {
        if (nwg_c < 0) nwg_c = __builtin_amdgcn_readfirstlane(tp[NE]) * nN;
        const int nwg = nwg_c; const long L = (long)i * G + c; if (L >= nwg) return false;
        int wgid = (int)L; { const int q = nwg / 8, r = nwg % 8, xcd = wgid % 8, off = wgid / 8; wgid = (xcd < r ? xcd * (q + 1) : r * (q + 1) + (xcd - r) * q) + off; }
        int e = ehint; int t0 = __builtin_amdgcn_readfirstlane(tp[e]); if (wgid < t0 * nN) { e = 0; t0 = 0; }
        int t1 = __builtin_amdgcn_readfirstlane(tp[e + 1]);
        while (wgid >= t1 * nN) { ++e; t0 = t1; t1 = __builtin_amdgcn_readfirstlane(tp[e + 1]); }
        ehint = e;
        const int ce = __builtin_amdgcn_readfirstlane(cn[e]);
        const int w = wgid - t0 * nN, te = t1 - t0, m = w % te;
        u.pn = w / te; u.pm = t0 + m; u.e = e; u.lrow0 = m * 256; u.nvalid = ce - m * 256; return true;
    }
    __device__ __forceinline__ const char* a_base(const pg8::Unit& u) const { return gather ? A : A + (size_t)u.pm * 256 * DF * 2; }
    __device__ __forceinline__ const char* b_base(const pg8::Unit& u) const { return Bt + (size_t)u.e * bstride_e + (size_t)u.pn * 256 * DM * 2; }
    static constexpr bool HAS_PREP = true;
    const float* bias; int bias_e;
    LAS int* slotT; LAS float* biasT;
    __device__ __forceinline__ void prep(const pg8::Unit& u, int par, int tid, int K) const {
        if (tid < 256) { const int slot = tid < u.nvalid ? elist[(size_t)u.e * T + u.lrow0 + tid] : (gather ? 0 : NSLOT);
            if (gather) roff[tid] = (unsigned)(slot >> 2) * (unsigned)(K * 2); else slotT[par * 256 + tid] = slot; }
        else if (tid < 320) { const int q = tid - 256; const f32x4 b = *(const f32x4*)(bias + (size_t)u.e * bias_e + u.pn * 256 + 4 * q); *(LAS f32x4*)(biasT + par * 256 + 4 * q) = b; }
    }
    __device__ __forceinline__ void prep_load(const pg8::Unit& u, int tid, int& slot, f32x4& b) const {
        if (tid < 256) slot = tid < u.nvalid ? elist[(size_t)u.e * T + u.lrow0 + tid] : (gather ? 0 : NSLOT);
        else if (tid < 320) b = *(const f32x4*)(bias + (size_t)u.e * bias_e + u.pn * 256 + 4 * (tid - 256));
    }
    __device__ __forceinline__ void prep_store(int par, int tid, int K, int slot, const f32x4& b) const {
        if (tid < 256) { if (gather) roff[tid] = (unsigned)(slot >> 2) * (unsigned)(K * 2); else slotT[par * 256 + tid] = slot; }
        else if (tid < 320) *(LAS f32x4*)(biasT + par * 256 + 4 * (tid - 256)) = b;
    }
};
namespace pg8 {
struct EpiMoe1 {
    static constexpr bool PERM = true; static constexpr int NSTORE = 8;
    const LAS float* biasT; bf16_t* act;
    __device__ __forceinline__ void operator()(const f32x4 (&acc)[2][2][4][2], const Unit& u, int wr, int wc, int fr, int fq, int par) const {
        const int cl = wc * 32 + 8 * fq, colg = u.pn * BM + cl; const LAS float* bp = biasT + par * 256 + cl;
        const bool odd = (fq & 1) != 0;
#pragma unroll
        for (int ai = 0; ai < 2; ++ai)
#pragma unroll
            for (int mp = 0; mp < 2; ++mp) {
                const int lr = ai * HALF + wr * 64 + (2 * mp + (odd ? 1 : 0)) * 16 + fr;
                bf16_t* rowp = act + (size_t)(u.pm * BM + lr) * DF + (colg >> 1) - (odd ? 4 : 0);
#pragma unroll
                for (int bj = 0; bj < 2; ++bj) { u32x2 w[2];
#pragma unroll
                    for (int h = 0; h < 2; ++h) { const int m = 2 * mp + h; f32x4 G = acc[ai][bj][m][0], U = acc[ai][bj][m][1], R;
#pragma unroll
                        for (int q = 0; q < 4; ++q) { G[q] = fminf(G[q], 7.0f); U[q] = __builtin_amdgcn_fmed3f(U[q], -6.0f, 8.0f); }
                        const f32x4 X = G * (-1.702f * 1.4426950408889634f);
#pragma unroll
                        for (int q = 0; q < 4; ++q) R[q] = __builtin_amdgcn_exp2f(X[q]);
                        R = R + 1.0f;
#pragma unroll
                        for (int q = 0; q < 4; ++q) R[q] = __builtin_amdgcn_rcpf(R[q]);
                        const f32x4 A = U * (G * R);
                        w[h].x = cvt_pk_bf16(A[0], A[1]); w[h].y = cvt_pk_bf16(A[2], A[3]); }
                    const auto rx = __builtin_amdgcn_permlane16_swap(w[0].x, w[1].x, false, false), ry = __builtin_amdgcn_permlane16_swap(w[0].y, w[1].y, false, false);
                    *(u32x4*)(rowp + bj * (HALF / 2)) = (u32x4){rx[0], ry[0], rx[1], ry[1]}; }
                asm volatile("" ::: "memory"); }
    }
};
template <> struct InitOf<EpiMoe1> { static constexpr bool BIAS = true;
    static __device__ __forceinline__ void load(const EpiMoe1& E, f32x4 (&iv)[2][2], const Unit&, int par, int wc, int fq) { const LAS float* bp = E.biasT + par * 256 + wc * 32 + 8 * fq;
#pragma unroll
        for (int bj = 0; bj < 2; ++bj) { const f32x4 b0 = *(const LAS f32x4*)(bp + bj * HALF), b1 = *(const LAS f32x4*)(bp + bj * HALF + 4);
            iv[bj][0] = (f32x4){b0[0], b0[2], b1[0], b1[2]}; iv[bj][1] = (f32x4){b0[1], b0[3], b1[1], b1[3]} + 1.0f; } } };
template <> struct PermOf<EpiMoe1> { static __host__ __device__ __forceinline__ int f(int rho) { const int n = rho >> 4, i = rho & 15; return 8 * (i >> 2) + 2 * (i & 3) + n; } };
struct EpiMoe2 {
    static constexpr bool PERM = true; static constexpr int NSTORE = 16;
    const LAS float* biasT; bf16_t* yb; const LAS int* slotT;
    __device__ __forceinline__ void operator()(const f32x4 (&acc)[2][2][4][2], const Unit& u, int wr, int wc, int fr, int fq, int par) const {
        const int cl = wc * 32 + 8 * fq, col = u.pn * BM + cl; const LAS float* bp = biasT + par * 256 + cl;
#pragma unroll
        for (int ai = 0; ai < 2; ++ai)
#pragma unroll
            for (int m = 0; m < 4; ++m) { const int lr = ai * HALF + wr * 64 + m * 16 + fr;
                { const int slot = slotT[par * 256 + lr]; bf16_t* rowp = yb + (size_t)slot * DM + col;
#pragma unroll
                for (int bj = 0; bj < 2; ++bj) { const f32x4 v0 = acc[ai][bj][m][0], v1 = acc[ai][bj][m][1];
                    u32x4 w; w.x = cvt_pk_bf16(v0[0], v0[1]); w.y = cvt_pk_bf16(v0[2], v0[3]); w.z = cvt_pk_bf16(v1[0], v1[1]); w.w = cvt_pk_bf16(v1[2], v1[3]);
                    *(u32x4*)(rowp + bj * HALF) = w; } }
                asm volatile("" ::: "memory"); }
    }
};
template <> struct InitOf<EpiMoe2> { static constexpr bool BIAS = true;
    static __device__ __forceinline__ void load(const EpiMoe2& E, f32x4 (&iv)[2][2], const Unit&, int par, int wc, int fq) { const LAS float* bp = E.biasT + par * 256 + wc * 32 + 8 * fq;
#pragma unroll
        for (int bj = 0; bj < 2; ++bj)
#pragma unroll
            for (int n = 0; n < 2; ++n) iv[bj][n] = *(const LAS f32x4*)(bp + bj * HALF + 4 * n); } };
}

constexpr int XT_ST = 2064;
constexpr int O_XH = 0, O_XL = 16 * XT_ST, O_PT = 2 * 16 * XT_ST, PT_ST = 36;
__device__ __forceinline__ void ln1_router_phase(LAS unsigned char* ring, int G, int c, int wave, int lane, const bf16_t* __restrict__ xb_in, const bf16_t* __restrict__ mix, const float* __restrict__ lg, const float* __restrict__ lb,
                                                 const float* __restrict__ rw, const float* __restrict__ rb, bf16_t* __restrict__ x1b, LAS int* rt_e, LAS float* rt_g, LAS int* rt_p, LAS int* rt_c) {
    const int fr = lane & 15, fq = lane >> 4;
    bf16x8 bh[4][2], bl[4][2];
#pragma unroll
    for (int ks = 0; ks < 4; ++ks)
#pragma unroll
        for (int nt = 0; nt < 2; ++nt) { const float* wp = rw + (size_t)(128 * wave + 32 * ks + 8 * fq) * NE + 16 * nt + fr; unsigned h[4], l[4];
#pragma unroll
            for (int q = 0; q < 4; ++q) { const float w0 = wp[(2 * q) * NE], w1 = wp[(2 * q + 1) * NE]; h[q] = pg8::cvt_pk_bf16(w0, w1);
                l[q] = pg8::cvt_pk_bf16(w0 - __uint_as_float(h[q] << 16), w1 - __uint_as_float(h[q] & 0xffff0000u)); }
            bh[ks][nt] = __builtin_bit_cast(bf16x8, (u32x4){h[0], h[1], h[2], h[3]}); bl[ks][nt] = __builtin_bit_cast(bf16x8, (u32x4){l[0], l[1], l[2], l[3]}); }
    const int nrow = 2 * G * NWAVES, t0 = 2 * (c * NWAVES + wave);
    const int nsw = (T - 2 * c * NWAVES + nrow - 1) / nrow;
    const float rbv = rb[lane & 31];
    u32x2 ra[2][4], rm[2][4];
#pragma unroll
    for (int r = 0; r < 2; ++r)
#pragma unroll
        for (int j = 0; j < 4; ++j) { const size_t o = (size_t)(t0 + r) * DM + 4 * lane + 256 * j; ra[r][j] = *(const u32x2*)(xb_in + o); rm[r][j] = *(const u32x2*)(mix + o); }
    for (int sweep = 0; sweep < nsw; ++sweep) {
        const int t = t0 + sweep * nrow;
#pragma unroll
        for (int r = 0; r < 2; ++r) {
            f32x4 y[4]; float s = 0.f; const size_t ro = (size_t)(t + r) * DM;
#pragma unroll
            for (int j = 0; j < 4; ++j) { const u32x2 aw = ra[r][j], mw = rm[r][j];
                y[j] = (f32x4){bf2f(aw.x & 0xffffu), bf2f(aw.x >> 16), bf2f(aw.y & 0xffffu), bf2f(aw.y >> 16)} * DN_ALPHA + (f32x4){bf2f(mw.x & 0xffffu), bf2f(mw.x >> 16), bf2f(mw.y & 0xffffu), bf2f(mw.y >> 16)};
                s += (y[j].x + y[j].y) + (y[j].z + y[j].w); }
            const float mean = wave_sum(s) * (1.0f / DM); float s2 = 0.f;
#pragma unroll
            for (int j = 0; j < 4; ++j) { y[j] = y[j] - mean; s2 += (y[j].x * y[j].x + y[j].y * y[j].y) + (y[j].z * y[j].z + y[j].w * y[j].w); }
            const float rstd = 1.0f / sqrtf(wave_sum(s2) * (1.0f / DM) + LN_EPS);
#pragma unroll
            for (int j = 0; j < 4; ++j) { const int cc = 4 * lane + 256 * j; const f32x4 gv = *(const f32x4*)(lg + cc), bv = *(const f32x4*)(lb + cc);
                const f32x4 o = y[j] * rstd * gv + bv;
                u32x2 hb; hb.x = pg8::cvt_pk_bf16(o.x, o.y); hb.y = pg8::cvt_pk_bf16(o.z, o.w); *(u32x2*)(x1b + ro + cc) = hb;
                u32x2 lw; lw.x = pg8::cvt_pk_bf16(o.x - __uint_as_float(hb.x << 16), o.y - __uint_as_float(hb.x & 0xffff0000u)); lw.y = pg8::cvt_pk_bf16(o.z - __uint_as_float(hb.y << 16), o.w - __uint_as_float(hb.y & 0xffff0000u));
                *(LAS u32x2*)(ring + O_XH + (2 * wave + r) * XT_ST + cc * 2) = hb; *(LAS u32x2*)(ring + O_XL + (2 * wave + r) * XT_ST + cc * 2) = lw; }
        }
        asm volatile("s_waitcnt lgkmcnt(0)" ::: "memory"); __builtin_amdgcn_s_barrier(); asm volatile("" ::: "memory");
        if (sweep + 1 < nsw) {
#pragma unroll
            for (int r = 0; r < 2; ++r)
#pragma unroll
                for (int j = 0; j < 4; ++j) { const size_t o = (size_t)(t + nrow + r) * DM + 4 * lane + 256 * j; ra[r][j] = *(const u32x2*)(xb_in + o); rm[r][j] = *(const u32x2*)(mix + o); }
        }
        f32x4 cacc[2] = {(f32x4){0.f, 0.f, 0.f, 0.f}, (f32x4){0.f, 0.f, 0.f, 0.f}};
        { LAS const unsigned char* ap = ring + fr * XT_ST + (128 * wave + 8 * fq) * 2;
#pragma unroll
          for (int ks = 0; ks < 4; ++ks) { const bf16x8 ah = *(LAS const bf16x8*)(ap + O_XH + 64 * ks), al = *(LAS const bf16x8*)(ap + O_XL + 64 * ks);
#pragma unroll
              for (int nt = 0; nt < 2; ++nt) { cacc[nt] = __builtin_amdgcn_mfma_f32_16x16x32_bf16(ah, bh[ks][nt], cacc[nt], 0, 0, 0); cacc[nt] = __builtin_amdgcn_mfma_f32_16x16x32_bf16(al, bh[ks][nt], cacc[nt], 0, 0, 0);
                  cacc[nt] = __builtin_amdgcn_mfma_f32_16x16x32_bf16(ah, bl[ks][nt], cacc[nt], 0, 0, 0); } } }
        { LAS float* pt = (LAS float*)(ring + O_PT) + (wave * 16 + 4 * fq) * PT_ST + fr;
#pragma unroll
          for (int nt = 0; nt < 2; ++nt)
#pragma unroll
              for (int i = 0; i < 4; ++i) pt[i * PT_ST + 16 * nt] = cacc[nt][i]; }
        asm volatile("s_waitcnt lgkmcnt(0)" ::: "memory"); __builtin_amdgcn_s_barrier(); asm volatile("" ::: "memory");
        const int e = lane & 31;
        float vcur;
        { LAS const float* pt = (LAS const float*)(ring + O_PT) + (2 * wave + (lane >> 5)) * PT_ST + e; float v = 0.f;
#pragma unroll
          for (int w = 0; w < 8; ++w) v += pt[w * 16 * PT_ST];
          vcur = v + rbv; }
        float topv[4]; int topi[4];
#pragma unroll
        for (int kk = 0; kk < 4; ++kk) {
            float m = vcur;
            m = fmaxf(m, dpp_f<0xB1>(m)); m = fmaxf(m, dpp_f<0x4E>(m)); m = fmaxf(m, dpp_f<0x141>(m)); m = fmaxf(m, dpp_f<0x140>(m));
            const float h0 = fmaxf(lane_f(m, 0), lane_f(m, 16)), h1 = fmaxf(lane_f(m, 32), lane_f(m, 48));
            const float mx = lane < 32 ? h0 : h1;
            const unsigned long long bal = __ballot(vcur == mx);
            const int i0 = __builtin_ctz((unsigned)bal), i1 = __builtin_ctz((unsigned)(bal >> 32));
            const int bi = lane < 32 ? i0 : i1;
            topv[kk] = mx; topi[kk] = bi; if (e == bi) vcur = -INFINITY;
        }
        const float e1 = __expf(topv[1] - topv[0]), e2 = __expf(topv[2] - topv[0]), e3 = __expf(topv[3] - topv[0]);
        const float inv = 1.0f / (1.0f + e1 + e2 + e3);
        if (e < 4) {
            const int ee = e == 0 ? topi[0] : e == 1 ? topi[1] : e == 2 ? topi[2] : topi[3];
            const float gg = (e == 0 ? 1.0f : e == 1 ? e1 : e == 2 ? e2 : e3) * inv;
            const int sl = (16 * sweep + 2 * wave + (lane >> 5)) * 4 + e;
            rt_e[sl] = ee; rt_g[sl] = gg; rt_p[sl] = (int)__hip_atomic_fetch_add((LAS unsigned*)(rt_c + ee), 1u, __ATOMIC_RELAXED, __HIP_MEMORY_SCOPE_WORKGROUP);
        }
    }
}
__device__ __forceinline__ void ln2_row(int t, int lane, const bf16_t* __restrict__ x1b, const bf16_t* __restrict__ yb, const float* __restrict__ gates, const float* __restrict__ lg, const float* __restrict__ lb,
                                        bf16_t* __restrict__ x2b) {
    const float g0 = gates[t * 4], g1 = gates[t * 4 + 1], g2 = gates[t * 4 + 2], g3 = gates[t * 4 + 3];
    f32x4 y[4]; float s = 0.f;
#pragma unroll
    for (int j = 0; j < 4; ++j) { const int c = 4 * lane + 256 * j; const u32x2 aw = __builtin_nontemporal_load((const u32x2*)(x1b + (size_t)t * DM + c)); const f32x4 a = (f32x4){bf2f(aw.x & 0xffffu), bf2f(aw.x >> 16), bf2f(aw.y & 0xffffu), bf2f(aw.y >> 16)};
        f32x4 f = (f32x4){0.f, 0.f, 0.f, 0.f};
#pragma unroll
        for (int kk = 0; kk < 4; ++kk) { const u32x2 w = __builtin_nontemporal_load((const u32x2*)(yb + (size_t)(t * 4 + kk) * DM + c)); const float gk = kk == 0 ? g0 : kk == 1 ? g1 : kk == 2 ? g2 : g3;
            f.x += gk * bf2f(w.x & 0xffffu); f.y += gk * bf2f(w.x >> 16); f.z += gk * bf2f(w.y & 0xffffu); f.w += gk * bf2f(w.y >> 16); }
        y[j] = a * DN_ALPHA + f; s += (y[j].x + y[j].y) + (y[j].z + y[j].w); }
    const float mean = wave_sum(s) * (1.0f / DM); float s2 = 0.f;
#pragma unroll
    for (int j = 0; j < 4; ++j) { y[j] = y[j] - mean; s2 += (y[j].x * y[j].x + y[j].y * y[j].y) + (y[j].z * y[j].z + y[j].w * y[j].w); }
    const float rstd = 1.0f / sqrtf(wave_sum(s2) * (1.0f / DM) + LN_EPS);
#pragma unroll
    for (int j = 0; j < 4; ++j) { const int c = 4 * lane + 256 * j; const f32x4 gv = *(const f32x4*)(lg + c), bv = *(const f32x4*)(lb + c);
        const f32x4 o = y[j] * rstd * gv + bv;
        u32x2 pb; pb.x = pk2(o.x, o.y); pb.y = pk2(o.z, o.w); *(u32x2*)(x2b + (size_t)t * DM + c) = pb; }
}
__device__ __forceinline__ void ln2_row2(int ta, int tb, int lane, const bf16_t* __restrict__ x1b, const bf16_t* __restrict__ yb, const float* __restrict__ gates, const float* __restrict__ lg, const float* __restrict__ lb,
                                         bf16_t* __restrict__ x2b) {
    u32x2 xa[2][4], ya[2][4][4]; float gk[2][4];
#pragma unroll
    for (int r = 0; r < 2; ++r) { const int t = r ? tb : ta;
#pragma unroll
        for (int kk = 0; kk < 4; ++kk) gk[r][kk] = gates[t * 4 + kk];
#pragma unroll
        for (int j = 0; j < 4; ++j) { const int c = 4 * lane + 256 * j; xa[r][j] = __builtin_nontemporal_load((const u32x2*)(x1b + (size_t)t * DM + c));
#pragma unroll
            for (int kk = 0; kk < 4; ++kk) ya[r][j][kk] = __builtin_nontemporal_load((const u32x2*)(yb + (size_t)(t * 4 + kk) * DM + c)); } }
    __builtin_amdgcn_sched_barrier(0);
#pragma unroll
    for (int r = 0; r < 2; ++r) { const int t = r ? tb : ta;
        f32x4 y[4]; float s = 0.f;
#pragma unroll
        for (int j = 0; j < 4; ++j) { const u32x2 aw = xa[r][j]; const f32x4 a = (f32x4){bf2f(aw.x & 0xffffu), bf2f(aw.x >> 16), bf2f(aw.y & 0xffffu), bf2f(aw.y >> 16)};
            f32x4 f = (f32x4){0.f, 0.f, 0.f, 0.f};
#pragma unroll
            for (int kk = 0; kk < 4; ++kk) { const u32x2 w = ya[r][j][kk]; const float g = gk[r][kk];
                f.x += g * bf2f(w.x & 0xffffu); f.y += g * bf2f(w.x >> 16); f.z += g * bf2f(w.y & 0xffffu); f.w += g * bf2f(w.y >> 16); }
            y[j] = a * DN_ALPHA + f; s += (y[j].x + y[j].y) + (y[j].z + y[j].w); }
        const float mean = wave_sum(s) * (1.0f / DM); float s2 = 0.f;
#pragma unroll
        for (int j = 0; j < 4; ++j) { y[j] = y[j] - mean; s2 += (y[j].x * y[j].x + y[j].y * y[j].y) + (y[j].z * y[j].z + y[j].w * y[j].w); }
        const float rstd = 1.0f / sqrtf(wave_sum(s2) * (1.0f / DM) + LN_EPS);
#pragma unroll
        for (int j = 0; j < 4; ++j) { const int c = 4 * lane + 256 * j; const f32x4 gv = *(const f32x4*)(lg + c), bv = *(const f32x4*)(lb + c);
            const f32x4 o = y[j] * rstd * gv + bv;
            u32x2 pb; pb.x = pk2(o.x, o.y); pb.y = pk2(o.z, o.w); *(u32x2*)(x2b + (size_t)t * DM + c) = pb; }
    }
}
typedef _Float16 f16x8 __attribute__((ext_vector_type(8)));
typedef _Float16 f16x2 __attribute__((ext_vector_type(2)));
typedef float f32x16 __attribute__((ext_vector_type(16)));
typedef short s16x4 __attribute__((ext_vector_type(4)));
__device__ __forceinline__ s16x4 lds_tr16(LAS const unsigned char* p) { return __builtin_bit_cast(s16x4, __builtin_amdgcn_ds_read_tr16_b64_v4i16((LAS s16x4*)p)); }
__device__ __forceinline__ bf16x8 cat4(s16x4 a, s16x4 b) { return __builtin_shufflevector(a, b, 0, 1, 2, 3, 4, 5, 6, 7); }
__device__ __forceinline__ unsigned cvtpk_c(float lo, float hi) { return pg8::cvt_pk_bf16(lo, hi); }
__device__ __forceinline__ float fexp2(float x) { return __builtin_amdgcn_exp2f(x); }
__device__ __forceinline__ float flog2(float x) { return __builtin_amdgcn_logf(x); }

namespace sb {
constexpr int KST = 144, SUB_B = 32 * KST, SLOT_B = 2 * SUB_B, NSLOT_R = 10;
__device__ __forceinline__ void attn_phase(LAS unsigned char* lds, const bf16_t* __restrict__ Q, const bf16_t* __restrict__ K, const bf16_t* __restrict__ V, bf16_t* __restrict__ O, int G, int c) {
    int tid = threadIdx.x; asm volatile("" : "+v"(tid));
    const int wid = __builtin_amdgcn_readfirstlane(tid >> 6), lane = tid & 63, n = lane & 31, hi = lane >> 5;
    f16x8 U0, U1, ONE;
#pragma unroll
    for (int j = 0; j < 8; ++j) { const int jp = 8 * (j >> 2) + 4 * hi + (j & 3); U0[j] = (jp > n) ? (_Float16)1.0f : (_Float16)0.0f; U1[j] = (16 + jp > n) ? (_Float16)1.0f : (_Float16)0.0f; ONE[j] = (_Float16)1.0f; }
    const int half = tid >> 8, srow = (tid & 255) >> 3, sch = tid & 7;
    const int trq = (lane & 15) >> 2, trp = lane & 3, blk = (lane >> 4) & 1;
    LAS unsigned* flg = (LAS unsigned*)(lds + NSLOT_R * SLOT_B);
    for (int it = 0;; ++it) {
        const int L = it * G + c; if (L >= NB * SH * 8) break;
        const int bh = L >> 3, qp = L & 7, qb = ((L >> 8) & 1) ? 7 - qp : qp, b = bh >> 4, h = bh & 15;
        const size_t rowbase = (size_t)b * SEQ;
        const int q0 = qb * 256 + wid * 32;
        bf16x8 qf[4];
        { const bf16_t* qrow = Q + (rowbase + q0 + n) * DM + h * SD + 8 * hi;
#pragma unroll
          for (int ks = 0; ks < 4; ++ks) qf[ks] = *(const bf16x8*)(qrow + 16 * ks); }
        f32x16 o0, o1, carry;
#pragma unroll
        for (int r = 0; r < 16; ++r) { o0[r] = 0.f; o1[r] = 0.f; carry[r] = 0.f; }
        const bf16_t* sg = (half ? V : K) + (rowbase + srow) * DM + h * SD + sch * 8;
        const int soff = half * SUB_B + srow * KST + sch * 16;
        { u32x4 r[9];
#pragma unroll
          for (int x = 0; x < 9; ++x) { const int g = 8 * qb + 7 - x; if (g >= 0) r[x] = *(const u32x4*)(sg + (size_t)g * 32 * DM); }
#pragma unroll
          for (int x = 0; x < 9; ++x) { const int g = 8 * qb + 7 - x; if (g >= 0) *(LAS u32x4*)(lds + (g % NSLOT_R) * SLOT_B + soff) = r[x]; } }
        asm volatile("s_waitcnt lgkmcnt(0)" ::: "memory"); __builtin_amdgcn_s_barrier(); asm volatile("" ::: "memory");
        int par = 0, j = 0;
        for (;; ++j) {
            const int gpre = 8 * qb - j - 2;
            u32x4 pr; if (gpre >= 0) pr = *(const u32x4*)(sg + (size_t)gpre * 32 * DM);
            const int g = 8 * qb + wid - j;
            int fin;
            {
                const bool diag = (j == 0);
                LAS const unsigned char* kb = lds + (g % NSLOT_R) * SLOT_B; LAS const unsigned char* vb = kb + SUB_B;
                f32x16 z;
#pragma unroll
                for (int r = 0; r < 16; ++r) z[r] = 0.f;
                bf16x8 kf[4], vaf[2], vcf[2];
                { LAS const unsigned char* kp = kb + n * KST + hi * 16;
#pragma unroll
                  for (int ks = 0; ks < 4; ++ks) kf[ks] = *(LAS const bf16x8*)(kp + ks * 32);
                  LAS const unsigned char* vp = vb + (4 * hi + trq) * KST + (16 * blk + 4 * trp) * 2;
#pragma unroll
                  for (int s2 = 0; s2 < 2; ++s2) { vaf[s2] = cat4(lds_tr16(vp + (16 * s2) * KST), lds_tr16(vp + (16 * s2 + 8) * KST)); vcf[s2] = cat4(lds_tr16(vp + (16 * s2) * KST + 64), lds_tr16(vp + (16 * s2 + 8) * KST + 64)); }
                  __builtin_amdgcn_sched_barrier(0);
#pragma unroll
                  for (int ks = 0; ks < 4; ++ks) z = __builtin_amdgcn_mfma_f32_32x32x16_bf16(kf[ks], qf[ks], z, 0, 0, 0); }
                f16x8 lf0, lf1;
                { f32x16 t, mx;
#pragma unroll
                  for (int r = 0; r < 16; ++r) t[r] = fexp2(-fabsf(z[r]));
                  t = t + 1.0f;
#pragma unroll
                  for (int r = 0; r < 16; ++r) { t[r] = flog2(t[r]); mx[r] = __builtin_amdgcn_fmed3f(z[r], 0.f, 3.0e38f); }
                  f32x16 l = (-mx) - t;
                  z = z + l;
                  if (diag) {
#pragma unroll
                      for (int r = 0; r < 16; ++r) { const bool valid = ((r & 3) + 8 * (r >> 2) + 4 * hi) < n; l[r] = valid ? l[r] : 0.f; z[r] = valid ? z[r] : -INFINITY; } }
                  unsigned hw[8];
#pragma unroll
                  for (int r2 = 0; r2 < 8; ++r2) { const pg8::f32x2_t pr2 = {l[2 * r2], l[2 * r2 + 1]}; hw[r2] = __builtin_bit_cast(unsigned, __builtin_convertvector(pr2, f16x2)); }
                  lf0 = __builtin_bit_cast(f16x8, (u32x4){hw[0], hw[1], hw[2], hw[3]}); lf1 = __builtin_bit_cast(f16x8, (u32x4){hw[4], hw[5], hw[6], hw[7]}); }
                f32x16 y = carry;
                y = __builtin_amdgcn_mfma_f32_32x32x16_f16(U0, lf0, y, 0, 0, 0); y = __builtin_amdgcn_mfma_f32_32x32x16_f16(U1, lf1, y, 0, 0, 0);
                carry = __builtin_amdgcn_mfma_f32_32x32x16_f16(ONE, lf0, carry, 0, 0, 0); carry = __builtin_amdgcn_mfma_f32_32x32x16_f16(ONE, lf1, carry, 0, 0, 0);
                bf16x8 pf0, pf1;
                { unsigned w[8]; const f32x16 zy = z + y;
#pragma unroll
                  for (int r2 = 0; r2 < 8; ++r2) w[r2] = cvtpk_c(fexp2(zy[2 * r2]), fexp2(zy[2 * r2 + 1]));
                  pf0 = __builtin_bit_cast(bf16x8, (u32x4){w[0], w[1], w[2], w[3]}); pf1 = __builtin_bit_cast(bf16x8, (u32x4){w[4], w[5], w[6], w[7]}); }
#pragma unroll
                for (int s = 0; s < 2; ++s) {
                    o0 = __builtin_amdgcn_mfma_f32_32x32x16_bf16(vaf[s], s ? pf1 : pf0, o0, 0, 0, 0);
                    o1 = __builtin_amdgcn_mfma_f32_32x32x16_bf16(vcf[s], s ? pf1 : pf0, o1, 0, 0, 0);
                }
                fin = (__all(carry[0] < -160.0f) || g == 0) ? 1 : 0;
            }
            if (lane == 0) flg[par * 8 + wid] = (unsigned)fin;
            if (gpre >= 0) *(LAS u32x4*)(lds + (gpre % NSLOT_R) * SLOT_B + soff) = pr;
            asm volatile("s_waitcnt lgkmcnt(0)" ::: "memory"); __builtin_amdgcn_s_barrier(); asm volatile("" ::: "memory");
            par ^= 1;
            if (fin) { ++j; break; }
        }
        bf16_t* orow = O + (rowbase + q0 + n) * DM + h * SD + 4 * hi;
#pragma unroll
        for (int g4 = 0; g4 < 4; ++g4) {
            u32x2 w0, w1; w0.x = pg8::cvt_pk_bf16(o0[4 * g4], o0[4 * g4 + 1]); w0.y = pg8::cvt_pk_bf16(o0[4 * g4 + 2], o0[4 * g4 + 3]);
            w1.x = pg8::cvt_pk_bf16(o1[4 * g4], o1[4 * g4 + 1]); w1.y = pg8::cvt_pk_bf16(o1[4 * g4 + 2], o1[4 * g4 + 3]);
            *(u32x2*)(orow + 8 * g4) = w0; *(u32x2*)(orow + 32 + 8 * g4) = w1; }
        for (;; ++j) {
            { const unsigned f = lane < 8 ? flg[(par ^ 1) * 8 + lane] : 1u; if (__all(f != 0u)) break; }
            const int gpre = 8 * qb - j - 2;
            u32x4 pr; if (gpre >= 0) pr = *(const u32x4*)(sg + (size_t)gpre * 32 * DM);
            if (lane == 0) flg[par * 8 + wid] = 1u;
            if (gpre >= 0) *(LAS u32x4*)(lds + (gpre % NSLOT_R) * SLOT_B + soff) = pr;
            asm volatile("s_waitcnt lgkmcnt(0)" ::: "memory"); __builtin_amdgcn_s_barrier(); asm volatile("" ::: "memory");
            par ^= 1;
        }
        asm volatile("s_waitcnt lgkmcnt(0)" ::: "memory"); __builtin_amdgcn_s_barrier(); asm volatile("" ::: "memory");
    }
}
}

namespace ret {
constexpr int QST = 528, VST = 144;
constexpr int O_Q = 0, O_K = 64 * QST, O_ST = 2 * 64 * QST, O_V = 3 * 64 * QST, O_VD = O_V + 64 * VST, O_P = O_VD + 64 * VST, LDS_END = O_P + 64 * VST;
static_assert(LDS_END <= 131072, "retention LDS");
__device__ __forceinline__ void scan_phase(LAS unsigned char* lds, const bf16_t* __restrict__ Q, const bf16_t* __restrict__ K, const bf16_t* __restrict__ V, bf16_t* __restrict__ RO, int G, int c, const float* __restrict__ cw, bf16_t* __restrict__ cwt) {
    int tid = threadIdx.x; asm volatile("" : "+v"(tid));
    const int wid = __builtin_amdgcn_readfirstlane(tid >> 6), lane = tid & 63, lr = lane & 15, g = lane >> 4;
    const int trq = (lane & 15) >> 2, trp = lane & 3;
    const int tqt = wid >> 1, e2 = 2 * (wid & 1);
    for (int it = 0;; ++it) {
        const int L = it * G + c; if (L >= NB * RH * 8) break;
        const int bh = (L & 7) * 4 + (L >> 6), es = (L >> 3) & 7, b = bh >> 2, h = bh & 3;
        const size_t rowbase = (size_t)b * SEQ;
        const float lg2 = flog2(1.0f - fexp2(-5.0f - (float)h));
        const float cdec = fexp2(lg2 * 64.0f);
        f32x4 S[2][4];
#pragma unroll
        for (int a = 0; a < 2; ++a)
#pragma unroll
            for (int e = 0; e < 4; ++e) S[a][e] = (f32x4){0.f, 0.f, 0.f, 0.f};
        const bf16_t* qg = Q + (rowbase + (tid >> 5)) * DM + h * RDK + (tid & 31) * 8; const bf16_t* kg = K + (rowbase + (tid >> 5)) * DM + h * RDK + (tid & 31) * 8;
        const bf16_t* vg = V + (rowbase + (tid >> 3)) * RHV + h * RDV + es * 64 + (tid & 7) * 8;
        const int sq = (tid >> 5) * QST + (tid & 31) * 16, sv = (tid >> 3) * VST + (tid & 7) * 16;
        const float kdv = fexp2(lg2 * (float)(63 - (tid >> 3)));
        u32x4 rq[4], rk[4], rv;
#pragma unroll
        for (int i = 0; i < 4; ++i) { rq[i] = *(const u32x4*)(qg + (size_t)(16 * i) * DM); rk[i] = *(const u32x4*)(kg + (size_t)(16 * i) * DM); }
        rv = *(const u32x4*)vg;
        __builtin_amdgcn_s_barrier();
        for (int ci = 0; ci < SEQ / 64; ++ci) {
#pragma unroll
            for (int i = 0; i < 4; ++i) { *(LAS u32x4*)(lds + O_Q + sq + 16 * i * QST) = rq[i]; *(LAS u32x4*)(lds + O_K + sq + 16 * i * QST) = rk[i]; }
            { *(LAS u32x4*)(lds + O_V + sv) = rv;
              u32x4 d; d.x = pk2(bf2f(rv.x & 0xffffu) * kdv, bf2f(rv.x >> 16) * kdv); d.y = pk2(bf2f(rv.y & 0xffffu) * kdv, bf2f(rv.y >> 16) * kdv);
              d.z = pk2(bf2f(rv.z & 0xffffu) * kdv, bf2f(rv.z >> 16) * kdv); d.w = pk2(bf2f(rv.w & 0xffffu) * kdv, bf2f(rv.w >> 16) * kdv);
              *(LAS u32x4*)(lds + O_VD + sv) = d; }
#pragma unroll
            for (int a = 0; a < 2; ++a)
#pragma unroll
                for (int e = 0; e < 4; ++e) { u32x2 w; w.x = pg8::cvt_pk_bf16(S[a][e][0], S[a][e][1]); w.y = pg8::cvt_pk_bf16(S[a][e][2], S[a][e][3]);
                    *(LAS u32x2*)(lds + O_ST + (16 * e + lr) * QST + (32 * wid + 16 * a + 4 * g) * 2) = w; }
            asm volatile("s_waitcnt lgkmcnt(0)" ::: "memory"); __builtin_amdgcn_s_barrier(); asm volatile("" ::: "memory");
            if (ci + 1 < SEQ / 64) {
#pragma unroll
                for (int i = 0; i < 4; ++i) { rq[i] = *(const u32x4*)(qg + (size_t)((ci + 1) * 64 + 16 * i) * DM); rk[i] = *(const u32x4*)(kg + (size_t)((ci + 1) * 64 + 16 * i) * DM); }
                rv = *(const u32x4*)(vg + (size_t)(ci + 1) * 64 * RHV);
            }
            float cv[16]; size_t cdst = 0;
            if (cw) { const int item = (L * 8 + wid) * 8 + (ci >> 2), sub = ci & 3, m = item >> 9, kb = (item >> 5) & 15, nb = item & 31;
                const float* su = cw + ((size_t)m * DM + kb * 64) * (2 * DF) + nb * 64 + sub * 16;
                const int lo = (lane >> 4) * 16 * (2 * DF) + (lane & 15);
#pragma unroll
                for (int j = 0; j < 16; ++j) { const float* sj = su + (size_t)j * (2 * DF); asm volatile("" : "+s"(sj)); cv[j] = ((const GAS float*)sj)[lo]; }
                cdst = ((size_t)m * 2 * DF + nb * 64 + sub * 16 + (lane & 15)) * DM + kb * 64 + (lane >> 4) * 16; }
            f32x4 pacc[2], oacc[2];
#pragma unroll
            for (int x = 0; x < 2; ++x) { pacc[x] = (f32x4){0.f, 0.f, 0.f, 0.f}; oacc[x] = (f32x4){0.f, 0.f, 0.f, 0.f}; }
            { LAS const unsigned char* qp = lds + O_Q + (16 * tqt + lr) * QST + 16 * g;
              LAS const unsigned char* kp = lds + O_K + (16 * e2 + lr) * QST + 16 * g;
              LAS const unsigned char* sp = lds + O_ST + (16 * e2 + lr) * QST + 16 * g;
#pragma unroll
              for (int ks = 0; ks < 8; ++ks) {
                  const bf16x8 qa = *(LAS const bf16x8*)(qp + 64 * ks);
                  const bf16x8 k0 = *(LAS const bf16x8*)(kp + 64 * ks), k1 = *(LAS const bf16x8*)(kp + 16 * QST + 64 * ks);
                  const bf16x8 s0 = *(LAS const bf16x8*)(sp + 64 * ks), s1 = *(LAS const bf16x8*)(sp + 16 * QST + 64 * ks);
                  pacc[0] = __builtin_amdgcn_mfma_f32_16x16x32_bf16(k0, qa, pacc[0], 0, 0, 0); pacc[1] = __builtin_amdgcn_mfma_f32_16x16x32_bf16(k1, qa, pacc[1], 0, 0, 0);
                  oacc[0] = __builtin_amdgcn_mfma_f32_16x16x32_bf16(s0, qa, oacc[0], 0, 0, 0); oacc[1] = __builtin_amdgcn_mfma_f32_16x16x32_bf16(s1, qa, oacc[1], 0, 0, 0);
              } }
#pragma unroll
            for (int x = 0; x < 2; ++x) { float pv[4];
#pragma unroll
                for (int i = 0; i < 4; ++i) { const int dist = (16 * tqt + lr) - (16 * (e2 + x) + 4 * g + i); pv[i] = pacc[x][i] * fexp2(lg2 * fabsf((float)dist)); }
                u32x2 w; w.x = pg8::cvt_pk_bf16(pv[0], pv[1]); w.y = pg8::cvt_pk_bf16(pv[2], pv[3]);
                *(LAS u32x2*)(lds + O_P + (16 * tqt + lr) * VST + (16 * (e2 + x) + 4 * g) * 2) = w; }
            { const float qd = fexp2(lg2 * (float)(16 * tqt + lr + 1)); oacc[0] = oacc[0] * qd; oacc[1] = oacc[1] * qd; }
            asm volatile("s_waitcnt lgkmcnt(0)" ::: "memory"); __builtin_amdgcn_s_barrier(); asm volatile("" ::: "memory");
            { LAS const unsigned char* pp = lds + O_P + (16 * tqt + lr) * VST + 16 * g;
              LAS const unsigned char* vp = lds + O_V + (8 * g + trq) * VST + (16 * e2 + 4 * trp) * 2;
#pragma unroll
              for (int ks = 0; ks < 2; ++ks) {
                  const bf16x8 pa = *(LAS const bf16x8*)(pp + 64 * ks);
                  const bf16x8 v0 = cat4(lds_tr16(vp + (32 * ks) * VST), lds_tr16(vp + (32 * ks + 4) * VST));
                  const bf16x8 v1 = cat4(lds_tr16(vp + (32 * ks) * VST + 32), lds_tr16(vp + (32 * ks + 4) * VST + 32));
                  oacc[0] = __builtin_amdgcn_mfma_f32_16x16x32_bf16(v0, pa, oacc[0], 0, 0, 0); oacc[1] = __builtin_amdgcn_mfma_f32_16x16x32_bf16(v1, pa, oacc[1], 0, 0, 0);
              } }
            { bf16_t* op = RO + (rowbase + ci * 64 + 16 * tqt + lr) * RHV + h * RDV + es * 64 + 16 * e2 + 4 * g;
#pragma unroll
              for (int x = 0; x < 2; ++x) { u32x2 w; w.x = pk2(oacc[x][0], oacc[x][1]); w.y = pk2(oacc[x][2], oacc[x][3]); *(u32x2*)(op + 16 * x) = w; } }
#pragma unroll
            for (int a = 0; a < 2; ++a)
#pragma unroll
                for (int e = 0; e < 4; ++e) S[a][e] = S[a][e] * cdec;
            { LAS const unsigned char* ktp = lds + O_K + (8 * g + trq) * QST + (32 * wid + 4 * trp) * 2;
              LAS const unsigned char* vtp = lds + O_VD + (8 * g + trq) * VST + (4 * trp) * 2;
#pragma unroll
              for (int ks = 0; ks < 2; ++ks) {
                  bf16x8 ka[2], vb[4];
#pragma unroll
                  for (int a = 0; a < 2; ++a) ka[a] = cat4(lds_tr16(ktp + (32 * ks) * QST + 32 * a), lds_tr16(ktp + (32 * ks + 4) * QST + 32 * a));
#pragma unroll
                  for (int e = 0; e < 4; ++e) vb[e] = cat4(lds_tr16(vtp + (32 * ks) * VST + 32 * e), lds_tr16(vtp + (32 * ks + 4) * VST + 32 * e));
#pragma unroll
                  for (int a = 0; a < 2; ++a)
#pragma unroll
                      for (int e = 0; e < 4; ++e) S[a][e] = __builtin_amdgcn_mfma_f32_16x16x32_bf16(ka[a], vb[e], S[a][e], 0, 0, 0);
              } }
            if (cw) { u32x4 w0, w1; w0.x = pk2(cv[0], cv[1]); w0.y = pk2(cv[2], cv[3]); w0.z = pk2(cv[4], cv[5]); w0.w = pk2(cv[6], cv[7]);
                w1.x = pk2(cv[8], cv[9]); w1.y = pk2(cv[10], cv[11]); w1.z = pk2(cv[12], cv[13]); w1.w = pk2(cv[14], cv[15]);
                *(u32x4*)(cwt + cdst) = w0; *(u32x4*)(cwt + cdst + 8) = w1; }
            asm volatile("s_waitcnt lgkmcnt(0)" ::: "memory"); __builtin_amdgcn_s_barrier(); asm volatile("" ::: "memory");
        }
    }
}
__device__ __forceinline__ void gate_row(int w, int lane, const bf16_t* __restrict__ ro, const bf16_t* __restrict__ g, bf16_t* __restrict__ gn) {
    const u32x4 rw = __builtin_nontemporal_load((const u32x4*)(ro + (size_t)w * RDV + 8 * lane)), gw = __builtin_nontemporal_load((const u32x4*)(g + (size_t)w * RDV + 8 * lane));
    float xv[8] = {bf2f(rw.x & 0xffffu), bf2f(rw.x >> 16), bf2f(rw.y & 0xffffu), bf2f(rw.y >> 16), bf2f(rw.z & 0xffffu), bf2f(rw.z >> 16), bf2f(rw.w & 0xffffu), bf2f(rw.w >> 16)};
    float gv[8] = {bf2f(gw.x & 0xffffu), bf2f(gw.x >> 16), bf2f(gw.y & 0xffffu), bf2f(gw.y >> 16), bf2f(gw.z & 0xffffu), bf2f(gw.z >> 16), bf2f(gw.w & 0xffffu), bf2f(gw.w >> 16)};
    float s = 0.f;
#pragma unroll
    for (int j = 0; j < 8; ++j) s += xv[j];
    const float mean = wave_sum(s) * (1.0f / RDV); float s2 = 0.f;
#pragma unroll
    for (int j = 0; j < 8; ++j) { xv[j] -= mean; s2 += xv[j] * xv[j]; }
    const float rstd = 1.0f / sqrtf(wave_sum(s2) * (1.0f / RDV) + GN_EPS);
    unsigned wv[4];
#pragma unroll
    for (int j = 0; j < 4; ++j) { const float g0 = gv[2 * j], g1 = gv[2 * j + 1];
        wv[j] = pg8::cvt_pk_bf16(g0 * __builtin_amdgcn_rcpf(1.0f + __expf(-g0)) * (xv[2 * j] * rstd), g1 * __builtin_amdgcn_rcpf(1.0f + __expf(-g1)) * (xv[2 * j + 1] * rstd)); }
    *(u32x4*)(gn + (size_t)w * RDV + 8 * lane) = (u32x4){wv[0], wv[1], wv[2], wv[3]};
}
}
struct Args { const float* in[19]; float* out; unsigned char* ws; int ph_lo, ph_hi, bar_region, pad; };
#define CAS __attribute__((address_space(4)))
#define PHASE_ARGS() const CAS Args* ka = (const CAS Args*)__builtin_amdgcn_kernarg_segment_ptr(); asm volatile("" : "+s"(ka) :: "memory"); unsigned char* const ws = ka->ws; (void)ws; int ptid = threadIdx.x; asm volatile("" : "+v"(ptid)); const int lane = ptid & 63, wave = __builtin_amdgcn_readfirstlane(ptid >> 6); (void)lane; (void)wave
#define WSP(type, off) ((type*)(ws + (off)))
#ifndef PH_MASK
#define PH_MASK 0xffff
#endif
#define ON(b) ((PH_MASK >> (b)) & 1)
#ifndef REP_MASK
#define REP_MASK 0
#endif
#define REP(b) _Pragma("unroll 1") for (int rep_ = 0; rep_ < 1 + ((REP_MASK >> (b)) & 1); ++rep_)
__global__ void __launch_bounds__(NWAVES * 64, 2) mega(Args args) {
    extern __shared__ __attribute__((aligned(16))) unsigned char lds_raw[];
    LAS unsigned char* lds = (LAS unsigned char*)lds_raw;
    const int tid = threadIdx.x;
    const int G = gridDim.x;
    for (int u = tid; u < (LDS_BYTES - LDSCTL_OFF) / 4; u += NWAVES * 64) ((LAS unsigned*)(lds + LDSCTL_OFF))[u] = 0u;
    __syncthreads();
    XcdBarrier bar = xcd_barrier_post((unsigned*)(args.ws + OFF_CTL) + CW_BAR + args.bar_region * XCD_BAR_WORDS, (volatile LAS unsigned*)(lds + MISC_OFF) + 8);
    const int lo = args.ph_lo, hi = args.ph_hi;
#define IN(k) (lo <= (k) && (k) < hi)
#define SEAM(k) do { if (IN(k) && IN((k) + 1)) xcd_barrier(bar); } while (0)

    REP(0) if (ON(0) && IN(0)) {
        PHASE_ARGS();
        LAS float* scr = (LAS float*)(lds + RING_OFF + wave * 16384);
        const int gw = blockIdx.x * NWAVES + wave, ngw = G * NWAVES;
        p0_transpose_all(ka->in[2], WSP(bf16_t, OFF_WRI), 2, DM, RIN, scr, gw, ngw, lane);
        p0_transpose_all(ka->in[3], WSP(bf16_t, OFF_WRO), 2, RHV, DM, scr, gw, ngw, lane);
        p0_transpose_all(ka->in[4], WSP(bf16_t, OFF_WSI), 2, DM, 3 * DM, scr, gw, ngw, lane);
        p0_transpose_all(ka->in[5], WSP(bf16_t, OFF_WSO), 2, DM, DM, scr, gw, ngw, lane);
        p0_transpose_all(ka->in[17], WSP(bf16_t, OFF_WPG), 4, DM, DM, scr, gw, ngw, lane);
        p0_transpose_all(ka->in[16], WSP(bf16_t, OFF_WPW), 4, DPLE, DM, scr, gw, ngw, lane);
        p0_transpose_all(ka->in[10], WSP(bf16_t, OFF_WGU), NE, DM, 2 * DF, scr, gw, ngw, lane);
        p0_transpose_all(ka->in[12], WSP(bf16_t, OFF_WDN), NE, DF, DM, scr, gw, ngw, lane);
        const size_t gt = (size_t)blockIdx.x * (NWAVES * 64) + ptid, ngt = (size_t)G * NWAVES * 64;
        { const f32x4* x = (const f32x4*)ka->in[0]; u32x2* xb = WSP(u32x2, OFF_XB);
          cvt_stream(x, xb, (size_t)T * DM / 4, gt, ngt); }
        { const f32x4* p = (const f32x4*)ka->in[1]; u32x2* pb = WSP(u32x2, OFF_PB);
          cvt_stream(p, pb, (size_t)4 * T * DPLE / 4, gt, ngt); }
    }
    SEAM(0);
#pragma unroll 1
    for (int i = 0; i < DEPTH; ++i) {
        const int pb = 2 + 10 * i, j = i >> 1;
        if (IN(pb)) {
            REP(2) if (ON(2) && (i & 1) == 0) {
                PHASE_ARGS();
                pg8::DenseOrder S; S.init(T, RIN, DM, G, (int)blockIdx.x, WSP(bf16_t, OFF_XB), WSP(bf16_t, OFF_WRI) + (size_t)j * RIN * DM);
                if (ptid < 128) ((LAS float*)(lds + LDS_INVF))[ptid] = 1.0f / powf(10000.0f, (float)ptid / 128.0f);
                __syncthreads();
                pg8::EpiRetProj E{WSP(bf16_t, OFF_Q), WSP(bf16_t, OFF_K), WSP(bf16_t, OFF_V), WSP(bf16_t, OFF_G), (const LAS float*)(lds + LDS_INVF)};
                pg8::gemm_phase<pg8::EpiRetProj, pg8::DenseOrder, true, false>(lds + RING_OFF, DM, S, E);
            } REP(3) if (ON(3) && (i & 1) == 1) {
                PHASE_ARGS();
                pg8::DenseOrder S; S.init(T, 3 * DM, DM, G, (int)blockIdx.x, WSP(bf16_t, OFF_XB), WSP(bf16_t, OFF_WSI) + (size_t)j * 3 * DM * DM);
                pg8::EpiBf16 E{WSP(bf16_t, OFF_Q), DM, DM, (size_t)(OFF_K - OFF_Q) / 2, 0.125f * 1.4426950408889634f, 0};
                pg8::gemm_phase<pg8::EpiBf16, pg8::DenseOrder, true, false>(lds + RING_OFF, DM, S, E);
            }
        }
        SEAM(pb);
        if (IN(pb + 1)) {
            REP(10) if (ON(10) && (i & 1) == 0) { PHASE_ARGS(); ret::scan_phase(lds + RING_OFF, WSP(bf16_t, OFF_Q), WSP(bf16_t, OFF_K), WSP(bf16_t, OFF_V), WSP(bf16_t, OFF_RO), G, (int)blockIdx.x,
                ka->in[10] + (size_t)(i + 1) * NE * DM * 2 * DF, WSP(bf16_t, OFF_WGU) + (size_t)(i + 1) * NE * 2 * DF * DM); }
            REP(11) if (ON(11) && (i & 1) == 1) { PHASE_ARGS(); sb::attn_phase(lds + RING_OFF, WSP(bf16_t, OFF_Q), WSP(bf16_t, OFF_K), WSP(bf16_t, OFF_V), WSP(bf16_t, OFF_GN), G, (int)blockIdx.x); }
        }
        SEAM(pb + 1);
        REP(12) if (ON(12) && IN(pb + 2) && (i & 1) == 0) {
            PHASE_ARGS();
            for (int w = blockIdx.x * NWAVES + wave; w < T * RH; w += G * NWAVES) ret::gate_row(w, lane, WSP(bf16_t, OFF_RO), WSP(bf16_t, OFF_G), WSP(bf16_t, OFF_GN));
        }
        if ((i & 1) == 0) SEAM(pb + 2);
        REP(4) if (ON(4) && IN(pb + 3)) {
            PHASE_ARGS();
            pg8::EpiBf16 E{WSP(bf16_t, OFF_MIX), DM, 0, 0, 1.0f, 0};
            const int Kx = (i & 1) ? DM : RHV;
            pg8::DenseOrder S; S.init(T, DM, Kx, G, (int)blockIdx.x, WSP(bf16_t, OFF_GN), (i & 1) ? (const void*)(WSP(bf16_t, OFF_WSO) + (size_t)j * DM * DM) : (const void*)(WSP(bf16_t, OFF_WRO) + (size_t)j * DM * RHV));
            pg8::gemm_phase<pg8::EpiBf16, pg8::DenseOrder, false, false>(lds + RING_OFF, Kx, S, E);
        }
        SEAM(pb + 3);
        REP(6) if (ON(6) && IN(pb + 4)) {
            PHASE_ARGS();
            if (i > 0) cvt_expert_weights(lds, ka->in[10], ka->in[12], ws, i, 1 << 20, ptid);
            __syncthreads();
            unsigned* cnt = WSP(unsigned, OFF_CTL) + CW_CNT + i * 2048;
            const float* lg = ka->in[6] + (size_t)i * DM; const float* lb = ka->in[7] + (size_t)i * DM; const float* rb = ka->in[9] + (size_t)i * NE;
            LAS int* rt_e = (LAS int*)(lds + LDS_ROFF); LAS float* rt_g = (LAS float*)(lds + LDS_SLOT); LAS int* rt_p = (LAS int*)(lds + LDS_SLOT + 1024); LAS int* rt_c = (LAS int*)(lds + LDS_BIAS); LAS int* rt_b = (LAS int*)(lds + LDS_BIAS + 128);
            if (ptid < NE) rt_c[ptid] = 0;
            __syncthreads();
            const int nrow = 2 * G * NWAVES;
            ln1_router_phase(lds + RING_OFF, G, (int)blockIdx.x, wave, lane, WSP(bf16_t, OFF_XB), WSP(bf16_t, OFF_MIX), lg, lb, ka->in[8] + (size_t)i * DM * NE, rb, WSP(bf16_t, OFF_X1B), rt_e, rt_g, rt_p, rt_c);
            __syncthreads();
            if (ptid < NE) rt_b[ptid] = (int)__hip_atomic_fetch_add(cnt + ptid * 64, (unsigned)rt_c[ptid], RLX_AGENT);
            __syncthreads();
            { const int nsw = (T - 2 * (int)blockIdx.x * NWAVES + nrow - 1) / nrow;
              int* elist = WSP(int, OFF_EL); float* gates = WSP(float, OFF_GT);
              for (int s = ptid; s < nsw * 64; s += NWAVES * 64) { const int li = s >> 2, kk = s & 3, sweep = li >> 4, wv = (li >> 1) & 7, r = li & 1;
                  const int t = 2 * ((int)blockIdx.x * NWAVES + wv) + sweep * nrow + r; const int ee = rt_e[s];
                  elist[(size_t)ee * T + rt_b[ee] + rt_p[s]] = t * 4 + kk; gates[t * 4 + kk] = rt_g[s]; } }
            __syncthreads();
        }
        SEAM(pb + 4);
        REP(7) if (ON(7) && IN(pb + 5)) {
            PHASE_ARGS();
            MoeOrder::setup(lds, WSP(unsigned, OFF_CTL) + CW_CNT + i * 2048);
            MoeOrder S; S.G = G; S.c = (int)blockIdx.x; S.nN = 2 * DF / 256; S.tp = (const LAS int*)(lds + LDS_TP); S.cn = (const LAS int*)(lds + LDS_TP + 256); S.elist = WSP(int, OFF_EL);
            S.A = (const char*)WSP(bf16_t, OFF_X1B); S.Bt = (const char*)(WSP(bf16_t, OFF_WGU) + (size_t)i * NE * 2 * DF * DM); S.bstride_e = (size_t)2 * DF * DM * 2; S.gather = true; S.roff = (LAS unsigned*)(lds + LDS_ROFF);
            S.bias = ka->in[11] + (size_t)i * NE * 2 * DF; S.bias_e = 2 * DF; S.slotT = (LAS int*)(lds + LDS_SLOT); S.biasT = (LAS float*)(lds + LDS_BIAS);
            pg8::EpiMoe1 E{(const LAS float*)(lds + LDS_BIAS), WSP(bf16_t, OFF_ACT)};
            pg8::gemm_phase<pg8::EpiMoe1, MoeOrder, true, true>(lds + RING_OFF, DM, S, E);
            if (i + 1 < DEPTH) { const int nwg = S.tp[NE] * S.nN, mine = (nwg - (int)blockIdx.x + G - 1) / G, most = (nwg + G - 1) / G;
                if (mine < most) cvt_expert_weights(lds, ka->in[10], ka->in[12], ws, i + 1, (most - mine) * CVT_TAIL_CLAIMS, ptid); }
        }
        SEAM(pb + 5);
        REP(8) if (ON(8) && IN(pb + 6)) {
            PHASE_ARGS();
            MoeOrder::setup(lds, WSP(unsigned, OFF_CTL) + CW_CNT + i * 2048);
            MoeOrder S; S.G = G; S.c = (int)blockIdx.x; S.nN = DM / 256; S.tp = (const LAS int*)(lds + LDS_TP); S.cn = (const LAS int*)(lds + LDS_TP + 256); S.elist = WSP(int, OFF_EL);
            S.A = (const char*)WSP(bf16_t, OFF_ACT); S.Bt = (const char*)(WSP(bf16_t, OFF_WDN) + (size_t)i * NE * DM * DF); S.bstride_e = (size_t)DM * DF * 2; S.gather = false; S.roff = (LAS unsigned*)(lds + LDS_ROFF);
            S.bias = ka->in[13] + (size_t)i * NE * DM; S.bias_e = DM; S.slotT = (LAS int*)(lds + LDS_SLOT); S.biasT = (LAS float*)(lds + LDS_BIAS);
            pg8::EpiMoe2 E{(const LAS float*)(lds + LDS_BIAS), WSP(bf16_t, OFF_YB), (const LAS int*)(lds + LDS_SLOT)};
            pg8::gemm_phase<pg8::EpiMoe2, MoeOrder, true, false>(lds + RING_OFF, DF, S, E);
            { const int nwg = S.tp[NE] * S.nN, rem = nwg % G, mine = (nwg - (int)blockIdx.x + G - 1) / G, most = (nwg + G - 1) / G;
              int nidle = rem ? G - rem : 0, q = (int)blockIdx.x - rem;
              if (nidle < 64) { nidle = G; q = (int)blockIdx.x; }
              int ppu = 0;
              if (q >= 0) { PPOrder P; P.G = nidle; P.c = 256 * i + q; P.lim = 256 * (i + 1); P.A = (const char*)WSP(bf16_t, OFF_PB); P.Bt = (const char*)WSP(bf16_t, OFF_WPW);
                  pg8::EpiBf16 E2{WSP(bf16_t, OFF_PPB), DM, 0, 0, 1.0f, (size_t)T * DM};
                  pg8::gemm_phase<pg8::EpiBf16, PPOrder, true, false>(lds + RING_OFF, DPLE, P, E2);
                  ppu = (256 - q + nidle - 1) / nidle; }
              if (i + 1 < DEPTH && mine < most) { const int claims = (most - mine) * CVT_TAIL_CLAIMS - ppu;
                  if (claims > 0) cvt_expert_weights(lds, ka->in[10], ka->in[12], ws, i + 1, claims, ptid); } }
        }
        SEAM(pb + 6);
        REP(9) if (ON(9) && IN(pb + 7)) {
            PHASE_ARGS();
            const float* lg = ka->in[14] + (size_t)i * DM; const float* lb = ka->in[15] + (size_t)i * DM;
            { const int st = G * NWAVES; int t = blockIdx.x * NWAVES + wave;
              for (; t + st < T; t += 2 * st) ln2_row2(t, t + st, lane, WSP(bf16_t, OFF_X1B), WSP(bf16_t, OFF_YB), WSP(float, OFF_GT), lg, lb, WSP(bf16_t, OFF_X2B));
              if (t < T) ln2_row(t, lane, WSP(bf16_t, OFF_X1B), WSP(bf16_t, OFF_YB), WSP(float, OFF_GT), lg, lb, WSP(bf16_t, OFF_X2B)); }
        }
        SEAM(pb + 7);
        REP(5) if (ON(5) && IN(pb + 8)) {
            PHASE_ARGS();
            pg8::DenseOrder S; S.init(T, DM, DM, G, (int)blockIdx.x, WSP(bf16_t, OFF_X2B), WSP(bf16_t, OFF_WPG) + (size_t)i * DM * DM);
            if (i == DEPTH - 1) { pg8::EpiPle<true> E{WSP(bf16_t, OFF_X2B), WSP(bf16_t, OFF_PPB) + (size_t)i * T * DM, ka->in[18] + (size_t)i * DM, WSP(bf16_t, OFF_XB), ka->out};
                pg8::gemm_phase<pg8::EpiPle<true>, pg8::DenseOrder, false, false>(lds + RING_OFF, DM, S, E); }
            else { pg8::EpiPle<false> E{WSP(bf16_t, OFF_X2B), WSP(bf16_t, OFF_PPB) + (size_t)i * T * DM, ka->in[18] + (size_t)i * DM, WSP(bf16_t, OFF_XB), nullptr};
                pg8::gemm_phase<pg8::EpiPle<false>, pg8::DenseOrder, false, false>(lds + RING_OFF, DM, S, E); }
        }
        SEAM(pb + 8);
    }
#undef IN
#undef SEAM
}
static int g_grid = 0;
extern "C" void kernel_launch(void* const* d_in, const int* in_sizes, int n_in, void* d_out, int out_size, void* d_ws, size_t ws_size, hipStream_t stream) {
    if (n_in != 19 || ws_size < WS_END || out_size != T * DM) { fprintf(stderr, "kernel_launch: unexpected arguments (n_in %d, ws %zu need %zu, out %d)\n", n_in, ws_size, (size_t)WS_END, out_size); return; }
    if (g_grid == 0) {
        int dev = 0, cus = 0;
        if (hipGetDevice(&dev) != hipSuccess || hipDeviceGetAttribute(&cus, hipDeviceAttributeMultiprocessorCount, dev) != hipSuccess) { g_grid = -1; return; }
        if (hipFuncSetAttribute((const void*)mega, hipFuncAttributeMaxDynamicSharedMemorySize, LDS_BYTES) != hipSuccess) { g_grid = -1; return; }
        int per_cu = 0; (void)hipOccupancyMaxActiveBlocksPerMultiprocessor(&per_cu, (const void*)mega, NWAVES * 64, LDS_BYTES); (void)hipGetLastError();
        if (per_cu < 1) fprintf(stderr, "kernel_launch: occupancy query reports %d workgroups per CU\n", per_cu);
        if (cus < 256) { fprintf(stderr, "kernel_launch: built for a 256-CU device (per-block routing tables hold 64 token rows); found %d CUs, nothing launched\n", cus); g_grid = -1; return; }
        g_grid = cus;
    }
    if (g_grid < 0) return;
    (void)hipMemsetAsync((unsigned char*)d_ws + OFF_CTL, 0, MiB, stream);
    Args a{};
    for (int i = 0; i < 19; ++i) a.in[i] = (const float*)d_in[i];
    a.out = (float*)d_out; a.ws = (unsigned char*)d_ws; a.ph_lo = 0; a.ph_hi = 2 + 10 * DEPTH; a.bar_region = 0; a.pad = 0;
    hipLaunchKernelGGL(mega, dim3(g_grid), dim3(NWAVES * 64), LDS_BYTES, stream, a);
}
```
